# Optimizing an MI355X kernel written in HIP

```python
import jax, jax.numpy as jnp
from jax import lax
import numpy as np

D_MODEL = 1024
BATCH = 4
SEQ = 8192
DEPTH = 1

GRID_W = 64
CTX_LEN = 256
RW_HEADS = 8
RW_HEAD_DIM = 64
RW_WIDTH = RW_HEADS * RW_HEAD_DIM
RW_DECAY_LORA = 64
RW_AAA_LORA = 64
RW_GATE_LORA = 128
MLA_HEADS = 4
MLA_Q_LORA = 256
MLA_KV_LORA = 256
MLA_NOPE_DIM = 128
MLA_ROPE_DIM = 64
MLA_V_DIM = 128
MLA_WIDTH = MLA_HEADS * MLA_V_DIM
MIX_WIDTH = RW_WIDTH + MLA_WIDTH
ROPE_BASE = 10000.0
Q_BLOCK = 128
N_EXPERTS = 16
EXPERT_HIDDEN = 1024
CAPACITY_FACTOR = 2
LN_EPS = 1e-5
RMS_EPS = 1e-6
GN_EPS = 64e-5
RW_PROJ = 3 * RW_WIDTH + 2 * RW_DECAY_LORA + 2 * RW_AAA_LORA + RW_GATE_LORA
MLA_PROJ = MLA_Q_LORA + MLA_KV_LORA + MLA_ROPE_DIM
IN_PROJ = RW_PROJ + MLA_PROJ

kernel_name = 'hybrid_rwkv7_mla_ecmoe_dit_block'


def _standardize(x, eps):
    xf = x.astype(jnp.float32)
    mu = jnp.mean(xf, axis=-1, keepdims=True)
    var = jnp.mean(jnp.square(xf - mu), axis=-1, keepdims=True)
    return (xf - mu) * lax.rsqrt(var + eps)


def modulate(x, shift, scale):
    return (_standardize(x, LN_EPS) * (1.0 + scale) + shift).astype(x.dtype)


def layer_norm(x, g, b):
    return (_standardize(x, LN_EPS) * g + b).astype(x.dtype)


def rms_norm(x, g):
    xf = x.astype(jnp.float32)
    return (xf * lax.rsqrt(jnp.mean(jnp.square(xf), -1, keepdims=True) + RMS_EPS) * g).astype(x.dtype)


def split_cols(h, sizes):
    return jnp.split(h, np.cumsum(sizes)[:-1].tolist(), axis=-1)


def centred_conv3(h, w):
    hp = jnp.pad(h, ((0, 0), (1, 1), (0, 0)))
    return w[0] * hp[:, :-2] + w[1] * hp[:, 1:-1] + w[2] * hp[:, 2:]


def axial_angles(rows):
    rr, cc = jnp.meshgrid(jnp.arange(rows), jnp.arange(GRID_W), indexing='ij')
    half = MLA_ROPE_DIM // 2
    inv_freq = ROPE_BASE ** (-jnp.arange(0, half, 2, dtype=jnp.float32) / half)
    ang_r = rr.reshape(-1, 1).astype(jnp.float32) * inv_freq
    ang_c = cc.reshape(-1, 1).astype(jnp.float32) * inv_freq
    return ang_r, ang_c


def rotate_pairs(x, ang):
    x1, x2 = jnp.split(x, 2, axis=-1)
    cos = jnp.cos(ang).astype(x.dtype)
    sin = jnp.sin(ang).astype(x.dtype)
    return jnp.concatenate([x1 * cos - x2 * sin, x2 * cos + x1 * sin], axis=-1)


def rope_axial(x, ang_r, ang_c):
    half = MLA_ROPE_DIM // 2
    return jnp.concatenate([rotate_pairs(x[..., :half], ang_r), rotate_pairs(x[..., half:], ang_c)], axis=-1)


def rwkv_prepare(h, p):
    B, T, _ = h.shape
    heads = lambda t: t.reshape(B, T, RW_HEADS, RW_HEAD_DIM).astype(jnp.float32)
    rkv, w_dn, a_dn, g_dn = split_cols(h, (3 * RW_WIDTH, 2 * RW_DECAY_LORA, 2 * RW_AAA_LORA, RW_GATE_LORA))
    r, k, v = jnp.split(centred_conv3(rkv, p['rwkv_conv']), 3, axis=-1)
    g = jax.nn.sigmoid(g_dn) @ p['rwkv_g_up']
    kk = heads(k * p['rwkv_k_k'])
    kk = kk * lax.rsqrt(jnp.sum(jnp.square(kk), -1, keepdims=True) + 1e-12)
    w_dirs = jnp.split(w_dn, 2, axis=-1)
    a_dirs = jnp.split(a_dn, 2, axis=-1)
    per_dir = []
    for d in range(2):
        logw = -jax.nn.softplus(-(p['rwkv_w0'][d] + jnp.tanh(w_dirs[d]) @ p['rwkv_w_up'][d]).astype(jnp.float32)) - 0.5
        decay = jnp.exp(-jnp.exp(logw))
        a = jax.nn.sigmoid(p['rwkv_a0'][d] + a_dirs[d] @ p['rwkv_a_up'][d])
        k_d = k * (1.0 + (a - 1.0) * p['rwkv_k_a'])
        per_dir.append((heads(decay), heads(a), heads(k_d)))
    return heads(r), heads(v), kk, g, per_dir


def rwkv_scan(r, decay, k, v, kk, a, state0, reverse, emit):
    def step(S, inp):
        r_t, w_t, k_t, v_t, kk_t, a_t = inp
        s_kk = jnp.einsum('bhvk,bhk->bhv', S, kk_t)
        S = S * w_t[:, :, None, :] - s_kk[..., None] * (kk_t * a_t)[:, :, None, :] + v_t[..., None] * k_t[:, :, None, :]
        y = jnp.einsum('bhvk,bhk->bhv', S, r_t) if emit else None
        return S, y
    xs = tuple(jnp.moveaxis(t, 1, 0) for t in (r, decay, k, v, kk, a))
    state, ys = lax.scan(step, state0, xs, reverse=reverse)
    return state, (jnp.moveaxis(ys, 0, 1) if emit else None)


def rwkv_readout(y, r, v, k_sum, g, p):
    B, T = y.shape[:2]
    yn = _standardize(y, GN_EPS).reshape(B, T, RW_WIDTH) * p['rwkv_gn_g'] + p['rwkv_gn_b']
    bonus = jnp.sum(r * k_sum * p['rwkv_r_k'], -1, keepdims=True) * v
    return (yn + bonus.reshape(B, T, RW_WIDTH)).astype(g.dtype) * g


def rwkv_group(h, hc, p, emit_ctx):
    r, v, kk, g, dirs = rwkv_prepare(h, p)
    rc, vc, kkc, gc, dirs_c = rwkv_prepare(hc, p)
    B = h.shape[0]
    ys_lat, ys_ctx = [], []
    for d in range(2):
        decay, a, k_d = dirs[d]
        decay_c, a_c, k_dc = dirs_c[d]
        state0 = jnp.zeros((B, RW_HEADS, RW_HEAD_DIM, RW_HEAD_DIM), jnp.float32)
        state_c, yc = rwkv_scan(rc, decay_c, k_dc, vc, kkc, a_c, state0, d == 1, emit_ctx)
        _, yl = rwkv_scan(r, decay, k_d, v, kk, a, state_c, d == 1, True)
        ys_lat.append(yl)
        ys_ctx.append(yc)
    out_lat = rwkv_readout(ys_lat[0] + ys_lat[1], r, v, dirs[0][2] + dirs[1][2], g, p)
    out_ctx = None
    if emit_ctx:
        out_ctx = rwkv_readout(ys_ctx[0] + ys_ctx[1], rc, vc, dirs_c[0][2] + dirs_c[1][2], gc, p)
    return out_lat, out_ctx


def mla_queries(h, p, ang):
    B, T, _ = h.shape
    q = rms_norm(h[..., :MLA_Q_LORA], p['mla_q_norm']) @ p['mla_w_uq']
    q = q.reshape(B, T, MLA_HEADS, MLA_NOPE_DIM + MLA_ROPE_DIM)
    q_nope, q_rope = q[..., :MLA_NOPE_DIM], q[..., MLA_NOPE_DIM:]
    if ang is not None:
        q_rope = rope_axial(q_rope, ang[0][:, None, :], ang[1][:, None, :])
    return q_nope, q_rope


def mla_keys_values(h, p, ang):
    B, T, _ = h.shape
    c_kv = rms_norm(h[..., MLA_Q_LORA:MLA_Q_LORA + MLA_KV_LORA], p['mla_kv_norm'])
    k_rope = h[..., MLA_Q_LORA + MLA_KV_LORA:]
    if ang is not None:
        k_rope = rope_axial(k_rope, ang[0], ang[1])
    k_nope = (c_kv @ p['mla_w_uk']).reshape(B, T, MLA_HEADS, MLA_NOPE_DIM)
    v = (c_kv @ p['mla_w_uv']).reshape(B, T, MLA_HEADS, MLA_V_DIM)
    return k_nope, k_rope, v


def block_attention(q_nope, q_rope, k_nope, k_rope, v):
    B, T, H, _ = q_nope.shape
    nb = T // Q_BLOCK
    scale = (MLA_NOPE_DIM + MLA_ROPE_DIM) ** -0.5
    qn = q_nope.reshape(B, nb, Q_BLOCK, H, MLA_NOPE_DIM).transpose(1, 0, 2, 3, 4)
    qr = q_rope.reshape(B, nb, Q_BLOCK, H, MLA_ROPE_DIM).transpose(1, 0, 2, 3, 4)

    def one_block(args):
        qn_b, qr_b = args
        s = jnp.einsum('bqhd,bkhd->bhqk', qn_b, k_nope) + jnp.einsum('bqhr,bkr->bhqk', qr_b, k_rope)
        prob = jax.nn.softmax(s.astype(jnp.float32) * scale, axis=-1).astype(v.dtype)
        return jnp.einsum('bhqk,bkhd->bqhd', prob, v)

    o = lax.map(one_block, (qn, qr))
    return o.transpose(1, 0, 2, 3, 4).reshape(B, T, H * MLA_V_DIM)


def mla_group(h, hc, p, ang, emit_ctx):
    kc_nope, kc_rope, vc = mla_keys_values(hc, p, None)
    k_nope, k_rope, v = mla_keys_values(h, p, ang)
    q_nope, q_rope = mla_queries(h, p, ang)
    out_lat = block_attention(q_nope, q_rope,
                              jnp.concatenate([kc_nope, k_nope], axis=1),
                              jnp.concatenate([kc_rope, k_rope], axis=1),
                              jnp.concatenate([vc, v], axis=1))
    out_ctx = None
    if emit_ctx:
        qc_nope, qc_rope = mla_queries(hc, p, None)
        out_ctx = block_attention(qc_nope, qc_rope, kc_nope, kc_rope, vc)
    return out_lat, out_ctx


def expert_choice_ffn(u, p):
    B, T, _ = u.shape
    cap = CAPACITY_FACTOR * T // N_EXPERTS
    affinity = jax.nn.softmax((u @ p['router']).astype(jnp.float32), axis=-1)
    gate, idx = lax.top_k(jnp.swapaxes(affinity, 1, 2), cap)
    b_idx = jnp.arange(B)[:, None, None]
    xe = u[b_idx, idx]
    hid = jax.nn.silu(jnp.einsum('becd,edf->becf', xe, p['exp_w_gate'])) * jnp.einsum('becd,edf->becf', xe, p['exp_w_up'])
    ye = jnp.einsum('becf,efd->becd', hid, p['exp_w_down']) * gate[..., None].astype(u.dtype)
    return jnp.zeros_like(u).at[b_idx, idx].add(ye)


def hybrid_layer(x, xc, mod, mod_c, ang, p, alpha, emit_ctx):
    sh1, sc1, g1, sh2, sc2, g2 = jnp.split(mod, 6, axis=-1)
    sh1c, sc1c, g1c, sh2c, sc2c, g2c = jnp.split(mod_c, 6, axis=-1)
    h = modulate(x, sh1, sc1) @ p['w_in']
    hc = modulate(xc, sh1c, sc1c) @ p['w_in']
    rw_lat, rw_ctx = rwkv_group(h[..., :RW_PROJ], hc[..., :RW_PROJ], p, emit_ctx)
    mla_lat, mla_ctx = mla_group(h[..., RW_PROJ:], hc[..., RW_PROJ:], p, ang, emit_ctx)
    mix = jnp.concatenate([rw_lat, mla_lat], axis=-1) @ p['w_out']
    x = layer_norm(alpha * x + g1 * mix, p['ln1_g'], p['ln1_b'])
    x = layer_norm(alpha * x + g2 * expert_choice_ffn(modulate(x, sh2, sc2), p), p['ln2_g'], p['ln2_b'])
    if emit_ctx:
        mix_c = jnp.concatenate([rw_ctx, mla_ctx], axis=-1) @ p['w_out']
        xc = layer_norm(alpha * xc + g1c * mix_c, p['ln1_g'], p['ln1_b'])
        xc = layer_norm(alpha * xc + g2c * expert_choice_ffn(modulate(xc, sh2c, sc2c), p), p['ln2_g'], p['ln2_b'])
    return x, xc


def setup_inputs(seed: int = 0) -> dict:
    key = jax.random.key(seed)
    keys = list(jax.random.split(key, 40))
    nk = lambda: keys.pop()
    f32 = jnp.float32
    normal = lambda shape: jax.random.normal(nk(), shape, f32)
    nrm = lambda shape, fan_in, gain=1.0: normal(shape) * (gain * fan_in ** -0.5)
    L, D = DEPTH, D_MODEL
    beta = (8.0 * DEPTH) ** -0.25
    x = normal((BATCH, SEQ, D))
    c = normal((BATCH, D))
    ctx = normal((BATCH, CTX_LEN, D))
    c_ctx = normal((D,))
    w_ada = nrm((L, D, 6 * D), D, 0.5)
    b_ada = 0.02 * normal((L, 6 * D))
    w_in = nrm((L, D, IN_PROJ), D)
    w_in = w_in.at[:, :, 2 * RW_WIDTH:3 * RW_WIDTH].multiply(beta)
    rwkv_conv = jnp.array([0.25, 1.0, 0.25], f32)[None, :, None] + 0.05 * normal((L, 3, 3 * RW_WIDTH))
    decay_ramp = jnp.tile(jnp.linspace(-6.5, -1.0, RW_HEAD_DIM, dtype=f32), RW_HEADS)
    rwkv_w0 = decay_ramp + 0.1 * normal((L, 2, RW_WIDTH))
    rwkv_w_up = 0.1 * normal((L, 2, RW_DECAY_LORA, RW_WIDTH))
    rwkv_a0 = 0.1 * normal((L, 2, RW_WIDTH))
    rwkv_a_up = nrm((L, 2, RW_AAA_LORA, RW_WIDTH), RW_AAA_LORA, 0.5)
    rwkv_g_up = nrm((L, RW_GATE_LORA, RW_WIDTH), RW_GATE_LORA)
    rwkv_k_k = 0.85 + 0.05 * normal((L, RW_WIDTH))
    rwkv_k_a = 1.0 + 0.05 * normal((L, RW_WIDTH))
    rwkv_r_k = 0.1 * normal((L, RW_HEADS, RW_HEAD_DIM))
    rwkv_gn_g = 1.0 + 0.05 * normal((L, RW_WIDTH))
    rwkv_gn_b = 0.02 * normal((L, RW_WIDTH))
    mla_q_norm = 1.0 + 0.05 * normal((L, MLA_Q_LORA))
    mla_w_uq = nrm((L, MLA_Q_LORA, MLA_HEADS * (MLA_NOPE_DIM + MLA_ROPE_DIM)), MLA_Q_LORA)
    mla_kv_norm = 1.0 + 0.05 * normal((L, MLA_KV_LORA))
    mla_w_uk = nrm((L, MLA_KV_LORA, MLA_HEADS * MLA_NOPE_DIM), MLA_KV_LORA)
    mla_w_uv = nrm((L, MLA_KV_LORA, MLA_HEADS * MLA_V_DIM), MLA_KV_LORA, beta)
    w_out = nrm((L, MIX_WIDTH, D), MIX_WIDTH, beta)
    ln1_g = 1.0 + 0.05 * normal((L, D))
    ln1_b = 0.02 * normal((L, D))
    router = nrm((L, D, N_EXPERTS), D)
    exp_w_gate = nrm((L, N_EXPERTS, D, EXPERT_HIDDEN), D)
    exp_w_up = nrm((L, N_EXPERTS, D, EXPERT_HIDDEN), D)
    exp_w_down = nrm((L, N_EXPERTS, EXPERT_HIDDEN, D), EXPERT_HIDDEN, beta)
    ln2_g = 1.0 + 0.05 * normal((L, D))
    ln2_b = 0.02 * normal((L, D))
    return {'x': x, 'c': c, 'ctx': ctx, 'c_ctx': c_ctx, 'w_ada': w_ada, 'b_ada': b_ada, 'w_in': w_in,
            'rwkv_conv': rwkv_conv, 'rwkv_w0': rwkv_w0, 'rwkv_w_up': rwkv_w_up, 'rwkv_a0': rwkv_a0,
            'rwkv_a_up': rwkv_a_up, 'rwkv_g_up': rwkv_g_up, 'rwkv_k_k': rwkv_k_k, 'rwkv_k_a': rwkv_k_a,
            'rwkv_r_k': rwkv_r_k, 'rwkv_gn_g': rwkv_gn_g, 'rwkv_gn_b': rwkv_gn_b, 'mla_q_norm': mla_q_norm,
            'mla_w_uq': mla_w_uq, 'mla_kv_norm': mla_kv_norm, 'mla_w_uk': mla_w_uk, 'mla_w_uv': mla_w_uv,
            'w_out': w_out, 'ln1_g': ln1_g, 'ln1_b': ln1_b, 'router': router, 'exp_w_gate': exp_w_gate,
            'exp_w_up': exp_w_up, 'exp_w_down': exp_w_down, 'ln2_g': ln2_g, 'ln2_b': ln2_b}


def reference(x, c, ctx, c_ctx, w_ada, b_ada, w_in, rwkv_conv, rwkv_w0, rwkv_w_up, rwkv_a0, rwkv_a_up,
              rwkv_g_up, rwkv_k_k, rwkv_k_a, rwkv_r_k, rwkv_gn_g, rwkv_gn_b, mla_q_norm, mla_w_uq,
              mla_kv_norm, mla_w_uk, mla_w_uv, w_out, ln1_g, ln1_b, router, exp_w_gate, exp_w_up,
              exp_w_down, ln2_g, ln2_b):
    ROWS = x.shape[1] // GRID_W
    ang = axial_angles(ROWS)
    alpha = (2.0 * DEPTH) ** 0.25
    for l in range(DEPTH):
        p = {'w_in': w_in[l], 'rwkv_conv': rwkv_conv[l], 'rwkv_w0': rwkv_w0[l], 'rwkv_w_up': rwkv_w_up[l],
             'rwkv_a0': rwkv_a0[l], 'rwkv_a_up': rwkv_a_up[l], 'rwkv_g_up': rwkv_g_up[l],
             'rwkv_k_k': rwkv_k_k[l], 'rwkv_k_a': rwkv_k_a[l], 'rwkv_r_k': rwkv_r_k[l],
             'rwkv_gn_g': rwkv_gn_g[l], 'rwkv_gn_b': rwkv_gn_b[l], 'mla_q_norm': mla_q_norm[l],
             'mla_w_uq': mla_w_uq[l], 'mla_kv_norm': mla_kv_norm[l], 'mla_w_uk': mla_w_uk[l],
             'mla_w_uv': mla_w_uv[l], 'w_out': w_out[l], 'ln1_g': ln1_g[l], 'ln1_b': ln1_b[l],
             'router': router[l], 'exp_w_gate': exp_w_gate[l], 'exp_w_up': exp_w_up[l],
             'exp_w_down': exp_w_down[l], 'ln2_g': ln2_g[l], 'ln2_b': ln2_b[l]}
        mod = jax.nn.silu(c) @ w_ada[l] + b_ada[l]
        mod_c = jax.nn.silu(c_ctx) @ w_ada[l] + b_ada[l]
        x, ctx = hybrid_layer(x, ctx, mod[:, None, :], mod_c, ang, p, alpha, l < DEPTH - 1)
    return x
```

```cpp
#include <hip/hip_runtime.h>
#include <hip/hip_cooperative_groups.h>
#include <cstdio>
#include <cstdint>
namespace cg = cooperative_groups;
#ifndef EDUP
#define EDUP 0
#endif
#define ER(k) for (int er_ = 0; er_ <= (((EDUP) >> (k)) & 1); ++er_)

#define LAS __attribute__((address_space(3)))
typedef unsigned short bf16_t;
typedef short bf16x8 __attribute__((ext_vector_type(8)));
typedef short s16x4 __attribute__((ext_vector_type(4)));
typedef float f32x2 __attribute__((ext_vector_type(2)));
typedef float f32x4 __attribute__((ext_vector_type(4)));
typedef float f32x16 __attribute__((ext_vector_type(16)));
typedef unsigned u32x2 __attribute__((ext_vector_type(2)));
typedef unsigned u32x4 __attribute__((ext_vector_type(4)));
typedef _Float16 h16x8 __attribute__((ext_vector_type(8)));
typedef _Float16 h16x4 __attribute__((ext_vector_type(4)));

constexpr int NB = 4, T = 8192, D = 1024, CTX = 256, SKV = T + CTX;
constexpr int ML = NB * T, MC = NB * CTX, MA = ML + MC;
constexpr int NHP = 2560, IN_PROJ = 2496;
constexpr int NE = 16, CAP = 1024, NSLOT = NE * NB * CAP;
constexpr int NTHREADS = 512, NWAVES = 8;
constexpr int LDS_BYTES = 163840;
constexpr int NPHASE = 15;
#ifndef USE_DIRECT_SCAN
#define USE_DIRECT_SCAN 0
#endif
constexpr float LN_EPS = 1e-5f, RMS_EPS = 1e-6f, GN_EPS = 64e-5f;
constexpr float ALPHA = 1.189207115002721f;

constexpr size_t MiB = 1u << 20;
constexpr size_t WS_CTL = 0, CTL_BYTES = 16384;
constexpr size_t WS_MOD = 1 * MiB, WS_RSTDQ = 1 * MiB + 256 * 1024, WS_RSTDKV = 1 * MiB + 512 * 1024;
constexpr size_t WS_WIN = 2 * MiB, WS_WLORA = 7 * MiB, WS_WUQ = 9 * MiB, WS_WUKV = 9 * MiB + 512 * 1024, WS_WOUT = 10 * MiB;
constexpr size_t WS_RN = 12 * MiB;
constexpr size_t WS_H = 16 * MiB;
constexpr size_t SZ_L16 = (size_t)MA * 512 * 2;
constexpr size_t WS_E16 = WS_H, WS_A16 = WS_H + 2 * SZ_L16, WS_G16 = WS_H + 4 * SZ_L16;
constexpr size_t WS_Y1 = 16 * MiB, WS_HID = 16 * MiB;
constexpr size_t WS_WD = 144 * MiB, WS_WGU = 176 * MiB, WS_XM2 = 240 * MiB, WS_YE = 176 * MiB;
constexpr size_t WS_RKV = 181 * MiB;
constexpr size_t WS_XM = 280 * MiB, WS_ACT = 280 * MiB;
constexpr size_t WS_Q = 346 * MiB, WS_K = 394 * MiB, WS_V = 444 * MiB, WS_X1 = 346 * MiB;
constexpr size_t WS_AFF = 478 * MiB, WS_SLOT = 480 * MiB, WS_IDX = 482 * MiB, WS_GATE = 482 * MiB + 512 * 1024;
constexpr size_t WS_QC0 = 280 * MiB, WS_SEG = 314 * MiB, WS_QC1 = 477 * MiB;
constexpr size_t WS_END = 510 * MiB;
constexpr size_t DO_YS = 0, DO_MIX = 64 * MiB;

struct Params { const float* in[32]; float* out; unsigned char* ws; int ph_lo, ph_hi; };
typedef const Params __attribute__((address_space(4)))& KP;
enum { I_X = 0, I_C, I_CTX, I_CCTX, I_WADA, I_BADA, I_WIN, I_CONV, I_W0, I_WUP, I_A0, I_AUP, I_GUP, I_KK, I_KA, I_RK, I_GNG, I_GNB,
       I_QNORM, I_WUQ, I_KVNORM, I_WUK, I_WUV, I_WOUT, I_LN1G, I_LN1B, I_ROUTER, I_EG, I_EU, I_ED, I_LN2G, I_LN2B };

__device__ __forceinline__ unsigned cvt_pk_bf16(float lo, float hi) { unsigned r; asm volatile("v_cvt_pk_bf16_f32 %0, %1, %2" : "=v"(r) : "v"(lo), "v"(hi)); return r; }
typedef __bf16 bf16x2_t __attribute__((ext_vector_type(2)));
__device__ __forceinline__ unsigned cvt_pk_bf16_n(float lo, float hi) { const f32x2 v = {lo, hi}; const bf16x2_t b = __builtin_convertvector(v, bf16x2_t); return __builtin_bit_cast(unsigned, b); }
__device__ __forceinline__ float bf2f(unsigned short b) { return __uint_as_float(((unsigned)b) << 16); }
__device__ __forceinline__ float bflo(unsigned w) { return __uint_as_float(w << 16); }
__device__ __forceinline__ float bfhi(unsigned w) { return __uint_as_float(w & 0xffff0000u); }
template <int CTRL> __device__ __forceinline__ float dppf(float x) { return __int_as_float(__builtin_amdgcn_update_dpp(0, __float_as_int(x), CTRL, 0xF, 0xF, true)); }
__device__ __forceinline__ float allred16(float x) { x += dppf<0xB1>(x); x += dppf<0x4E>(x); x += dppf<0x141>(x); x += dppf<0x140>(x); return x; }
__device__ __forceinline__ float wave_sum(float v) {
    v = allred16(v);
    { const auto r16 = __builtin_amdgcn_permlane16_swap(__float_as_uint(v), __float_as_uint(v), false, false); v = __uint_as_float(r16[0]) + __uint_as_float(r16[1]); }
    const auto rr = __builtin_amdgcn_permlane32_swap(__float_as_uint(v), __float_as_uint(v), false, false);
    return __uint_as_float(rr[0]) + __uint_as_float(rr[1]);
}
__device__ __forceinline__ float sigmoidf_(float x) { return __builtin_amdgcn_rcpf(1.0f + __builtin_amdgcn_exp2f(-1.4426950408889634f * x)); }
#define LDS_WAIT() asm volatile("s_waitcnt lgkmcnt(0)" ::: "memory")


#define XB_TMO      128
#define XB_XCNT(j)  (256  + 64 * (j))
#define XB_XSUB(j)  (1280 + 64 * (j))
#define XB_XGEN(j)  (2304 + 64 * (j))
#define XB_TOP      3328
#define XB_TOPGEN   3392
#define XCD_BAR_WORDS 3456
#define XB_SPIN_CAP (1u << 18)
__device__ __forceinline__ unsigned xb_ld(unsigned* p)              { return __hip_atomic_load(p, __ATOMIC_RELAXED, __HIP_MEMORY_SCOPE_AGENT); }
__device__ __forceinline__ unsigned xb_add(unsigned* p, unsigned v) { return __hip_atomic_fetch_add(p, v, __ATOMIC_RELAXED, __HIP_MEMORY_SCOPE_AGENT); }
__device__ __forceinline__ unsigned xb_xcc_id() { return (unsigned)__builtin_amdgcn_s_getreg((3 << 11) | 20) & 0xFu; }
#define XB_SPIN(cond, bar) do { unsigned _sp = 0; while (cond) { __builtin_amdgcn_s_sleep(1); \
    if ((++_sp & 255u) == 0u) { if (xb_ld(&(bar)[XB_TMO])) break; if (_sp > XB_SPIN_CAP) { atomicAdd(&(bar)[XB_TMO], 1u); break; } } } } while (0)
struct XcdBarrier { unsigned* bar; unsigned x; volatile LAS unsigned* st; };
__device__ __forceinline__ XcdBarrier xcd_barrier_post(unsigned* bar, volatile LAS unsigned* st) {
    XcdBarrier b; b.bar = bar; b.x = xb_xcc_id(); b.st = st;
    if (threadIdx.x == 0) (void)xb_add(&bar[XB_XCNT(b.x)], 1u);
    return b;
}
__device__ __forceinline__ void xcd_barrier_complete(unsigned* bar, unsigned x, unsigned& nloc, unsigned& nx) {
    const unsigned G = gridDim.x * gridDim.y * gridDim.z;
    unsigned sum, cnt, mine, sp = 0u;
    for (;;) {
        sum = 0u; cnt = 0u; mine = 0u;
#pragma unroll
        for (unsigned j = 0; j < 16; ++j) { const unsigned c = xb_ld(&bar[XB_XCNT(j)]); sum += c; cnt += (c > 0u) ? 1u : 0u; mine = (j == x) ? c : mine; }
        if (sum == G) break;
        __builtin_amdgcn_s_sleep(1);
        if ((++sp & 255u) == 0u) { if (xb_ld(&bar[XB_TMO])) break; if (sp > XB_SPIN_CAP) { atomicAdd(&bar[XB_TMO], 1u); break; } }
    }
    nloc = mine > 0u ? mine : 1u; nx = cnt > 0u ? cnt : 1u;
}
__device__ __forceinline__ void xcd_barrier(const XcdBarrier& b) {
    asm volatile("s_waitcnt vmcnt(0)" ::: "memory");
    __syncthreads();
    if (threadIdx.x == 0) {
        unsigned* bar = b.bar;
        __builtin_amdgcn_s_waitcnt(0);
        unsigned nloc = b.st[0], nx = b.st[1];
        if (nloc == 0u) { xcd_barrier_complete(bar, b.x, nloc, nx); b.st[0] = nloc; b.st[1] = nx; }
        const unsigned old = xb_add(&bar[XB_XSUB(b.x)], 1u);
        const unsigned gen = old / nloc;
        if (old + 1u == (gen + 1u) * nloc) {
            __builtin_amdgcn_fence(__ATOMIC_RELEASE, "agent");
            asm volatile("s_waitcnt vmcnt(0)" ::: "memory");
            const unsigned og = xb_add(&bar[XB_TOP], 1u);
            const unsigned tg = og / nx;
            if (og + 1u == (tg + 1u) * nx) xb_add(&bar[XB_TOPGEN], 1u);
            else XB_SPIN(xb_ld(&bar[XB_TOPGEN]) == tg, bar);
            __builtin_amdgcn_fence(__ATOMIC_ACQUIRE, "agent");
            xb_add(&bar[XB_XGEN(b.x)], 1u);
            asm volatile("s_waitcnt vmcnt(0)" ::: "memory");
        } else {
            XB_SPIN(xb_ld(&bar[XB_XGEN(b.x)]) == gen, bar);
            __builtin_amdgcn_fence(__ATOMIC_ACQUIRE, "agent");
            asm volatile("s_waitcnt vmcnt(0)" ::: "memory");
        }
    }
    __syncthreads();
}

namespace pg8 {
constexpr int BM = 256, BK = 64, HALF = 128, HTB = HALF * BK * 2, STAGE_BYTES = 8 * HTB;
__device__ __forceinline__ int lds_byte(int r, int c) { const int st = (r >> 4) * 2 + (c >> 5), rr = r & 15, cc = c & 31, ob = rr * 64 + cc * 2; return st * 1024 + (ob ^ (((ob >> 9) & 1) << 5)); }
__device__ __forceinline__ void stage_rc(int b, int& R, int& C) { const int st = b / 1024, sb = b % 1024, swz = sb ^ (((sb >> 9) & 1) << 5); R = (st >> 1) * 16 + swz / 64; C = (st & 1) * 32 + (swz % 64) / 2; }
__device__ __forceinline__ int perm32(int rho) { const int n = rho >> 4, i = rho & 15; return 8 * (i >> 2) + 4 * n + (i & 3); }
struct Unit { int pm, pn; };
struct Gemm { const bf16_t* A; const bf16_t* Bt; int K, lda; };

struct DenseOrder {
    int nM, nN, nwg, G, c, dupf;
    __device__ void init(int M, int N, int G_, int c_, int dupf_ = 1) { nM = M / BM; nN = N / BM; nwg = nM * nN; G = G_; c = c_; dupf = dupf_; }
    __device__ bool next(int i, Unit& u) const {
        const long L = (long)i * G + c; if (L >= (long)nwg * dupf) return false;
        int wgid = (int)(L % nwg); { const int q = nwg / 8, r = nwg % 8, xcd = wgid % 8, off = wgid / 8; wgid = (xcd < r ? xcd * (q + 1) : r * (q + 1) + (xcd - r) * q) + off; }
        const int nig = 8 * nN, gid = wgid / nig, fm = gid * 8, gsz = (nM - fm) < 8 ? (nM - fm) : 8;
        u.pm = fm + ((wgid % nig) % gsz); u.pn = (wgid % nig) / gsz; return true;
    }
    __device__ __forceinline__ int arow(const Unit& u, int r) const { return u.pm * BM + r; }
    __device__ __forceinline__ int acol(const Unit&) const { return 0; }
};
struct LoraOrder : DenseOrder { __device__ __forceinline__ int acol(const Unit& u) const { return u.pn < 4 ? 0 : (u.pn < 8 ? 128 : 256); } };

template <class Epi, class Sched>
__device__ __forceinline__ void gemm_phase(LAS unsigned char* lds, const Gemm g, const Sched& S, const Epi& E) {
    const int tid = threadIdx.x, wid = __builtin_amdgcn_readfirstlane(tid >> 6), lane = tid & 63, wr = wid >> 2, wc = wid & 3, fr = lane & 15, fq = lane >> 4;
    int K = g.K; asm volatile("" : "+s"(K));
    const int nt = K / BK;
    int Rr[2], Cc[2]; unsigned voffB[2];
#pragma unroll
    for (int i = 0; i < 2; ++i) { int R, C; stage_rc(tid * 16 + i * 8192, R, C); Rr[i] = R; Cc[i] = C; const int Rb = Epi::PERM ? ((R & ~31) + perm32(R & 31)) : R; voffB[i] = (unsigned)(Rb * K + C) * 2u; }
    const size_t kstep = (size_t)(BK * 2);
    const size_t hstepB = (size_t)HALF * K * 2, tstepB = 2 * hstepB;
    const unsigned ldsw = (unsigned)wid * 1024u;
    const int aoff = lds_byte(wr * 64 + fr, fq * 8), boff = lds_byte(wc * 32 + fr, fq * 8);
#define PG8_SA(b, h) (((b) * 2 + (h)) * HTB)
#define PG8_SB(b, h) ((4 + (b) * 2 + (h)) * HTB)
#define PG8_STAGE(bufoff, gbase, voff) do { _Pragma("unroll") for (int _i = 0; _i < 2; ++_i) \
        __builtin_amdgcn_global_load_lds((const unsigned*)((const char*)(gbase) + (voff)[_i]), (LAS unsigned*)(lds + (bufoff) + ldsw + _i * 8192), 16, 0, 0); } while (0)
#define PG8_LDA(dst, b, h) do { _Pragma("unroll") for (int m = 0; m < 4; ++m) _Pragma("unroll") for (int k = 0; k < 2; ++k) dst[m][k] = *(const LAS bf16x8*)(lds + PG8_SA(b, h) + aoff + m * 2048 + k * 1024); } while (0)
#define PG8_LDB(dst, b, h) do { _Pragma("unroll") for (int n = 0; n < 2; ++n) _Pragma("unroll") for (int k = 0; k < 2; ++k) dst[n][k] = *(const LAS bf16x8*)(lds + PG8_SB(b, h) + boff + n * 2048 + k * 1024); } while (0)
#define PG8_MMA(ai, bj, At, Bt) do { __builtin_amdgcn_s_setprio(1); _Pragma("unroll") for (int m = 0; m < 4; ++m) _Pragma("unroll") for (int n = 0; n < 2; ++n) _Pragma("unroll") for (int k = 0; k < 2; ++k) \
        acc[ai][bj][m][n] = __builtin_amdgcn_mfma_f32_16x16x32_bf16(Bt[n][k], At[m][k], acc[ai][bj][m][n], 0, 0, 0); __builtin_amdgcn_s_setprio(0); } while (0)
#define PG8_WAIT_V(n) asm volatile("s_waitcnt vmcnt(" #n ")" ::: "memory")
#define PG8_WAIT_L(n) asm volatile("s_waitcnt lgkmcnt(" #n ")" ::: "memory")
#define PG8_BAR __builtin_amdgcn_s_barrier()
#define PG8_SCHED __builtin_amdgcn_sched_barrier(0)
#define PG8_LOADVO(dst, u) do { _Pragma("unroll") for (int _h = 0; _h < 2; ++_h) _Pragma("unroll") for (int _i = 0; _i < 2; ++_i) \
        dst[_h][_i] = ((unsigned)S.arow(u, _h * HALF + Rr[_i]) * (unsigned)g.lda + (unsigned)Cc[_i] + (unsigned)S.acol(u)) * 2u; } while (0)
    Unit cur, nxt; int ui = 0;
    if (!S.next(0, cur)) return;
    f32x4 acc[2][2][4][2];
#pragma unroll
    for (int a = 0; a < 2; ++a)
#pragma unroll
        for (int b = 0; b < 2; ++b)
#pragma unroll
            for (int m = 0; m < 4; ++m)
#pragma unroll
                for (int n = 0; n < 2; ++n) acc[a][b][m][n] = (f32x4){0.f, 0.f, 0.f, 0.f};
    bf16x8 At[4][2], B0[2][2], B1[2][2];
    unsigned voA[2][2], voN[2][2];
    PG8_LOADVO(voA, cur);
    const char* Ab = (const char*)g.A;
    const char* cB = (const char*)g.Bt + (size_t)cur.pn * tstepB;
    PG8_STAGE(PG8_SB(0, 0), cB, voffB); PG8_STAGE(PG8_SA(0, 0), Ab, voA[0]); PG8_STAGE(PG8_SB(0, 1), cB + hstepB, voffB); PG8_STAGE(PG8_SA(0, 1), Ab, voA[1]);
    if (wr == 1) PG8_BAR;
    PG8_WAIT_V(4); PG8_BAR;
    PG8_STAGE(PG8_SB(1, 0), cB + kstep, voffB); PG8_STAGE(PG8_SA(1, 0), Ab + kstep, voA[0]); PG8_STAGE(PG8_SB(1, 1), cB + hstepB + kstep, voffB);
    PG8_WAIT_V(6); PG8_BAR;
    for (;;) {
        const bool has_next = S.next(ui + 1, nxt);
        if (has_next) { PG8_LOADVO(voN, nxt); }
        else {
#pragma unroll
            for (int h = 0; h < 2; ++h)
#pragma unroll
                for (int i = 0; i < 2; ++i) voN[h][i] = voA[h][i]; }
        const char* nB = has_next ? (const char*)g.Bt + (size_t)nxt.pn * tstepB : cB;
#pragma unroll 1
        for (int t = 0; t < nt; t += 2) {
            const bool last = (t == nt - 2);
            const char* a1 = Ab + (size_t)(t + 1) * kstep;
            const char* a2 = last ? Ab : Ab + (size_t)(t + 2) * kstep; const char* b2 = last ? nB : cB + (size_t)(t + 2) * kstep;
            const char* a3 = a2 + kstep; const char* b3 = b2 + kstep;
            unsigned o2[2][2];
#pragma unroll
            for (int h = 0; h < 2; ++h)
#pragma unroll
                for (int i = 0; i < 2; ++i) o2[h][i] = last ? voN[h][i] : voA[h][i];
            PG8_LDB(B0, 0, 0); PG8_SCHED; PG8_LDA(At, 0, 0); PG8_STAGE(PG8_SA(1, 1), a1, voA[1]);
            PG8_WAIT_L(8); PG8_BAR; PG8_WAIT_L(0); PG8_MMA(0, 0, At, B0); PG8_BAR; PG8_SCHED;
            PG8_LDB(B1, 0, 1); PG8_STAGE(PG8_SB(0, 0), b2, voffB);
            PG8_BAR; PG8_WAIT_L(0); PG8_MMA(0, 1, At, B1); PG8_BAR;
            PG8_LDA(At, 0, 1); PG8_STAGE(PG8_SA(0, 0), a2, o2[0]);
            PG8_BAR; PG8_WAIT_L(0); PG8_MMA(1, 0, At, B0); PG8_BAR; PG8_SCHED;
            PG8_STAGE(PG8_SB(0, 1), b2 + hstepB, voffB);
            PG8_WAIT_V(6); PG8_BAR; PG8_MMA(1, 1, At, B1); PG8_BAR;
            PG8_LDB(B0, 1, 0); PG8_SCHED; PG8_LDA(At, 1, 0); PG8_STAGE(PG8_SA(0, 1), a2, o2[1]);
            PG8_WAIT_L(8); PG8_BAR; PG8_WAIT_L(0); PG8_MMA(0, 0, At, B0); PG8_BAR; PG8_SCHED;
            PG8_LDB(B1, 1, 1); PG8_STAGE(PG8_SB(1, 0), b3, voffB);
            PG8_BAR; PG8_WAIT_L(0); PG8_MMA(0, 1, At, B1); PG8_BAR;
            PG8_LDA(At, 1, 1); PG8_STAGE(PG8_SA(1, 0), a3, o2[0]);
            PG8_BAR; PG8_WAIT_L(0); PG8_MMA(1, 0, At, B0); PG8_BAR; PG8_SCHED;
            PG8_STAGE(PG8_SB(1, 1), b3 + hstepB, voffB);
            PG8_WAIT_V(6); PG8_BAR; PG8_MMA(1, 1, At, B1); PG8_BAR;
        }
        { int fr_ = fr, fq_ = fq; asm volatile("" : "+v"(fr_), "+v"(fq_)); E(acc, cur, wr, wc, fr_, fq_); }
        if (!has_next) break;
#pragma unroll
        for (int a = 0; a < 2; ++a)
#pragma unroll
            for (int b = 0; b < 2; ++b)
#pragma unroll
                for (int m = 0; m < 4; ++m)
#pragma unroll
                    for (int n = 0; n < 2; ++n) acc[a][b][m][n] = (f32x4){0.f, 0.f, 0.f, 0.f};
        cur = nxt; cB = nB; ++ui;
#pragma unroll
        for (int h = 0; h < 2; ++h)
#pragma unroll
            for (int i = 0; i < 2; ++i) voA[h][i] = voN[h][i];
    }
    PG8_WAIT_V(0);
    if (wr == 0) PG8_BAR;
    PG8_BAR;
#undef PG8_SA
#undef PG8_SB
#undef PG8_STAGE
#undef PG8_LDA
#undef PG8_LDB
#undef PG8_MMA
#undef PG8_WAIT_V
#undef PG8_WAIT_L
#undef PG8_BAR
#undef PG8_SCHED
#undef PG8_LOADVO
}
}
using pg8::Unit;

typedef const f32x4 (&AccRef)[2][2][4][2];

struct EpiH {
    static constexpr bool PERM = true; bf16_t* O;
    __device__ __forceinline__ void operator()(AccRef acc, const Unit& u, int wr, int wc, int fr, int fq) const {
        const int row0 = u.pm * 256 + wr * 64 + fr, col0 = u.pn * 256 + wc * 32 + 8 * fq;
#pragma unroll
        for (int ai = 0; ai < 2; ++ai)
#pragma unroll
            for (int m = 0; m < 4; ++m) { bf16_t* rowp = O + (size_t)(row0 + ai * 128 + m * 16) * NHP + col0;
#pragma unroll
                for (int bj = 0; bj < 2; ++bj) { const f32x4 v0 = acc[ai][bj][m][0], v1 = acc[ai][bj][m][1];
                    u32x4 w; w.x = cvt_pk_bf16(v0[0], v0[1]); w.y = cvt_pk_bf16(v0[2], v0[3]); w.z = cvt_pk_bf16(v1[0], v1[1]); w.w = cvt_pk_bf16(v1[2], v1[3]);
                    *(u32x4*)(rowp + bj * 128) = w; } }
    }
};

__device__ __forceinline__ float rope_invfreq(int j) { return __builtin_amdgcn_exp2f(-(float)(2 * j) * (13.287712379549449f / 32.0f)) * 0.15915494309189535f; }

struct EpiQ {
    static constexpr bool PERM = false; bf16_t* Q; const float* rstd;
    __device__ __forceinline__ void operator()(AccRef acc, const Unit& u, int wr, int wc, int fr, int fq) const {
        const int row0 = u.pm * 256 + wr * 64 + fr;
        float fr4[4];
#pragma unroll
        for (int i = 0; i < 4; ++i) fr4[i] = rope_invfreq(4 * fq + i);
#pragma unroll
        for (int ai = 0; ai < 2; ++ai)
#pragma unroll
            for (int m = 0; m < 4; ++m) {
                const int row = row0 + ai * 128 + m * 16; const int b = row >> 13, t = row & (T - 1);
                const float rs = rstd[row];
#pragma unroll
                for (int bj = 0; bj < 2; ++bj) {
                    const int cgp = u.pn * 8 + bj * 4 + wc;
                    const int head = cgp / 6, wg = cgp - head * 6;
                    bf16_t* qp = Q + ((size_t)(b * 4 + head) * T + t) * 192 + wg * 32 + 4 * fq;
                    f32x4 x1 = acc[ai][bj][m][0] * rs, x2 = acc[ai][bj][m][1] * rs;
                    if (wg >= 4) {
                        const float pos = (float)(wg == 4 ? (t >> 6) : (t & 63));
#pragma unroll
                        for (int i = 0; i < 4; ++i) { float rev = pos * fr4[i]; rev = rev - floorf(rev);
                            const float sn = __builtin_amdgcn_sinf(rev), cs = __builtin_amdgcn_cosf(rev);
                            const float a = x1[i], bb = x2[i]; x1[i] = a * cs - bb * sn; x2[i] = bb * cs + a * sn; }
                    }
                    u32x2 w0, w1; w0.x = cvt_pk_bf16(x1[0], x1[1]); w0.y = cvt_pk_bf16(x1[2], x1[3]); w1.x = cvt_pk_bf16(x2[0], x2[1]); w1.y = cvt_pk_bf16(x2[2], x2[3]);
                    *(u32x2*)qp = w0; *(u32x2*)(qp + 16) = w1;
                }
                asm volatile("" ::: "memory");
            }
    }
};

struct EpiKV {
    static constexpr bool PERM = true; bf16_t* Kb; bf16_t* Vb; const float* rstd;
    __device__ __forceinline__ void operator()(AccRef acc, const Unit& u, int wr, int wc, int fr, int fq) const {
        const int row0 = u.pm * 256 + wr * 64 + fr; const bool isv = u.pn >= 2; const int c0 = wc * 32 + 8 * fq;
#pragma unroll
        for (int ai = 0; ai < 2; ++ai)
#pragma unroll
            for (int m = 0; m < 4; ++m) {
                const int row = row0 + ai * 128 + m * 16; int b, key;
                if (row < ML) { b = row >> 13; key = CTX + (row & (T - 1)); } else { const int rc = row - ML; b = rc >> 8; key = rc & (CTX - 1); }
                const float rs = rstd[row];
#pragma unroll
                for (int bj = 0; bj < 2; ++bj) { const int head = ((u.pn & 1) << 1) + bj;
                    const f32x4 v0 = acc[ai][bj][m][0] * rs, v1 = acc[ai][bj][m][1] * rs;
                    u32x4 w; w.x = cvt_pk_bf16(v0[0], v0[1]); w.y = cvt_pk_bf16(v0[2], v0[3]); w.z = cvt_pk_bf16(v1[0], v1[1]); w.w = cvt_pk_bf16(v1[2], v1[3]);
                    const size_t kr = (size_t)(b * 4 + head) * SKV + key;
                    if (isv) *(u32x4*)(Vb + kr * 128 + c0) = w; else *(u32x4*)(Kb + kr * 192 + c0) = w; }
                asm volatile("" ::: "memory");
            }
    }
};

struct EpiLora {
    static constexpr bool PERM = true; _Float16* E16; _Float16* A16; _Float16* G16; const float* w0; const float* a0;
    __device__ __forceinline__ void operator()(AccRef acc, const Unit& u, int wr, int wc, int fr, int fq) const {
        const int row0 = u.pm * 256 + wr * 64 + fr; const int type = u.pn >> 1, dir = type & 1;
        _Float16* dst = type < 2 ? E16 + (size_t)dir * MA * 512 : (type < 4 ? A16 + (size_t)dir * MA * 512 : G16);
        const float* bias = type < 2 ? w0 + dir * 512 : a0 + dir * 512;
#pragma unroll
        for (int bj = 0; bj < 2; ++bj) { const int ch = (u.pn & 1) * 256 + bj * 128 + wc * 32 + 8 * fq;
            f32x4 b0 = {0.f, 0.f, 0.f, 0.f}, b1 = {0.f, 0.f, 0.f, 0.f};
            if (type < 4) { b0 = *(const f32x4*)(bias + ch); b1 = *(const f32x4*)(bias + ch + 4); }
#pragma unroll
            for (int ai = 0; ai < 2; ++ai)
#pragma unroll
                for (int m = 0; m < 4; ++m) { const int row = row0 + ai * 128 + m * 16;
                    f32x4 v0 = acc[ai][bj][m][0] + b0, v1 = acc[ai][bj][m][1] + b1;
                    if (type < 4) {
                        const float sc = type < 2 ? 0.6065306597126334f : 1.0f;
#pragma unroll
                        for (int i = 0; i < 4; ++i) { v0[i] = sc * sigmoidf_(v0[i]); v1[i] = sc * sigmoidf_(v1[i]); } }
                    h16x8 o; o[0] = (_Float16)v0[0]; o[1] = (_Float16)v0[1]; o[2] = (_Float16)v0[2]; o[3] = (_Float16)v0[3]; o[4] = (_Float16)v1[0]; o[5] = (_Float16)v1[1]; o[6] = (_Float16)v1[2]; o[7] = (_Float16)v1[3];
                    *(h16x8*)(dst + (size_t)row * 512 + ch) = o; asm volatile("" ::: "memory"); } }
    }
};

struct EpiMix {
    static constexpr bool PERM = true; bf16_t* O;
    __device__ __forceinline__ void operator()(AccRef acc, const Unit& u, int wr, int wc, int fr, int fq) const {
        const int row0 = u.pm * 256 + wr * 64 + fr, col0 = u.pn * 256 + wc * 32 + 8 * fq;
#pragma unroll
        for (int ai = 0; ai < 2; ++ai)
#pragma unroll
            for (int m = 0; m < 4; ++m) { bf16_t* rowp = O + (size_t)(row0 + ai * 128 + m * 16) * D + col0;
#pragma unroll
                for (int bj = 0; bj < 2; ++bj) { const f32x4 v0 = acc[ai][bj][m][0], v1 = acc[ai][bj][m][1];
                    u32x4 w; w.x = cvt_pk_bf16(v0[0], v0[1]); w.y = cvt_pk_bf16(v0[2], v0[3]); w.z = cvt_pk_bf16(v1[0], v1[1]); w.w = cvt_pk_bf16(v1[2], v1[3]);
                    *(u32x4*)(rowp + bj * 128) = w; } }
    }
};

struct EpiHid {
    static constexpr bool PERM = true; bf16_t* Hd;
    __device__ __forceinline__ void operator()(AccRef acc, const Unit& u, int wr, int wc, int fr, int fq) const {
        const int row0 = u.pm * 256 + wr * 64 + fr, col0 = (u.pn & 7) * 128 + wc * 32 + 8 * fq;
#pragma unroll
        for (int ai = 0; ai < 2; ++ai)
#pragma unroll
            for (int m = 0; m < 4; ++m) {
                f32x4 v0, v1;
#pragma unroll
                for (int i = 0; i < 4; ++i) { const float g0 = acc[ai][0][m][0][i], g1 = acc[ai][0][m][1][i];
                    v0[i] = g0 * sigmoidf_(g0) * acc[ai][1][m][0][i]; v1[i] = g1 * sigmoidf_(g1) * acc[ai][1][m][1][i]; }
                u32x4 w; w.x = cvt_pk_bf16(v0[0], v0[1]); w.y = cvt_pk_bf16(v0[2], v0[3]); w.z = cvt_pk_bf16(v1[0], v1[1]); w.w = cvt_pk_bf16(v1[2], v1[3]);
                *(u32x4*)(Hd + (size_t)(row0 + ai * 128 + m * 16) * 1024 + col0) = w; }
    }
};

struct EpiYe {
    static constexpr bool PERM = true; bf16_t* Ye; const float* gate;
    __device__ __forceinline__ void operator()(AccRef acc, const Unit& u, int wr, int wc, int fr, int fq) const {
        const int row0 = u.pm * 256 + wr * 64 + fr, col0 = (u.pn & 3) * 256 + wc * 32 + 8 * fq;
#pragma unroll
        for (int ai = 0; ai < 2; ++ai)
#pragma unroll
            for (int m = 0; m < 4; ++m) { const int row = row0 + ai * 128 + m * 16; const float gt = gate[row];
#pragma unroll
                for (int bj = 0; bj < 2; ++bj) { const f32x4 v0 = acc[ai][bj][m][0] * gt, v1 = acc[ai][bj][m][1] * gt;
                    u32x4 w; w.x = cvt_pk_bf16(v0[0], v0[1]); w.y = cvt_pk_bf16(v0[2], v0[3]); w.z = cvt_pk_bf16(v1[0], v1[1]); w.w = cvt_pk_bf16(v1[2], v1[3]);
                    *(u32x4*)(Ye + (size_t)row * 1024 + col0 + bj * 128) = w; } }
    }
};

struct GuOrder {
    int G, c; const int* idx; int dupf;
    __device__ bool next(int i, Unit& u) const { long L = (long)i * G + c; if (L >= 2048L * dupf) return false; L &= 2047;
        const int e = (int)L >> 7, w = (int)L & 127;
        const int xc = w & 7, k = w >> 3; u.pn = e * 8 + (xc & 3) * 2 + (k & 1); u.pm = e * 16 + (xc >> 2) * 8 + (k >> 1); return true; }
    __device__ __forceinline__ int arow(const Unit& u, int r) const { return ((u.pm >> 2) & 3) * T + idx[u.pm * 256 + r]; }
    __device__ __forceinline__ int acol(const Unit&) const { return 0; }
};
struct DnOrder {
    int G, c, dupf;
    __device__ bool next(int i, Unit& u) const { long L = (long)i * G + c; if (L >= 1024L * dupf) return false; L &= 1023;
        const int e = (int)L >> 6, w = (int)L & 63; u.pm = e * 16 + (w >> 2); u.pn = e * 4 + (w & 3); return true; }
    __device__ __forceinline__ int arow(const Unit& u, int r) const { return u.pm * 256 + r; }
    __device__ __forceinline__ int acol(const Unit&) const { return 0; }
};

namespace att {
constexpr int DQK = 192, DV = 128, KVBLK = 64, QBLK = 32;
constexpr float SCALE = 0.07216878364870322f;
constexpr float THR = 8.f;
constexpr int KPITCH = 400;
constexpr int SHM_V = KVBLK * DV * 2, SHM_K = KVBLK * KPITCH;
constexpr int SHM_ATTN = 2 * SHM_V + 2 * SHM_K + NWAVES * 64 * 4;
#define SBAR() __builtin_amdgcn_sched_barrier(0)
__device__ __forceinline__ int crow(int r, int hi) { return (r & 3) + 8 * (r >> 2) + 4 * hi; }
__device__ __forceinline__ void partialSM(f32x16& p0, f32x16& p1, float& m_reg, float& mn, float& alpha) {
    constexpr float C = SCALE * 1.4426950408889634f;
    float pmax = p0[0];
#pragma unroll
    for (int r = 1; r < 16; ++r) pmax = fmaxf(pmax, p0[r]);
#pragma unroll
    for (int r = 0; r < 16; ++r) pmax = fmaxf(pmax, p1[r]);
    { auto rr = __builtin_amdgcn_permlane32_swap(__float_as_uint(pmax), __float_as_uint(pmax), false, false);
      pmax = fmaxf(__uint_as_float(rr[0]), __uint_as_float(rr[1])); }
    if (__builtin_expect(__all(pmax - m_reg <= THR / SCALE), 1)) { mn = m_reg; alpha = 1.f; }
    else { mn = fmaxf(m_reg, pmax); alpha = __builtin_amdgcn_exp2f((m_reg - mn) * C); m_reg = mn; }
    const float mnC = -mn * C;
#pragma unroll
    for (int r = 0; r < 16; ++r) p0[r] = fmaf(p0[r], C, mnC);
#pragma unroll
    for (int r = 0; r < 16; ++r) p1[r] = fmaf(p1[r], C, mnC);
#pragma unroll
    for (int r = 0; r < 16; ++r) p0[r] = __builtin_amdgcn_exp2f(p0[r]);
}
__device__ __forceinline__ void finishSM(f32x16& p0, f32x16& p1, float alpha, float& l_reg, bf16x8& pa0, bf16x8& pa1, bf16x8& pa2, bf16x8& pa3) {
#pragma unroll
    for (int r = 0; r < 16; ++r) p1[r] = __builtin_amdgcn_exp2f(p1[r]);
    float ps = 0;
#pragma unroll
    for (int r = 0; r < 16; ++r) ps += p0[r];
#pragma unroll
    for (int r = 0; r < 16; ++r) ps += p1[r];
    { auto rr = __builtin_amdgcn_permlane32_swap(__float_as_uint(ps), __float_as_uint(ps), false, false);
      ps = __uint_as_float(rr[0]) + __uint_as_float(rr[1]); }
    l_reg = l_reg * alpha + ps;
#define PK4(P, BASE, OUT) do { unsigned a0 = cvt_pk_bf16(P[BASE + 0], P[BASE + 1]), a1 = cvt_pk_bf16(P[BASE + 2], P[BASE + 3]);   \
    unsigned b0 = cvt_pk_bf16(P[BASE + 4], P[BASE + 5]), b1 = cvt_pk_bf16(P[BASE + 6], P[BASE + 7]);                              \
    auto r0 = __builtin_amdgcn_permlane32_swap(a0, b0, false, false); auto r1 = __builtin_amdgcn_permlane32_swap(a1, b1, false, false); \
    u32x4 w = {r0[0], r1[0], r0[1], r1[1]}; OUT = *reinterpret_cast<bf16x8*>(&w); } while (0)
    PK4(p0, 0, pa0); PK4(p0, 8, pa1); PK4(p1, 0, pa2); PK4(p1, 8, pa3);
#undef PK4
}
__device__ __forceinline__ void qkt(f32x16& p0, f32x16& p1, const char* Ks, const bf16x8* qr, int r32, int hi) {
    p0 = f32x16{}; p1 = f32x16{};
#pragma unroll
    for (int d0 = 0; d0 < 12; ++d0) { const int cb = d0 * 32 + hi * 16;
        const bf16x8 b0 = *reinterpret_cast<const bf16x8*>(Ks + r32 * KPITCH + cb);
        const bf16x8 b1 = *reinterpret_cast<const bf16x8*>(Ks + (32 + r32) * KPITCH + cb);
        p0 = __builtin_amdgcn_mfma_f32_32x32x16_bf16(b0, qr[d0], p0, 0, 0, 0);
        p1 = __builtin_amdgcn_mfma_f32_32x32x16_bf16(b1, qr[d0], p1, 0, 0, 0); }
}
__device__ __forceinline__ int v_st(int k, int c) { const int kk = (k & ~0xC) | ((k & 4) << 1) | ((k & 8) >> 1); return ((kk >> 3) * 4 + (c >> 5)) * 512 + ((kk & 7) * 32 + (c & 31)) * 2; }
__device__ __forceinline__ int v_rd_base(int lane) { return ((lane & 3) << 3) | (((lane >> 2) & 3) << 6) | (((lane >> 4) & 1) << 5) | (((lane >> 5) & 1) << 8); }
constexpr int v_rd_off(int d0, int ks, int half) { return d0 * 512 + ks * 4096 + half * 2048; }
template <int OFF> __device__ __forceinline__ s16x4 tr_read(int vb) {
    s16x4 r; asm volatile("ds_read_b64_tr_b16 %0, %1 offset:%2" : "=&v"(r) : "v"(vb), "i"(OFF) : "memory"); return r;
}
template <int D0> __device__ __forceinline__ void pv_one(f32x16& od, int vb, bf16x8 pa0, bf16x8 pa1, bf16x8 pa2, bf16x8 pa3) {
    const s16x4 l0 = tr_read<v_rd_off(D0, 0, 0)>(vb), h0 = tr_read<v_rd_off(D0, 0, 1)>(vb), l1 = tr_read<v_rd_off(D0, 1, 0)>(vb), h1 = tr_read<v_rd_off(D0, 1, 1)>(vb);
    const s16x4 l2 = tr_read<v_rd_off(D0, 2, 0)>(vb), h2 = tr_read<v_rd_off(D0, 2, 1)>(vb), l3 = tr_read<v_rd_off(D0, 3, 0)>(vb), h3 = tr_read<v_rd_off(D0, 3, 1)>(vb);
    asm volatile("s_waitcnt lgkmcnt(0)" ::: "memory"); SBAR();
#define PK(L, H) (bf16x8){L[0], L[1], L[2], L[3], H[0], H[1], H[2], H[3]}
    od = __builtin_amdgcn_mfma_f32_32x32x16_bf16(pa0, PK(l0, h0), od, 0, 0, 0);
    od = __builtin_amdgcn_mfma_f32_32x32x16_bf16(pa1, PK(l1, h1), od, 0, 0, 0);
    od = __builtin_amdgcn_mfma_f32_32x32x16_bf16(pa2, PK(l2, h2), od, 0, 0, 0);
    od = __builtin_amdgcn_mfma_f32_32x32x16_bf16(pa3, PK(l3, h3), od, 0, 0, 0);
#undef PK
}
__device__ __forceinline__ void pv_d0(f32x16* o, int vb, bf16x8 pa0, bf16x8 pa1, bf16x8 pa2, bf16x8 pa3) {
    pv_one<0>(o[0], vb, pa0, pa1, pa2, pa3); pv_one<1>(o[1], vb, pa0, pa1, pa2, pa3); pv_one<2>(o[2], vb, pa0, pa1, pa2, pa3); pv_one<3>(o[3], vb, pa0, pa1, pa2, pa3);
}
__device__ __forceinline__ void attn_unit(const bf16_t* __restrict__ Qb, const bf16_t* __restrict__ Kh, const bf16_t* __restrict__ Vh, bf16_t* __restrict__ Ob, char* lds) {
    const int tid = threadIdx.x, wid = __builtin_amdgcn_readfirstlane(tid >> 6), lane = tid & 63, r32 = lane & 31, hi = lane >> 5;
    char* V_lds = lds; char* K_lds = lds + 2 * SHM_V;
    float* ws = (float*)(lds + 2 * SHM_V + 2 * SHM_K) + wid * 64; float* li_l = ws; float* al_l = ws + 32;
    float m_reg = -1e30f, l_reg = 0; f32x16 o[4] = {}; bf16x8 qr[12];
    const bf16_t* Qw = Qb + (size_t)(wid * QBLK + r32) * DQK + hi * 8;
#pragma unroll
    for (int d0 = 0; d0 < 12; ++d0) qr[d0] = *reinterpret_cast<const bf16x8*>(Qw + d0 * 16);
    const int sr = tid >> 4, sc = (tid & 15) * 8, vst0 = v_st(sr, sc);
    const int kd0 = tid * 16 + 16 * (tid / 24), kd1 = (tid + 512) * 16 + 16 * ((tid + 512) / 24), kd2 = (tid + 1024) * 16 + 16 * ((tid + 1024) / 24);
    const char* Kg = (const char*)Kh + tid * 16; const char* Vg = (const char*)Vh + tid * 16;
    const int vb0 = (int)(uintptr_t)V_lds + v_rd_base(lane);
    bf16x8 vs0, vs1, ks0, ks1, ks2;
#define SLOAD(k0) do { const char* vp = Vg + (size_t)(k0) * (DV * 2); const char* kp = Kg + (size_t)(k0) * (DQK * 2); \
    vs0 = *reinterpret_cast<const bf16x8*>(vp); vs1 = *reinterpret_cast<const bf16x8*>(vp + 8192); \
    ks0 = *reinterpret_cast<const bf16x8*>(kp); ks1 = *reinterpret_cast<const bf16x8*>(kp + 8192); ks2 = *reinterpret_cast<const bf16x8*>(kp + 16384); } while (0)
#define SWRITE(b) do { *(bf16x8*)(V_lds + (b) * SHM_V + vst0) = vs0; *(bf16x8*)(V_lds + (b) * SHM_V + vst0 + 8192) = vs1; \
    *(bf16x8*)(K_lds + (b) * SHM_K + kd0) = ks0; *(bf16x8*)(K_lds + (b) * SHM_K + kd1) = ks1; *(bf16x8*)(K_lds + (b) * SHM_K + kd2) = ks2; } while (0)
#define SWAIT() asm volatile("s_waitcnt vmcnt(0)" ::: "memory")
#define RESC(a) do { if (__any((a) < 1.f)) { if (hi == 0) al_l[r32] = (a); asm volatile("s_waitcnt lgkmcnt(0)" ::: "memory"); \
    _Pragma("unroll") for (int d = 0; d < 4; ++d) _Pragma("unroll") for (int r = 0; r < 16; ++r) o[d][r] *= al_l[crow(r, hi)]; } } while (0)
    f32x16 pA0, pA1, pB0, pB1; float mnA, mnB, alA, alB; bf16x8 pa0, pa1, pa2, pa3; constexpr int NT = SKV / KVBLK;
    SLOAD(0); SWAIT(); SWRITE(0); __syncthreads();
    qkt(pA0, pA1, K_lds, qr, r32, hi); partialSM(pA0, pA1, m_reg, mnA, alA);
    SLOAD(KVBLK);
    SWAIT(); SWRITE(1); __syncthreads();
    for (int j = 1; j + 1 < NT; j += 2) {
        SBAR(); qkt(pB0, pB1, K_lds + SHM_K, qr, r32, hi);
        finishSM(pA0, pA1, alA, l_reg, pa0, pa1, pa2, pa3); SBAR();
        SLOAD((j + 1) * KVBLK); SBAR();
        pv_d0(o, vb0, pa0, pa1, pa2, pa3); partialSM(pB0, pB1, m_reg, mnB, alB);
        __syncthreads(); SWAIT(); SWRITE(0);
        RESC(alB); __syncthreads();
        SBAR(); qkt(pA0, pA1, K_lds, qr, r32, hi);
        finishSM(pB0, pB1, alB, l_reg, pa0, pa1, pa2, pa3); SBAR();
        SLOAD((j + 2) * KVBLK); SBAR();
        pv_d0(o, vb0 + SHM_V, pa0, pa1, pa2, pa3); partialSM(pA0, pA1, m_reg, mnA, alA);
        __syncthreads(); SWAIT(); SWRITE(1);
        RESC(alA); __syncthreads();
    }
    SBAR(); qkt(pB0, pB1, K_lds + SHM_K, qr, r32, hi);
    finishSM(pA0, pA1, alA, l_reg, pa0, pa1, pa2, pa3); SBAR();
    pv_d0(o, vb0, pa0, pa1, pa2, pa3); partialSM(pB0, pB1, m_reg, mnB, alB);
    __syncthreads(); RESC(alB);
    finishSM(pB0, pB1, alB, l_reg, pa0, pa1, pa2, pa3); SBAR();
    pv_d0(o, vb0 + SHM_V, pa0, pa1, pa2, pa3);
    if (hi == 0) li_l[r32] = l_reg;
    asm volatile("s_waitcnt lgkmcnt(0)" ::: "memory");
    float rli[16];
#pragma unroll
    for (int r = 0; r < 16; ++r) rli[r] = __builtin_amdgcn_rcpf(li_l[crow(r, hi)]);
    bf16_t* Ow = Ob + (size_t)(wid * QBLK) * 1024;
#pragma unroll
    for (int r = 0; r < 16; ++r) { const int orow = crow(r, hi);
#pragma unroll
        for (int d0 = 0; d0 < 4; ++d0) Ow[(size_t)orow * 1024 + d0 * 32 + r32] = (bf16_t)(cvt_pk_bf16(o[d0][r] * rli[r], 0.f) & 0xffffu); }
#undef SLOAD
#undef SWRITE
#undef SWAIT
#undef RESC
}
}

namespace att2 {
using att::crow; using att::v_rd_base; using att::v_rd_off;
constexpr int DQK = 192, DV = 128, KVBLK = 64, QBLK = 32, NT = SKV / KVBLK;
constexpr float SCALE = 0.07216878364870322f, THR = 8.f, CL = SCALE * 1.4426950408889634f;
constexpr int KTB = KVBLK * DQK * 2, VTB = KVBLK * DV * 2, VRING = 4 * KTB, OFF_SCR = VRING + 3 * VTB;
#define SB2() __builtin_amdgcn_sched_barrier(0)
template <int I> __device__ __forceinline__ float pget(const f32x16& p0, const f32x16& p1) { if constexpr (I < 16) return p0[I]; else return p1[I - 16]; }
template <int I> __device__ __forceinline__ void pset(f32x16& p0, f32x16& p1, float v) { if constexpr (I < 16) p0[I] = v; else p1[I - 16] = v; }
template <int I> __device__ __forceinline__ void fexp(f32x16& p0, f32x16& p1) { pset<I>(p0, p1, __builtin_amdgcn_exp2f(pget<I>(p0, p1))); }
template <int I> __device__ __forceinline__ void fadd(const f32x16& p0, const f32x16& p1, float& psA, float& psB) { if constexpr (I < 16) psA += pget<I>(p0, p1); else psB += pget<I>(p0, p1); }
template <int B> __device__ __forceinline__ void fcvt(const f32x16& p0, const f32x16& p1, unsigned (&tw)[4]) {
    tw[0] = cvt_pk_bf16_n(pget<B>(p0, p1), pget<B + 1>(p0, p1)); tw[1] = cvt_pk_bf16_n(pget<B + 2>(p0, p1), pget<B + 3>(p0, p1));
    tw[2] = cvt_pk_bf16_n(pget<B + 4>(p0, p1), pget<B + 5>(p0, p1)); tw[3] = cvt_pk_bf16_n(pget<B + 6>(p0, p1), pget<B + 7>(p0, p1)); }
__device__ __forceinline__ bf16x8 fperm(const unsigned (&tw)[4]) {
    const auto r0 = __builtin_amdgcn_permlane32_swap(tw[0], tw[2], false, false); const auto r1 = __builtin_amdgcn_permlane32_swap(tw[1], tw[3], false, false);
    const u32x4 w = {r0[0], r1[0], r0[1], r1[1]}; return __builtin_bit_cast(bf16x8, w); }
template <int G> __device__ __forceinline__ void fin_gap(f32x16& p0, f32x16& p1, float& psA, float& psB, unsigned (&tw)[4], bf16x8 (&pa)[4], float& l_reg, float alO) {
    if constexpr (G == 0) { fexp<8>(p0, p1); fexp<9>(p0, p1); psA = pget<0>(p0, p1) + pget<1>(p0, p1); }
    if constexpr (G == 1) { fexp<10>(p0, p1); fexp<11>(p0, p1); fadd<2>(p0, p1, psA, psB); fadd<3>(p0, p1, psA, psB); }
    if constexpr (G == 2) { fexp<12>(p0, p1); fexp<13>(p0, p1); fadd<4>(p0, p1, psA, psB); fadd<5>(p0, p1, psA, psB); }
    if constexpr (G == 3) { fexp<14>(p0, p1); fexp<15>(p0, p1); fadd<6>(p0, p1, psA, psB); fadd<7>(p0, p1, psA, psB); }
    if constexpr (G == 4) { fcvt<0>(p0, p1, tw); fadd<8>(p0, p1, psA, psB); }
    if constexpr (G == 5) { pa[0] = fperm(tw); fexp<16>(p0, p1); fadd<9>(p0, p1, psA, psB); fadd<10>(p0, p1, psA, psB); }
    if constexpr (G == 6) { fexp<17>(p0, p1); fexp<18>(p0, p1); fadd<11>(p0, p1, psA, psB); fadd<12>(p0, p1, psA, psB); }
    if constexpr (G == 7) { fexp<19>(p0, p1); fexp<20>(p0, p1); fadd<13>(p0, p1, psA, psB); fadd<14>(p0, p1, psA, psB); }
    if constexpr (G == 8) { fcvt<8>(p0, p1, tw); fadd<15>(p0, p1, psA, psB); }
    if constexpr (G == 9) { pa[1] = fperm(tw); fexp<21>(p0, p1); psB = pget<16>(p0, p1) + pget<17>(p0, p1); }
    if constexpr (G == 10) { fexp<22>(p0, p1); fexp<23>(p0, p1); fadd<18>(p0, p1, psA, psB); fadd<19>(p0, p1, psA, psB); }
    if constexpr (G == 11) { fexp<24>(p0, p1); fexp<25>(p0, p1); fadd<20>(p0, p1, psA, psB); fadd<21>(p0, p1, psA, psB); }
    if constexpr (G == 12) { fcvt<16>(p0, p1, tw); fadd<22>(p0, p1, psA, psB); }
    if constexpr (G == 13) { pa[2] = fperm(tw); fexp<26>(p0, p1); fadd<23>(p0, p1, psA, psB); fadd<24>(p0, p1, psA, psB); }
    if constexpr (G == 14) { fexp<27>(p0, p1); fexp<28>(p0, p1); fadd<25>(p0, p1, psA, psB); fadd<26>(p0, p1, psA, psB); }
    if constexpr (G == 15) { fexp<29>(p0, p1); fexp<30>(p0, p1); fadd<27>(p0, p1, psA, psB); fadd<28>(p0, p1, psA, psB); }
    if constexpr (G == 16) { fexp<31>(p0, p1); fadd<29>(p0, p1, psA, psB); fadd<30>(p0, p1, psA, psB); }
    if constexpr (G == 17) { fadd<31>(p0, p1, psA, psB); fcvt<24>(p0, p1, tw); }
    if constexpr (G == 18) { pa[3] = fperm(tw); psA += psB; }
    if constexpr (G == 19) { const auto rr = __builtin_amdgcn_permlane32_swap(__float_as_uint(psA), __float_as_uint(psA), false, false);
                             l_reg = l_reg * alO + (__uint_as_float(rr[0]) + __uint_as_float(rr[1])); }
}
template <int G> __device__ __forceinline__ void par_gap(f32x16& n0, f32x16& n1, float& mA, float& mB, float& m_reg, float& alN, float& mnC) {
#define MX3(a, b, c) fmaxf(fmaxf(a, b), c)
#define NV(I) pget<I>(n0, n1)
    if constexpr (G == 0) { mA = MX3(NV(0), NV(1), NV(2)); mB = MX3(NV(16), NV(17), NV(18)); mA = MX3(mA, NV(3), NV(4)); mB = MX3(mB, NV(19), NV(20)); }
    if constexpr (G == 1) { mA = MX3(mA, NV(5), NV(6)); mB = MX3(mB, NV(21), NV(22)); mA = MX3(mA, NV(7), NV(8)); mB = MX3(mB, NV(23), NV(24)); }
    if constexpr (G == 2) { mA = MX3(mA, NV(9), NV(10)); mB = MX3(mB, NV(25), NV(26)); mA = MX3(mA, NV(11), NV(12)); mB = MX3(mB, NV(27), NV(28)); }
    if constexpr (G == 3) { mA = MX3(mA, NV(13), NV(14)); mB = MX3(mB, NV(29), NV(30)); mA = MX3(mA, NV(15), NV(31)); mA = fmaxf(mA, mB); }
    if constexpr (G == 4) { const auto rr = __builtin_amdgcn_permlane32_swap(__float_as_uint(mA), __float_as_uint(mA), false, false);
                            const float pmax = fmaxf(__uint_as_float(rr[0]), __uint_as_float(rr[1]));
                            const bool keep = __all(pmax - m_reg <= THR / SCALE); mB = keep ? m_reg : fmaxf(m_reg, pmax); }
    if constexpr (G == 5) { alN = __builtin_amdgcn_exp2f((m_reg - mB) * CL); m_reg = mB; mnC = -mB * CL; }
    if constexpr (G >= 6 && G <= 13) { constexpr int k = G - 6;
        pset<4 * k>(n0, n1, fmaf(NV(4 * k), CL, mnC)); pset<4 * k + 1>(n0, n1, fmaf(NV(4 * k + 1), CL, mnC));
        pset<4 * k + 2>(n0, n1, fmaf(NV(4 * k + 2), CL, mnC)); pset<4 * k + 3>(n0, n1, fmaf(NV(4 * k + 3), CL, mnC));
        fexp<k>(n0, n1); }
#undef MX3
#undef NV
}
template <int G> __device__ __forceinline__ bf16x8 kfrag(const LAS unsigned char* lds, const int (&kb)[4]) {
    constexpr int d0 = G >> 1, h = G & 1;
    return *(const LAS bf16x8*)(lds + kb[d0 & 3] + (d0 >> 2) * 128 + h * 12288);
}
template <int I> __device__ __forceinline__ bf16x8 vfrag(const LAS unsigned char* lds, int vb) {
    constexpr int d0 = I >> 2, ks = I & 3;
    const s16x4 l = __builtin_amdgcn_ds_read_tr16_b64_v4i16((LAS s16x4*)(lds + vb + v_rd_off(d0, ks, 0)));
    const s16x4 h = __builtin_amdgcn_ds_read_tr16_b64_v4i16((LAS s16x4*)(lds + vb + v_rd_off(d0, ks, 1)));
    return (bf16x8){l[0], l[1], l[2], l[3], h[0], h[1], h[2], h[3]};
}
struct VF { s16x4 l, h; };
template <int I> __device__ __forceinline__ void vfrag_asm(VF& f, int vaddr) {
    constexpr int d0 = I >> 2, ks = I & 3;
    asm volatile("ds_read_b64_tr_b16 %0, %1 offset:%2" : "=v"(f.l) : "v"(vaddr), "i"(v_rd_off(d0, ks, 0)) : "memory");
    asm volatile("ds_read_b64_tr_b16 %0, %1 offset:%2" : "=v"(f.h) : "v"(vaddr), "i"(v_rd_off(d0, ks, 1)) : "memory");
}
template <int N> __device__ __forceinline__ bf16x8 vwait(VF& f) { asm volatile("s_waitcnt lgkmcnt(%2)" : "+v"(f.l), "+v"(f.h) : "i"(N)); return (bf16x8){f.l[0], f.l[1], f.l[2], f.l[3], f.h[0], f.h[1], f.h[2], f.h[3]}; }
constexpr int seg2_maxissued(int i) { return i == 0 ? 1 : ((((i - 1) & ~1) == 0) ? 5 : ((((i - 1) & ~1) <= 10) ? ((i - 1) & ~1) + 5 : 15)); }
struct Dma { const char* Kg; const char* Vg; unsigned ko0, ko1, ko2, vo; int wid; };
__device__ __forceinline__ void dma_k(LAS unsigned char* lds, const Dma& d, int t, int so) {
    const unsigned kt = (unsigned)t * KTB;
    LAS unsigned char* kd = lds + so + d.wid * 3072;
    __builtin_amdgcn_global_load_lds((const unsigned*)(d.Kg + (d.ko0 + kt)), (LAS unsigned*)(kd), 16, 0, 0);
    __builtin_amdgcn_global_load_lds((const unsigned*)(d.Kg + (d.ko1 + kt)), (LAS unsigned*)(kd + 1024), 16, 0, 0);
    __builtin_amdgcn_global_load_lds((const unsigned*)(d.Kg + (d.ko2 + kt)), (LAS unsigned*)(kd + 2048), 16, 0, 0);
}
__device__ __forceinline__ void dma_v(LAS unsigned char* lds, const Dma& d, int t, int so) {
    const unsigned vt = (unsigned)t * VTB;
    LAS unsigned char* vd = lds + so + d.wid * 2048;
    __builtin_amdgcn_global_load_lds((const unsigned*)(d.Vg + (d.vo + vt)), (LAS unsigned*)(vd), 16, 0, 0);
    __builtin_amdgcn_global_load_lds((const unsigned*)(d.Vg + (d.vo + vt + 128u)), (LAS unsigned*)(vd + 1024), 16, 0, 0);
}
struct DmaIt { unsigned kt, vt; int soK, soV; };
template <int PIECE> __device__ __forceinline__ void dma_piece(LAS unsigned char* lds, const Dma& d, const DmaIt& it) {
    if constexpr (PIECE < 3) { LAS unsigned char* kd = lds + it.soK + d.wid * 3072 + PIECE * 1024; const unsigned ko = PIECE == 0 ? d.ko0 : PIECE == 1 ? d.ko1 : d.ko2;
        __builtin_amdgcn_global_load_lds((const unsigned*)(d.Kg + (ko + it.kt)), (LAS unsigned*)(kd), 16, 0, 0); }
    else { LAS unsigned char* vd = lds + it.soV + d.wid * 2048 + (PIECE - 3) * 1024;
        __builtin_amdgcn_global_load_lds((const unsigned*)(d.Vg + (d.vo + it.vt + (PIECE - 3) * 128u)), (LAS unsigned*)(vd), 16, 0, 0); }
}
#define PIN2(a, b) asm volatile("" : "+v"(a), "+v"(b))
template <int G, int DM> __device__ __forceinline__ void seg1_gaps(LAS unsigned char* lds, const Dma& dm, const DmaIt& dit, const int (&kb)[4], int vb, const bf16x8 (&qr)[12], f32x16& pN0, f32x16& pN1, f32x16& pO0, f32x16& pO1,
                                                           bf16x8& f0, bf16x8& f1, bf16x8& f2, bf16x8& f3, VF& v0, VF& v1, float& psA, float& psB, unsigned (&tw)[4], bf16x8 (&pa)[4], float& l_reg, float alO) {
    if constexpr (G < 24) {
        bf16x8& fc = (G & 3) == 0 ? f0 : (G & 3) == 1 ? f1 : (G & 3) == 2 ? f2 : f3;
        if constexpr ((G & 1) == 0) { if constexpr (G < 2) pN0 = __builtin_amdgcn_mfma_f32_32x32x16_bf16(fc, qr[G >> 1], f32x16{}, 0, 0, 0); else pN0 = __builtin_amdgcn_mfma_f32_32x32x16_bf16(fc, qr[G >> 1], pN0, 0, 0, 0); }
        else { if constexpr (G < 2) pN1 = __builtin_amdgcn_mfma_f32_32x32x16_bf16(fc, qr[G >> 1], f32x16{}, 0, 0, 0); else pN1 = __builtin_amdgcn_mfma_f32_32x32x16_bf16(fc, qr[G >> 1], pN1, 0, 0, 0); }
        if constexpr ((G & 1) == 0) {
            bf16x8& fa = ((G + 2) & 3) == 0 ? f0 : f2; bf16x8& fb = ((G + 2) & 3) == 0 ? f1 : f3;
            if constexpr (G + 3 < 24) { fa = kfrag<G + 2>(lds, kb); fb = kfrag<G + 3>(lds, kb); }
            else { vfrag_asm<0>(v0, vb); vfrag_asm<1>(v1, vb); }
        }
        if constexpr (G == 3 && (DM & 1)) dma_piece<0>(lds, dm, dit);
        if constexpr (G == 7 && (DM & 1)) dma_piece<1>(lds, dm, dit);
        if constexpr (G == 11 && (DM & 1)) dma_piece<2>(lds, dm, dit);
        if constexpr (G == 15 && (DM & 2)) dma_piece<3>(lds, dm, dit);
        if constexpr (G == 19 && (DM & 2)) dma_piece<4>(lds, dm, dit);
        fin_gap<G>(pO0, pO1, psA, psB, tw, pa, l_reg, alO);
        PIN2(pO0, pO1);
        SB2();
        seg1_gaps<G + 1, DM>(lds, dm, dit, kb, vb, qr, pN0, pN1, pO0, pO1, f0, f1, f2, f3, v0, v1, psA, psB, tw, pa, l_reg, alO);
    }
}
template <int I> __device__ __forceinline__ void seg2_gaps(int vb, f32x16 (&o)[4], const bf16x8 (&pa)[4], f32x16& pN0, f32x16& pN1,
                                                           VF& f0, VF& f1, VF& f2, VF& f3, VF& f4, VF& f5, float& mA, float& mB, float& m_reg, float& alN, float& mnC) {
    if constexpr (I < 16) {
        VF& fc = (I % 6) == 0 ? f0 : (I % 6) == 1 ? f1 : (I % 6) == 2 ? f2 : (I % 6) == 3 ? f3 : (I % 6) == 4 ? f4 : f5;
        const bf16x8 bv = vwait<2 * (seg2_maxissued(I) - I)>(fc);
        o[I >> 2] = __builtin_amdgcn_mfma_f32_32x32x16_bf16(pa[I & 3], bv, o[I >> 2], 0, 0, 0);
        if constexpr (I == 0) { vfrag_asm<2>(f2, vb); vfrag_asm<3>(f3, vb); vfrag_asm<4>(f4, vb); vfrag_asm<5>(f5, vb); }
        else if constexpr ((I & 1) == 0 && I + 5 < 16) {
            VF& fa = ((I + 4) % 6) == 0 ? f0 : ((I + 4) % 6) == 2 ? f2 : f4; VF& fb = ((I + 4) % 6) == 0 ? f1 : ((I + 4) % 6) == 2 ? f3 : f5;
            vfrag_asm<I + 4>(fa, vb); vfrag_asm<I + 5>(fb, vb);
        }
        par_gap<I>(pN0, pN1, mA, mB, m_reg, alN, mnC);
        PIN2(pN0, pN1);
        SB2();
        seg2_gaps<I + 1>(vb, o, pa, pN0, pN1, f0, f1, f2, f3, f4, f5, mA, mB, m_reg, alN, mnC);
    }
}
__device__ __forceinline__ void attn_unit(const bf16_t* __restrict__ Qb, const bf16_t* __restrict__ Kh, const bf16_t* __restrict__ Vh, bf16_t* __restrict__ Ob, LAS unsigned char* lds) {
    int tid_o = threadIdx.x; asm volatile("" : "+v"(tid_o));
    const int tid = tid_o, wid = __builtin_amdgcn_readfirstlane(tid >> 6), lane = tid & 63, r32 = lane & 31, hi = lane >> 5;
    LAS float* scr = (LAS float*)(lds + OFF_SCR) + wid * 64; LAS float* li_l = scr; LAS float* al_l = scr + 32;
    const int kbase = r32 * 384 + ((hi ^ ((r32 >> 1) & 7)) << 4);
    const int vbase = v_rd_base(lane);
    Dma dm; dm.Kg = (const char*)Kh; dm.Vg = (const char*)Vh; dm.wid = wid;
    { unsigned ko[3];
#pragma unroll
      for (int i = 0; i < 3; ++i) { const int L = (3 * wid + i) * 1024 + lane * 16, r = L / 384, cp = (L - r * 384) >> 4, c = (cp & ~7) | ((cp ^ (r >> 1)) & 7); ko[i] = (unsigned)(r * 384 + c * 16); }
      dm.ko0 = ko[0]; dm.ko1 = ko[1]; dm.ko2 = ko[2];
      const int L = (2 * wid) * 1024 + lane * 16, blk = L >> 9, wv = L & 511, kk = (blk >> 2) * 8 + (wv >> 6), c = (blk & 3) * 32 + ((wv & 63) >> 1);
      const int k = (kk & ~0xC) | ((kk & 4) << 1) | ((kk & 8) >> 1); dm.vo = (unsigned)(k * 256 + c * 2); }
    dma_k(lds, dm, 0, 0); dma_k(lds, dm, 1, KTB); dma_k(lds, dm, 2, 2 * KTB); dma_k(lds, dm, 3, 3 * KTB); dma_v(lds, dm, 0, VRING); dma_v(lds, dm, 1, VRING + VTB);
    float m_reg = -1e30f, l_reg = 0.f; f32x16 o[4] = {}; bf16x8 qr[12];
    { const bf16_t* Qw = Qb + (size_t)(wid * QBLK + r32) * DQK + hi * 8;
#pragma unroll
      for (int d0 = 0; d0 < 12; ++d0) qr[d0] = *reinterpret_cast<const bf16x8*>(Qw + d0 * 16); }
    asm volatile("s_waitcnt vmcnt(0)" ::: "memory"); __builtin_amdgcn_s_barrier(); SB2();
    f32x16 pA0, pA1, pB0, pB1; float alA = 1.f, alB = 1.f, mA, mB, mnC, psA, psB; unsigned tw[4]; bf16x8 pa[4], f0, f1, f2, f3; VF vf0, vf1, vf2, vf3, vf4, vf5;
    int kb[4];
#define KB_SET(so) do { kb[0] = kbase + (so); asm volatile("" : "+v"(kb[0])); kb[1] = kb[0] ^ 32; kb[2] = kb[0] ^ 64; kb[3] = kb[0] ^ 96; } while (0)
    KB_SET(0);
    pA0 = f32x16{}; pA1 = f32x16{};
#pragma unroll
    for (int d0 = 0; d0 < 12; ++d0) { const bf16x8 b0 = *(const LAS bf16x8*)(lds + kb[d0 & 3] + (d0 >> 2) * 128), b1 = *(const LAS bf16x8*)(lds + kb[d0 & 3] + (d0 >> 2) * 128 + 12288);
        pA0 = __builtin_amdgcn_mfma_f32_32x32x16_bf16(b0, qr[d0], pA0, 0, 0, 0); pA1 = __builtin_amdgcn_mfma_f32_32x32x16_bf16(b1, qr[d0], pA1, 0, 0, 0); }
    par_gap<0>(pA0, pA1, mA, mB, m_reg, alA, mnC); par_gap<1>(pA0, pA1, mA, mB, m_reg, alA, mnC); par_gap<2>(pA0, pA1, mA, mB, m_reg, alA, mnC); par_gap<3>(pA0, pA1, mA, mB, m_reg, alA, mnC);
    par_gap<4>(pA0, pA1, mA, mB, m_reg, alA, mnC); par_gap<5>(pA0, pA1, mA, mB, m_reg, alA, mnC); par_gap<6>(pA0, pA1, mA, mB, m_reg, alA, mnC); par_gap<7>(pA0, pA1, mA, mB, m_reg, alA, mnC);
    par_gap<8>(pA0, pA1, mA, mB, m_reg, alA, mnC); par_gap<9>(pA0, pA1, mA, mB, m_reg, alA, mnC); par_gap<10>(pA0, pA1, mA, mB, m_reg, alA, mnC); par_gap<11>(pA0, pA1, mA, mB, m_reg, alA, mnC);
    par_gap<12>(pA0, pA1, mA, mB, m_reg, alA, mnC); par_gap<13>(pA0, pA1, mA, mB, m_reg, alA, mnC);
    alA = 1.f;
    __builtin_amdgcn_s_barrier(); SB2();
    int sV = VRING, sD = VRING + 2 * VTB, sVn = VRING + VTB;
    KB_SET(KTB); f0 = kfrag<0>(lds, kb); f1 = kfrag<1>(lds, kb);
#define RESC2(a) do { if (__any((a) < 1.f)) { if (hi == 0) al_l[r32] = (a); asm volatile("s_waitcnt lgkmcnt(0)" ::: "memory"); \
    _Pragma("unroll") for (int d = 0; d < 4; ++d) _Pragma("unroll") for (int r = 0; r < 16; ++r) o[d][r] *= al_l[crow(r, hi)]; } } while (0)
#define ITER2(pO0, pO1, alO, pN0, pN1, alN, t_, DO_DMA, VMW, PRE) do { \
        int vb_ = vbase + sV + (int)(unsigned long)lds; asm volatile("" : "+v"(vb_)); \
        const DmaIt dit_ = {(unsigned)((t_) + 4) * KTB, (unsigned)((t_) + 2) * VTB, ((t_) & 3) * KTB, sD}; \
        SB2(); \
        seg1_gaps<0, DO_DMA>(lds, dm, dit_, kb, vb_, qr, pN0, pN1, pO0, pO1, f0, f1, f2, f3, vf0, vf1, psA, psB, tw, pa, l_reg, alO); \
        seg2_gaps<0>(vb_, o, pa, pN0, pN1, vf0, vf1, vf2, vf3, vf4, vf5, mA, mB, m_reg, alN, mnC); \
        if (PRE) { KB_SET((((t_) + 2) & 3) * KTB); f0 = kfrag<0>(lds, kb); f1 = kfrag<1>(lds, kb); }        \
        RESC2(alN); \
        asm volatile("s_waitcnt vmcnt(" #VMW ")" ::: "memory"); __builtin_amdgcn_s_barrier(); SB2(); \
        { const int t3_ = sV; sV = sVn; sVn = sD; sD = t3_; } } while (0)
    for (int t = 0; t < NT - 4; t += 2) {
        ITER2(pA0, pA1, alA, pB0, pB1, alB, t, 3, 5, true);
        ITER2(pB0, pB1, alB, pA0, pA1, alA, t + 1, 3, 5, true);
    }
    ITER2(pA0, pA1, alA, pB0, pB1, alB, NT - 4, 2, 2, true);
    ITER2(pB0, pB1, alB, pA0, pA1, alA, NT - 3, 2, 2, true);
    ITER2(pA0, pA1, alA, pB0, pB1, alB, NT - 2, 0, 0, false);
    { int vb_ = vbase + sV; asm volatile("" : "+v"(vb_));
      fin_gap<0>(pB0, pB1, psA, psB, tw, pa, l_reg, alB); fin_gap<1>(pB0, pB1, psA, psB, tw, pa, l_reg, alB); fin_gap<2>(pB0, pB1, psA, psB, tw, pa, l_reg, alB); fin_gap<3>(pB0, pB1, psA, psB, tw, pa, l_reg, alB);
      fin_gap<4>(pB0, pB1, psA, psB, tw, pa, l_reg, alB); fin_gap<5>(pB0, pB1, psA, psB, tw, pa, l_reg, alB); fin_gap<6>(pB0, pB1, psA, psB, tw, pa, l_reg, alB); fin_gap<7>(pB0, pB1, psA, psB, tw, pa, l_reg, alB);
      fin_gap<8>(pB0, pB1, psA, psB, tw, pa, l_reg, alB); fin_gap<9>(pB0, pB1, psA, psB, tw, pa, l_reg, alB); fin_gap<10>(pB0, pB1, psA, psB, tw, pa, l_reg, alB); fin_gap<11>(pB0, pB1, psA, psB, tw, pa, l_reg, alB);
      fin_gap<12>(pB0, pB1, psA, psB, tw, pa, l_reg, alB); fin_gap<13>(pB0, pB1, psA, psB, tw, pa, l_reg, alB); fin_gap<14>(pB0, pB1, psA, psB, tw, pa, l_reg, alB); fin_gap<15>(pB0, pB1, psA, psB, tw, pa, l_reg, alB);
      fin_gap<16>(pB0, pB1, psA, psB, tw, pa, l_reg, alB); fin_gap<17>(pB0, pB1, psA, psB, tw, pa, l_reg, alB); fin_gap<18>(pB0, pB1, psA, psB, tw, pa, l_reg, alB); fin_gap<19>(pB0, pB1, psA, psB, tw, pa, l_reg, alB);
#pragma unroll
      for (int d0 = 0; d0 < 4; ++d0) {
          const bf16x8 v0 = d0 == 0 ? vfrag<0>(lds, vb_) : d0 == 1 ? vfrag<4>(lds, vb_) : d0 == 2 ? vfrag<8>(lds, vb_) : vfrag<12>(lds, vb_);
          const bf16x8 v1 = d0 == 0 ? vfrag<1>(lds, vb_) : d0 == 1 ? vfrag<5>(lds, vb_) : d0 == 2 ? vfrag<9>(lds, vb_) : vfrag<13>(lds, vb_);
          const bf16x8 v2 = d0 == 0 ? vfrag<2>(lds, vb_) : d0 == 1 ? vfrag<6>(lds, vb_) : d0 == 2 ? vfrag<10>(lds, vb_) : vfrag<14>(lds, vb_);
          const bf16x8 v3 = d0 == 0 ? vfrag<3>(lds, vb_) : d0 == 1 ? vfrag<7>(lds, vb_) : d0 == 2 ? vfrag<11>(lds, vb_) : vfrag<15>(lds, vb_);
          o[d0] = __builtin_amdgcn_mfma_f32_32x32x16_bf16(pa[0], v0, o[d0], 0, 0, 0); o[d0] = __builtin_amdgcn_mfma_f32_32x32x16_bf16(pa[1], v1, o[d0], 0, 0, 0);
          o[d0] = __builtin_amdgcn_mfma_f32_32x32x16_bf16(pa[2], v2, o[d0], 0, 0, 0); o[d0] = __builtin_amdgcn_mfma_f32_32x32x16_bf16(pa[3], v3, o[d0], 0, 0, 0); } }
    if (hi == 0) li_l[r32] = l_reg;
    asm volatile("s_waitcnt lgkmcnt(0)" ::: "memory");
    float rli[16];
#pragma unroll
    for (int r = 0; r < 16; ++r) rli[r] = __builtin_amdgcn_rcpf(li_l[crow(r, hi)]);
    { LAS unsigned char* ost = lds + wid * 8192;
#pragma unroll
      for (int r = 0; r < 16; ++r) { const int orow = crow(r, hi);
#pragma unroll
          for (int d0 = 0; d0 < 4; ++d0) *(LAS unsigned short*)(ost + orow * 256 + (d0 * 32 + r32) * 2) = (unsigned short)(cvt_pk_bf16_n(o[d0][r] * rli[r], 0.f) & 0xffffu); }
      asm volatile("s_waitcnt lgkmcnt(0)" ::: "memory");
      bf16_t* Ow = Ob + (size_t)(wid * QBLK) * 1024;
#pragma unroll
      for (int j = 0; j < 8; ++j) { const int row = j * 4 + (lane >> 4); const u32x4 vv = *(const LAS u32x4*)(ost + row * 256 + (lane & 15) * 16);
          *(u32x4*)(Ow + (size_t)row * 1024 + (lane & 15) * 8) = vv; } }
#undef KB_SET
#undef RESC2
#undef ITER2
}
#undef SB2
}

__device__ __forceinline__ void transpose_item(const float* W, int ldw, int k0, int n0, bf16_t* dst, int ldd, const float* kscale, LAS float* scr, int lane) {
    float tv[32];
#pragma unroll
    for (int i = 0; i < 32; ++i) { const int kk = 2 * i + (lane >> 5); tv[i] = W[(size_t)(k0 + kk) * ldw + n0 + (lane & 31)]; }
#pragma unroll
    for (int i = 0; i < 32; ++i) { const int kk = 2 * i + (lane >> 5); float v = tv[i]; if (kscale) v *= kscale[k0 + kk]; scr[kk * 33 + (lane & 31)] = v; }
    LDS_WAIT(); asm volatile("" ::: "memory");
    const int c = lane & 7;
#pragma unroll
    for (int j = 0; j < 4; ++j) { const int n = (lane >> 3) + 8 * j; const LAS float* s = scr + (8 * c) * 33 + n;
        u32x4 o; o.x = cvt_pk_bf16(s[0 * 33], s[1 * 33]); o.y = cvt_pk_bf16(s[2 * 33], s[3 * 33]); o.z = cvt_pk_bf16(s[4 * 33], s[5 * 33]); o.w = cvt_pk_bf16(s[6 * 33], s[7 * 33]);
        *(u32x4*)(dst + (size_t)n * ldd + 8 * c) = o; }
    LDS_WAIT(); asm volatile("" ::: "memory");
}

__device__ __forceinline__ void ph_mod_and_weights(KP p, LAS unsigned char* lds) {
    const int tid = threadIdx.x, lane = tid & 63, wave = tid >> 6;
    unsigned char* ws = p.ws;
    float* mod = (float*)(ws + WS_MOD);
    {
        LAS float* sc = (LAS float*)lds;
        LAS float* red = (LAS float*)(lds + 20480);
        if ((int)blockIdx.x < 192) {
            for (int i = tid; i < 5 * 1024; i += NTHREADS) { const int j = i >> 10, k = i & 1023; const float v = j < 4 ? p.in[I_C][j * 1024 + k] : p.in[I_CCTX][k]; sc[i] = v * sigmoidf_(v); }
            __syncthreads();
            for (int unit = blockIdx.x; unit < 192; unit += gridDim.x) {
                const int c32 = tid & 31, kg = tid >> 5, col = unit * 32 + c32;
                float a0 = 0, a1 = 0, a2 = 0, a3 = 0, a4 = 0;
                const float* wp = p.in[I_WADA] + (size_t)(kg * 64) * 6144 + col;
#pragma unroll 8
                for (int kk = 0; kk < 64; ++kk) { const float w = wp[(size_t)kk * 6144]; const int k = kg * 64 + kk;
                    a0 += sc[k] * w; a1 += sc[1024 + k] * w; a2 += sc[2048 + k] * w; a3 += sc[3072 + k] * w; a4 += sc[4096 + k] * w; }
                LAS float* rp = red + (kg * 32 + c32) * 5; rp[0] = a0; rp[1] = a1; rp[2] = a2; rp[3] = a3; rp[4] = a4;
                __syncthreads();
                if (tid < 160) { const int cc = tid & 31, j = tid >> 5; float s = p.in[I_BADA][unit * 32 + cc];
                    for (int g = 0; g < 16; ++g) s += red[(g * 32 + cc) * 5 + j];
                    mod[j * 6144 + unit * 32 + cc] = s; }
                __syncthreads();
            }
        }
    }
    __syncthreads();
    {
        LAS float* scr = (LAS float*)(lds + wave * 8448);
        const int gw = blockIdx.x * NWAVES + wave, NGW = gridDim.x * NWAVES;
        bf16_t* WIN = (bf16_t*)(ws + WS_WIN); bf16_t* WLO = (bf16_t*)(ws + WS_WLORA); bf16_t* WUQ = (bf16_t*)(ws + WS_WUQ); bf16_t* WUKV = (bf16_t*)(ws + WS_WUKV); bf16_t* WOUT = (bf16_t*)(ws + WS_WOUT);
        constexpr int I_IN = 16 * 78, I_L = 16, I_G = 32, I_Q = 4 * 24, I_KV = 4 * 16, I_O = 16 * 32;
        constexpr int NITEMS = I_IN + 4 * I_L + I_G + I_Q + 2 * I_KV + I_O;
        for (int it = gw; it < NITEMS; it += NGW) {
            int r = it;
            if (r < I_IN) { const int kb = r / 78, nb = r % 78; transpose_item(p.in[I_WIN], IN_PROJ, kb * 64, nb * 32, WIN + (size_t)(nb * 32) * 1024 + kb * 64, 1024, nullptr, scr, lane); continue; } r -= I_IN;
            if (r < 2 * I_L) { const int d = r / 16, nb = r % 16; transpose_item(p.in[I_WUP] + (size_t)d * 64 * 512, 512, 0, nb * 32, WLO + (size_t)(d * 512 + nb * 32) * 128 + d * 64, 128, nullptr, scr, lane); continue; } r -= 2 * I_L;
            if (r < 2 * I_L) { const int d = r / 16, nb = r % 16; transpose_item(p.in[I_AUP] + (size_t)d * 64 * 512, 512, 0, nb * 32, WLO + (size_t)(1024 + d * 512 + nb * 32) * 128 + d * 64, 128, nullptr, scr, lane); continue; } r -= 2 * I_L;
            if (r < I_G) { const int kb = r / 16, nb = r % 16; transpose_item(p.in[I_GUP], 512, kb * 64, nb * 32, WLO + (size_t)(2048 + nb * 32) * 128 + kb * 64, 128, nullptr, scr, lane); continue; } r -= I_G;
            if (r < I_Q) { const int kb = r / 24, nb = r % 24; transpose_item(p.in[I_WUQ], 768, kb * 64, nb * 32, WUQ + (size_t)(nb * 32) * 256 + kb * 64, 256, p.in[I_QNORM], scr, lane); continue; } r -= I_Q;
            if (r < I_KV) { const int kb = r / 16, nb = r % 16; transpose_item(p.in[I_WUK], 512, kb * 64, nb * 32, WUKV + (size_t)(nb * 32) * 256 + kb * 64, 256, p.in[I_KVNORM], scr, lane); continue; } r -= I_KV;
            if (r < I_KV) { const int kb = r / 16, nb = r % 16; transpose_item(p.in[I_WUV], 512, kb * 64, nb * 32, WUKV + (size_t)(512 + nb * 32) * 256 + kb * 64, 256, p.in[I_KVNORM], scr, lane); continue; } r -= I_KV;
            { const int kb = r / 32, nb = r % 32; transpose_item(p.in[I_WOUT], 1024, kb * 64, nb * 32, WOUT + (size_t)(nb * 32) * 1024 + kb * 64, 1024, nullptr, scr, lane); }
        }
        const long gt = (long)blockIdx.x * NTHREADS + tid, gs = (long)gridDim.x * NTHREADS;
        const u32x4 z = {0u, 0u, 0u, 0u};
        for (long i = gt; i < 64 * 128; i += gs) *(u32x4*)(WIN + (size_t)IN_PROJ * 1024 + i * 8) = z;
        for (long i = gt; i < 2048 * 8; i += gs) { const int row = (int)(i >> 3), ch = (int)(i & 7), d = (row >> 9) & 1;
            *(u32x4*)(WLO + (size_t)row * 128 + (1 - d) * 64 + ch * 8) = z; }
    }
}

__device__ __forceinline__ void ph_modulate1(KP p) {
    const int tid = threadIdx.x, lane = tid & 63, wave = tid >> 6;
    const float* mod = (const float*)(p.ws + WS_MOD); bf16_t* XM = (bf16_t*)(p.ws + WS_XM);
    const int gw = blockIdx.x * NWAVES + wave, NGW = gridDim.x * NWAVES;
    ER(1) for (int row = gw; row < MA; row += NGW) {
        const float* xr; int j;
        if (row < ML) { xr = p.in[I_X] + (size_t)row * D; j = row >> 13; } else { xr = p.in[I_CTX] + (size_t)(row - ML) * D; j = 4; }
        const float* sh = mod + j * 6144, * sc = sh + 1024;
        f32x4 v[4]; float s = 0.f;
#pragma unroll
        for (int q = 0; q < 4; ++q) { v[q] = *(const f32x4*)(xr + q * 256 + lane * 4); s += (v[q].x + v[q].y) + (v[q].z + v[q].w); }
        const float mean = wave_sum(s) * (1.f / D); float s2 = 0.f;
#pragma unroll
        for (int q = 0; q < 4; ++q) { v[q] = v[q] - mean; s2 += (v[q].x * v[q].x + v[q].y * v[q].y) + (v[q].z * v[q].z + v[q].w * v[q].w); }
        const float rstd = 1.0f / sqrtf(wave_sum(s2) * (1.f / D) + LN_EPS);
#pragma unroll
        for (int q = 0; q < 4; ++q) { const int c = q * 256 + lane * 4; const f32x4 a = *(const f32x4*)(sc + c), bsh = *(const f32x4*)(sh + c);
            const f32x4 y = v[q] * rstd * (a + 1.0f) + bsh;
            u32x2 w; w.x = cvt_pk_bf16(y.x, y.y); w.y = cvt_pk_bf16(y.z, y.w); *(u32x2*)(XM + (size_t)row * D + c) = w; }
    }
}

__device__ __forceinline__ void ph_prepare(KP p) {
    const int tid = threadIdx.x, lane = tid & 63, wave = tid >> 6;
    unsigned char* ws = p.ws;
    const bf16_t* H = (const bf16_t*)(ws + WS_H); _Float16* RKV = (_Float16*)(ws + WS_RKV); bf16_t* ACT = (bf16_t*)(ws + WS_ACT);
    float* rq = (float*)(ws + WS_RSTDQ); float* rkv = (float*)(ws + WS_RSTDKV); bf16_t* Kb = (bf16_t*)(ws + WS_K);
    const float* cw = p.in[I_CONV]; float* rnp = (float*)(ws + WS_RN);
    const int gw = blockIdx.x * NWAVES + wave, NGW = gridDim.x * NWAVES;
    constexpr int STRIP = 17, NSTRIP = (MA + STRIP - 1) / STRIP;
    const u32x4 z4 = {0u, 0u, 0u, 0u};
    ER(3) for (int strip = gw; strip < NSTRIP; strip += NGW) {
        const int r0 = strip * STRIP, r1 = (r0 + STRIP < MA) ? r0 + STRIP : MA;
        u32x4 prv[3], cur[3], nxt[3]; u32x4 lx = z4; u32x2 qa, qc; unsigned short k1 = 0, k2 = 0;
#define PREP_LOADROW(dst, row_) do { const bf16_t* hp_ = H + (size_t)(row_) * NHP; _Pragma("unroll") for (int q = 0; q < 3; ++q) dst[q] = *(const u32x4*)(hp_ + q * 512 + lane * 8); } while (0)
#define PREP_LOADAUX(row_) do { const bf16_t* hp_ = H + (size_t)(row_) * NHP; if (lane < 48) lx = *(const u32x4*)(hp_ + 1536 + lane * 8); qa = *(const u32x2*)(hp_ + 1920 + lane * 4); qc = *(const u32x2*)(hp_ + 2176 + lane * 4); \
        if (lane < 32) { const int g_ = (lane >> 4) & 1, jj_ = lane & 15; k1 = hp_[2432 + g_ * 32 + jj_]; k2 = hp_[2432 + g_ * 32 + 16 + jj_]; } } while (0)
        PREP_LOADROW(cur, r0); PREP_LOADAUX(r0);
        if (r0 > 0) PREP_LOADROW(prv, r0 - 1); else { prv[0] = z4; prv[1] = z4; prv[2] = z4; }
        if (r0 + 1 < MA) PREP_LOADROW(nxt, r0 + 1); else { nxt[0] = z4; nxt[1] = z4; nxt[2] = z4; }
        for (int row = r0; row < r1; ++row) {
            int b, t, len, key;
            if (row < ML) { b = row >> 13; t = row & (T - 1); len = T; key = CTX + t; } else { const int rc = row - ML; b = rc >> 8; t = rc & (CTX - 1); len = CTX; key = t; }
            const u32x4 lxc = lx; const u32x2 qac = qa, qcc = qc; const unsigned short k1c = k1, k2c = k2;
            u32x4 nn[3]; nn[0] = z4; nn[1] = z4; nn[2] = z4;
            if (row + 2 < MA && row + 1 < r1) PREP_LOADROW(nn, row + 2);
            if (row + 1 < r1) PREP_LOADAUX(row + 1);
            const bool hasp = t > 0, hasn = t < len - 1;
#pragma unroll
            for (int q = 0; q < 3; ++q) { const int c = q * 512 + lane * 8;
                const u32x4 pv = hasp ? prv[q] : z4, nv = hasn ? nxt[q] : z4, cv = cur[q];
                h16x8 o;
#pragma unroll
                for (int i = 0; i < 4; ++i) { const int ch = c + 2 * i;
                    const float lo = cw[ch] * bflo(pv[i]) + cw[1536 + ch] * bflo(cv[i]) + cw[3072 + ch] * bflo(nv[i]);
                    const float hi = cw[ch + 1] * bfhi(pv[i]) + cw[1536 + ch + 1] * bfhi(cv[i]) + cw[3072 + ch + 1] * bfhi(nv[i]);
                    o[2 * i] = (_Float16)lo; o[2 * i + 1] = (_Float16)hi; }
                *(h16x8*)(RKV + (size_t)row * 1536 + c) = o;
                if (q == 1) {
                    float ss = 0.f;
#pragma unroll
                    for (int i = 0; i < 8; ++i) { const float kr = (float)o[i] * p.in[I_KK][lane * 8 + i]; ss += kr * kr; }
                    ss += __shfl_xor(ss, 1); ss += __shfl_xor(ss, 2); ss += __shfl_xor(ss, 4);
                    if ((lane & 7) == 0) rnp[(size_t)row * 8 + (lane >> 3)] = 1.0f / sqrtf(ss + 1e-12f); } }
            if (lane < 48) { u32x4 o;
#pragma unroll
                for (int i = 0; i < 4; ++i) { float lo = bflo(lxc[i]), hi = bfhi(lxc[i]);
                    if (lane < 16) { const float el = __builtin_amdgcn_exp2f(-2.885390081777927f * lo), eh = __builtin_amdgcn_exp2f(-2.885390081777927f * hi);
                        lo = 2.0f * __builtin_amdgcn_rcpf(1.0f + el) - 1.0f; hi = 2.0f * __builtin_amdgcn_rcpf(1.0f + eh) - 1.0f; }
                    else if (lane >= 32) { lo = sigmoidf_(lo); hi = sigmoidf_(hi); }
                    o[i] = cvt_pk_bf16(lo, hi); }
                *(u32x4*)(ACT + (size_t)row * 384 + lane * 8) = o; }
            { float sa = bflo(qac.x) * bflo(qac.x) + bfhi(qac.x) * bfhi(qac.x) + bflo(qac.y) * bflo(qac.y) + bfhi(qac.y) * bfhi(qac.y);
              float sb = bflo(qcc.x) * bflo(qcc.x) + bfhi(qcc.x) * bfhi(qcc.x) + bflo(qcc.y) * bflo(qcc.y) + bfhi(qcc.y) * bfhi(qcc.y);
              sa = wave_sum(sa); sb = wave_sum(sb);
              if (lane == 0) { rq[row] = 1.0f / sqrtf(sa * (1.f / 256.f) + RMS_EPS); rkv[row] = 1.0f / sqrtf(sb * (1.f / 256.f) + RMS_EPS); } }
            if (lane < 32) { float o1, o2; const int g = (lane >> 4) & 1, jj = lane & 15; const float x1 = bf2f(k1c), x2 = bf2f(k2c);
                if (row < ML) { const float pos = (float)(g == 0 ? (t >> 6) : (t & 63)); float rev = pos * rope_invfreq(jj); rev = rev - floorf(rev);
                    const float sn = __builtin_amdgcn_sinf(rev), cs = __builtin_amdgcn_cosf(rev); o1 = x1 * cs - x2 * sn; o2 = x2 * cs + x1 * sn; }
                else { o1 = x1; o2 = x2; }
                const bf16_t w1 = (bf16_t)(cvt_pk_bf16(o1, 0.f) & 0xffffu), w2 = (bf16_t)(cvt_pk_bf16(o2, 0.f) & 0xffffu);
#pragma unroll
                for (int hh = 0; hh < 4; ++hh) { bf16_t* kp = Kb + ((size_t)(b * 4 + hh) * SKV + key) * 192 + 128 + g * 32 + jj; kp[0] = w1; kp[16] = w2; } }
#pragma unroll
            for (int q = 0; q < 3; ++q) { prv[q] = cur[q]; cur[q] = nxt[q]; nxt[q] = nn[q]; }
        }
#undef PREP_LOADROW
#undef PREP_LOADAUX
    }
}

constexpr int SC_CH = 32, SC_TOKF = 344;
__device__ __forceinline__ int scan_row_of(int b, int dir, int n) {
    if (n < CTX) { const int tc = dir ? (CTX - 1 - n) : n; return ML + b * CTX + tc; }
    const int tl = dir ? (T - 1 - (n - CTX)) : (n - CTX); return b * T + tl;
}
__device__ __forceinline__ void ph_scan(KP p, LAS unsigned char* lds) {
    const int tid = threadIdx.x, lane = tid & 63, wave = tid >> 6;
    unsigned char* ws = p.ws;
    const _Float16* RKV = (const _Float16*)(ws + WS_RKV); const _Float16* E16 = (const _Float16*)(ws + WS_E16); const _Float16* A16 = (const _Float16*)(ws + WS_A16);
    _Float16* YS = (_Float16*)((unsigned char*)p.out + DO_YS);
    const float* kkp = p.in[I_KK]; const float* kap = p.in[I_KA];
    LAS float* buf = (LAS float*)lds;
    constexpr int NCHUNK = SKV / SC_CH;
    for (int unit = blockIdx.x; unit < 256; unit += gridDim.x) {
        const int chain = unit >> 2, rb = (unit & 3) * 16;
        const int dir = chain & 1, hh = (chain >> 1) & 3  ;
        const int b = chain >> 4, head = (chain >> 1) & 7;
        (void)hh;
#define SC_PREP(ck) do { const int pt = tid - 256; const int tt = pt >> 3, part = pt & 7;                                                        \
        const int row = scan_row_of(b, dir, (ck) * SC_CH + tt); const int ch0 = head * 64 + part * 8;                                            \
        const h16x8 r8 = *(const h16x8*)(RKV + (size_t)row * 1536 + ch0), k8 = *(const h16x8*)(RKV + (size_t)row * 1536 + 512 + ch0);          \
        const h16x8 a8 = *(const h16x8*)(A16 + ((size_t)dir * MA + row) * 512 + ch0), e8 = *(const h16x8*)(E16 + ((size_t)dir * MA + row) * 512 + ch0); \
        float kf[8], kkr[8]; float ss = 0.f;                                                                                                     \
        _Pragma("unroll") for (int i = 0; i < 8; ++i) { kf[i] = (float)k8[i]; kkr[i] = kf[i] * kkp[ch0 + i]; ss += kkr[i] * kkr[i]; }           \
        ss += __shfl_xor(ss, 1); ss += __shfl_xor(ss, 2); ss += __shfl_xor(ss, 4);                                                               \
        const float rn = 1.0f / sqrtf(ss + 1e-12f);                                                                                              \
        LAS float* rec = buf + ((ck) & 1) * (SC_CH * SC_TOKF) + tt * SC_TOKF; float c1 = 0.f, c2 = 0.f;                                         \
        _Pragma("unroll") for (int i = 0; i < 8; ++i) { const float a = (float)a8[i], r = (float)r8[i]; const float kk = kkr[i] * rn;           \
            const float w = __builtin_amdgcn_exp2f(-1.4426950408889634f * (float)e8[i]); const float ka = kk * a;                                \
            const float kd = kf[i] * (1.0f + (a - 1.0f) * kap[ch0 + i]);                                                                         \
            rec[part * 8 + i] = kk; rec[64 + part * 8 + i] = w * r; rec[128 + part * 8 + i] = w; rec[192 + part * 8 + i] = kd; rec[256 + part * 8 + i] = ka; \
            c1 += ka * r; c2 += kd * r; }                                                                                                        \
        c1 += __shfl_xor(c1, 1); c1 += __shfl_xor(c1, 2); c1 += __shfl_xor(c1, 4); c2 += __shfl_xor(c2, 1); c2 += __shfl_xor(c2, 2); c2 += __shfl_xor(c2, 4); \
        if (part == 0) { rec[336] = c1; rec[337] = c2; }                                                                                         \
        if (part < 2) { const h16x8 v8 = *(const h16x8*)(RKV + (size_t)row * 1536 + 1024 + head * 64 + rb + part * 8);                           \
            _Pragma("unroll") for (int i = 0; i < 8; ++i) rec[320 + part * 8 + i] = (float)v8[i]; } } while (0)
        if (wave >= 4) SC_PREP(0);
        __syncthreads();
        f32x2 S01 = {0.f, 0.f}, S23 = {0.f, 0.f};
        const int ri = (wave & 3) * 4 + (lane >> 4), q = lane & 15;
        for (int ck = 0; ck < NCHUNK; ++ck) {
            if (wave >= 4) { if (ck + 1 < NCHUNK) SC_PREP(ck + 1); }
            else {
                const LAS float* cb = buf + (ck & 1) * (SC_CH * SC_TOKF);
                float yk0 = 0.f, yk1 = 0.f;
#pragma unroll 4
                for (int tt = 0; tt < SC_CH; ++tt) {
                    const LAS float* rec = cb + tt * SC_TOKF;
                    const f32x4 kk4 = *(const LAS f32x4*)(rec + q * 4), wr4 = *(const LAS f32x4*)(rec + 64 + q * 4), w4 = *(const LAS f32x4*)(rec + 128 + q * 4);
                    const f32x4 kd4 = *(const LAS f32x4*)(rec + 192 + q * 4), ka4 = *(const LAS f32x4*)(rec + 256 + q * 4);
                    const float v = rec[320 + ri]; const f32x2 cc = *(const LAS f32x2*)(rec + 336);
                    f32x2 d1 = S01 * (f32x2){kk4.x, kk4.y}; d1 = S23 * (f32x2){kk4.z, kk4.w} + d1;
                    f32x2 d2 = S01 * (f32x2){wr4.x, wr4.y}; d2 = S23 * (f32x2){wr4.z, wr4.w} + d2;
                    const float sk = allred16(d1.x + d1.y), qv = allred16(d2.x + d2.y);
                    const float y = qv - sk * cc.x + v * cc.y;
                    const f32x2 vv = {v, v}, ns = {-sk, -sk};
                    S01 = S01 * (f32x2){w4.x, w4.y}; S01 = vv * (f32x2){kd4.x, kd4.y} + S01; S01 = ns * (f32x2){ka4.x, ka4.y} + S01;
                    S23 = S23 * (f32x2){w4.z, w4.w}; S23 = vv * (f32x2){kd4.z, kd4.w} + S23; S23 = ns * (f32x2){ka4.z, ka4.w} + S23;
                    if ((tt & 15) == q) { if (tt < 16) yk0 = y; else yk1 = y; }
                }
                if (ck >= CTX / SC_CH) {
                    const int r0 = scan_row_of(b, dir, ck * SC_CH + q), r1 = scan_row_of(b, dir, ck * SC_CH + 16 + q);
                    YS[((size_t)dir * ML + r0) * 512 + head * 64 + rb + ri] = (_Float16)yk0;
                    YS[((size_t)dir * ML + r1) * 512 + head * 64 + rb + ri] = (_Float16)yk1;
                }
            }
            __syncthreads();
        }
#undef SC_PREP
    }
}


#ifndef SC2_DUP
#define SC2_DUP 0
#endif
namespace sc2 {
constexpr int PITCH = 128, SLOT = 64 * PITCH;
constexpr int CPS = 33, CH = 64;
enum { SL_S = 0, SL_MT = 1, SL_AH = 2, SL_BH = 3, SL_KH = 4, SL_RH = 5, SL_AHT = 6, SL_BBT = 7, SL_VT = 8, SL_KBT = 9, SL_AAB = 10, SL_AAKT = 11, SL_ARB = 12, SL_ARK = 13, SL_P2T = 14,
       SL_TT = 2, SL_ET = 3, SL_T = 4, SL_Q1 = 2, SL_Q2 = 3, SL_ML = 4, SL_ZX = 6, SL_P1T = 10, SL_TB = 15, SL_TTB = 16 };
constexpr int GC_OFF = 17 * SLOT;
__device__ __forceinline__ int swz(int row, int byte) { return row * PITCH + ((((byte >> 4) ^ (row >> 1)) & 7) << 4) + (byte & 15); }
struct Fr { bf16x8 k0, k1; };
__device__ __forceinline__ Fr ldf(const LAS char* M, int tile, int lane) { const int row = 16 * tile + (lane & 15), cq = lane >> 4, sw = (row >> 1) & 7; Fr f;
    f.k0 = *(const LAS bf16x8*)(M + row * PITCH + ((cq ^ sw) << 4)); f.k1 = *(const LAS bf16x8*)(M + row * PITCH + (((cq + 4) ^ sw) << 4)); return f; }
__device__ __forceinline__ f32x4 mm(const Fr& A, const Fr& B, f32x4 acc) {
    acc = __builtin_amdgcn_mfma_f32_16x16x32_bf16(A.k0, B.k0, acc, 0, 0, 0); acc = __builtin_amdgcn_mfma_f32_16x16x32_bf16(A.k1, B.k1, acc, 0, 0, 0); return acc; }
__device__ __forceinline__ void st4(LAS char* M, int row, int col, f32x4 v) { u32x2 w; w.x = cvt_pk_bf16_n(v[0], v[1]); w.y = cvt_pk_bf16_n(v[2], v[3]); *(LAS u32x2*)(M + swz(row, col * 2)) = w; }
__device__ __forceinline__ f32x4 ld4(const LAS char* M, int row, int col) { const u32x2 w = *(const LAS u32x2*)(M + swz(row, col * 2)); return (f32x4){bflo(w.x), bfhi(w.x), bflo(w.y), bfhi(w.y)}; }
__device__ __forceinline__ void st1(LAS char* M, int row, int col, float v) { *(LAS unsigned short*)(M + swz(row, col * 2)) = (unsigned short)(cvt_pk_bf16_n(v, 0.f) & 0xffffu); }
#define SC2_SLOT(i) ((LAS char*)lds + (i) * SLOT)
#define SC2_BAR() do { asm volatile("s_waitcnt lgkmcnt(0)" ::: "memory"); __syncthreads(); } while (0)
#define SC2_Z ((f32x4){0.f, 0.f, 0.f, 0.f})
#define SC2_SB() __builtin_amdgcn_sched_barrier(0)

__device__ __forceinline__ void pass_a(KP p, LAS unsigned char* lds) {
    int tid_o = threadIdx.x; asm volatile("" : "+v"(tid_o));
    const int tid = tid_o, lane = tid & 63, wave = __builtin_amdgcn_readfirstlane(tid >> 6), q4 = (lane >> 4) * 4, l15 = lane & 15;
    unsigned char* ws = p.ws;
    const _Float16* RKV = (const _Float16*)(ws + WS_RKV); const _Float16* E16 = (const _Float16*)(ws + WS_E16); const _Float16* A16 = (const _Float16*)(ws + WS_A16);
    _Float16* YS = (_Float16*)((unsigned char*)p.out + DO_YS);
    LAS float* gC = (LAS float*)((LAS char*)lds + GC_OFF); const float* RN = (const float*)(ws + WS_RN);
    const int tx = wave >> 1, ty0 = (wave & 1) * 2;
    const int x = 16 * tx + l15;
    for (int unit = blockIdx.x; unit < 256; unit += gridDim.x) {
        const int chain = unit >> 2, seg = unit & 3, dir = chain & 1, head = (chain >> 1) & 7, b = chain >> 4;
        bf16_t* QC = (bf16_t*)(ws + (dir ? WS_QC1 : WS_QC0)) + (size_t)(chain >> 1) * SKV * 64;
        float* SEG = (float*)(ws + WS_SEG) + (size_t)unit * 8192;
        h16x8 e8n, a8n, r8n, k8n, v8n; float rnn;
#define SC2_LOADRAW(ck_) do { const int row_ = scan_row_of(b, dir, (ck_) * CH + lane); const size_t eo_ = ((size_t)dir * MA + row_) * 512 + head * 64 + wave * 8; \
        e8n = *(const h16x8*)(E16 + eo_); a8n = *(const h16x8*)(A16 + eo_); const _Float16* rp_ = RKV + (size_t)row_ * 1536 + head * 64 + wave * 8; \
        r8n = *(const h16x8*)rp_; k8n = *(const h16x8*)(rp_ + 512); v8n = *(const h16x8*)(rp_ + 1024); rnn = RN[(size_t)row_ * 8 + head]; } while (0)
        for (int i = tid; i < 2 * SLOT / 16; i += NTHREADS) *(LAS u32x4*)((LAS char*)lds + i * 16) = (u32x4){0u, 0u, 0u, 0u};
        SC2_BAR();
        if (tid < 64) st1(SC2_SLOT(SL_MT), tid, tid, 1.0f);
        const int cb = wave & 3;
        f32x4 mst[4];
#pragma unroll
        for (int tk = 0; tk < 4; ++tk) { mst[tk] = SC2_Z;
            if (wave >= 4) {
#pragma unroll
                for (int e = 0; e < 4; ++e) mst[tk][e] = (16 * tk + q4 + e == 16 * cb + l15) ? 1.0f : 0.0f; } }
        SC2_BAR();
        for (int ck = seg * CPS; ck < (seg + 1) * CPS; ++ck) {
            {
                SC2_LOADRAW(ck);
                const h16x8 e8 = e8n, a8 = a8n, r8 = r8n, k8 = k8n, v8 = v8n; const float rn = rnn;
                u32x4 wah, wrh, wbh, wkh; unsigned pa = 0, pr = 0, pb = 0, pk = 0;
                const f32x4 kk0 = *(const f32x4*)(p.in[I_KK] + head * 64 + wave * 8), kk1 = *(const f32x4*)(p.in[I_KK] + head * 64 + wave * 8 + 4), ka0 = *(const f32x4*)(p.in[I_KA] + head * 64 + wave * 8), ka1 = *(const f32x4*)(p.in[I_KA] + head * 64 + wave * 8 + 4);
#pragma unroll
                for (int j = 0; j < 8; ++j) {
                    const float ev = (float)e8[j];
                    float L = ev; L += dppf<0x111>(L); L += dppf<0x112>(L); L += dppf<0x114>(L); L += dppf<0x118>(L);
                    const float r0 = __int_as_float(__builtin_amdgcn_readlane(__float_as_int(L), 15)), r1 = __int_as_float(__builtin_amdgcn_readlane(__float_as_int(L), 31)), r2 = __int_as_float(__builtin_amdgcn_readlane(__float_as_int(L), 47));
                    L += (lane >= 16 ? r0 : 0.f) + (lane >= 32 ? r1 : 0.f) + (lane >= 48 ? r2 : 0.f);
                    const float tot = __int_as_float(__builtin_amdgcn_readlane(__float_as_int(L), 63));
                    const float gam = __builtin_amdgcn_exp2f(-1.4426950408889634f * L), gprev = __builtin_amdgcn_exp2f(-1.4426950408889634f * (L - ev));
                    const float ginv = __builtin_amdgcn_exp2f(1.4426950408889634f * L), gbar = __builtin_amdgcn_exp2f(1.4426950408889634f * (L - tot));
                    const float kf = (float)k8[j], af = (float)a8[j], kkn = kf * (j < 4 ? kk0[j & 3] : kk1[j & 3]) * rn;
                    const float ka = kkn * af, kd = kf * (1.0f + (af - 1.0f) * (j < 4 ? ka0[j & 3] : ka1[j & 3]));
                    const float Ah = -kkn * gprev, Rh = (float)r8[j] * gam, Bh = ka * ginv, Kh = kd * ginv, Bb = ka * gbar, Kb = kd * gbar;
                    const int c = wave * 8 + j;
                    st1(SC2_SLOT(SL_AHT), c, lane, Ah); st1(SC2_SLOT(SL_BBT), c, lane, Bb); st1(SC2_SLOT(SL_VT), c, lane, (float)v8[j]); st1(SC2_SLOT(SL_KBT), c, lane, Kb);
                    if (lane == 0) gC[c] = __builtin_amdgcn_exp2f(-1.4426950408889634f * tot);
                    if (j & 1) { wah[j >> 1] = cvt_pk_bf16_n(__uint_as_float(pa), Ah); wrh[j >> 1] = cvt_pk_bf16_n(__uint_as_float(pr), Rh); wbh[j >> 1] = cvt_pk_bf16_n(__uint_as_float(pb), Bh); wkh[j >> 1] = cvt_pk_bf16_n(__uint_as_float(pk), Kh); SC2_SB(); }
                    else { pa = __float_as_uint(Ah); pr = __float_as_uint(Rh); pb = __float_as_uint(Bh); pk = __float_as_uint(Kh); } }
                const int ro = swz(lane, wave * 16);
                *(LAS u32x4*)(SC2_SLOT(SL_AH) + ro) = wah; *(LAS u32x4*)(SC2_SLOT(SL_RH) + ro) = wrh; *(LAS u32x4*)(SC2_SLOT(SL_BH) + ro) = wbh; *(LAS u32x4*)(SC2_SLOT(SL_KH) + ro) = wkh;
            }
            SC2_BAR();
            { const Fr fAHx = ldf(SC2_SLOT(SL_AH), tx, lane), fKHx = ldf(SC2_SLOT(SL_KH), tx, lane), fRHx = ldf(SC2_SLOT(SL_RH), tx, lane);
#pragma unroll
              for (int j = 0; j < 2; ++j) { const int y0 = 16 * (ty0 + j) + q4;
                const Fr fBHy = ldf(SC2_SLOT(SL_BH), ty0 + j, lane), fAHy = ldf(SC2_SLOT(SL_AH), ty0 + j, lane), fKHy = ldf(SC2_SLOT(SL_KH), ty0 + j, lane);
                SC2_SB();
                f32x4 aab = mm(fBHy, fAHx, SC2_Z), aak = mm(fAHy, fKHx, SC2_Z), arb = mm(fBHy, fRHx, SC2_Z), ark = mm(fKHy, fRHx, SC2_Z);
                SC2_SB();
#pragma unroll
                for (int e = 0; e < 4; ++e) { const int y = y0 + e; if (!(y < x)) aab[e] = 0.f; if (!(x < y)) aak[e] = 0.f; if (!(y <= x)) { arb[e] = 0.f; ark[e] = 0.f; } }
                st4(SC2_SLOT(SL_AAB), x, y0, aab); st4(SC2_SLOT(SL_AAKT), x, y0, aak); st4(SC2_SLOT(SL_ARB), x, y0, arb); st4(SC2_SLOT(SL_ARK), x, y0, ark); } }
            SC2_BAR();
            if (wave == 0) {
                const int blk = lane >> 4, c = lane & 15; float X[16];
                const LAS char* am = SC2_SLOT(SL_AAB);
                { u32x4 ar0[9];
#pragma unroll
                  for (int r = 1; r < 9; ++r) ar0[r] = *(const LAS u32x4*)(am + swz(16 * blk + r, 32 * blk));
#pragma unroll
                  for (int r = 0; r < 9; ++r) { float xv = (r == c) ? 1.0f : 0.0f;
#pragma unroll
                      for (int s2 = 0; s2 < 8; ++s2) { if (s2 < r) { const unsigned wv = ar0[r][s2 >> 1]; xv += ((s2 & 1) ? bfhi(wv) : bflo(wv)) * X[s2]; } }
                      X[r] = xv; st1(SC2_SLOT(SL_T), 16 * blk + r, 16 * blk + c, xv); } }
                asm volatile("" ::: "memory");
                { u32x4 ar0[7], ar1[7];
#pragma unroll
                  for (int r = 9; r < 16; ++r) { ar0[r - 9] = *(const LAS u32x4*)(am + swz(16 * blk + r, 32 * blk)); ar1[r - 9] = *(const LAS u32x4*)(am + swz(16 * blk + r, 32 * blk + 16)); }
#pragma unroll
                  for (int r = 9; r < 16; ++r) { float xv = (r == c) ? 1.0f : 0.0f;
#pragma unroll
                      for (int s2 = 0; s2 < 16; ++s2) { if (s2 < r) { const unsigned wv = s2 < 8 ? ar0[r - 9][s2 >> 1] : ar1[r - 9][(s2 - 8) >> 1]; xv += ((s2 & 1) ? bfhi(wv) : bflo(wv)) * X[s2]; } }
                      X[r] = xv; st1(SC2_SLOT(SL_T), 16 * blk + r, 16 * blk + c, xv); } }
                u32x4 o0, o1;
#pragma unroll
                for (int i = 0; i < 4; ++i) { o0[i] = cvt_pk_bf16_n(X[2 * i], X[2 * i + 1]); o1[i] = cvt_pk_bf16_n(X[8 + 2 * i], X[9 + 2 * i]); }
                *(LAS u32x4*)(SC2_SLOT(SL_TT) + swz(16 * blk + c, 32 * blk)) = o0; *(LAS u32x4*)(SC2_SLOT(SL_TT) + swz(16 * blk + c, 32 * blk + 16)) = o1;
            } else {
                for (int i = tid - 64; i < 768; i += NTHREADS - 64) { const int m = i / 384, rem = i % 384, b12 = rem >> 5, rr = (rem & 31) >> 1, hf = rem & 1; const int bi = b12 / 3; int bj = b12 % 3; bj += (bj >= bi) ? 1 : 0;
                    *(LAS u32x4*)(SC2_SLOT(m ? SL_TT : SL_T) + swz(16 * bi + rr, 32 * bj + 16 * hf)) = (u32x4){0u, 0u, 0u, 0u}; }
            }
            SC2_BAR();
#pragma unroll
            for (int lv = 0; lv < 2; ++lv) { const int sh = 4 + lv;
                const LAS char* Ts = SC2_SLOT(lv ? SL_TB : SL_T); const LAS char* TTs = SC2_SLOT(lv ? SL_TTB : SL_TT); LAS char* Td = SC2_SLOT(lv ? SL_T : SL_TB); LAS char* TTd = SC2_SLOT(lv ? SL_TT : SL_TTB);
                { const Fr fTTx = ldf(TTs, tx, lane); Fr fABy[2];
#pragma unroll
                  for (int j = 0; j < 2; ++j) fABy[j] = ldf(SC2_SLOT(SL_AAB), ty0 + j, lane);
                  SC2_SB();
                  f32x4 ev[2];
#pragma unroll
                  for (int j = 0; j < 2; ++j) ev[j] = mm(fABy[j], fTTx, SC2_Z);
                  SC2_SB();
#pragma unroll
                  for (int j = 0; j < 2; ++j) { const int r0 = 16 * (ty0 + j) + q4;
#pragma unroll
                    for (int e = 0; e < 4; ++e) { const int r = r0 + e; const bool ok = ((r >> (sh + 1)) == (x >> (sh + 1))) && ((r >> sh) & 1) && !((x >> sh) & 1); if (!ok) ev[j][e] = 0.f; }
                    st4(SC2_SLOT(SL_ET), x, r0, ev[j]); } }
                SC2_BAR();
                { const Fr fTx = ldf(Ts, tx, lane), fETx = ldf(SC2_SLOT(SL_ET), tx, lane); Fr fETy[2], fTy[2]; f32x4 tn[2], ttn[2];
#pragma unroll
                  for (int j = 0; j < 2; ++j) { const int y0 = 16 * (ty0 + j) + q4; fETy[j] = ldf(SC2_SLOT(SL_ET), ty0 + j, lane); tn[j] = ld4(Ts, x, y0);
                      if (lv == 0) { fTy[j] = ldf(Ts, ty0 + j, lane); ttn[j] = ld4(TTs, x, y0); } }
                  SC2_SB();
#pragma unroll
                  for (int j = 0; j < 2; ++j) { tn[j] = mm(fETy[j], fTx, tn[j]);
                      if (lv == 0) ttn[j] = mm(fTy[j], fETx, ttn[j]); }
                  SC2_SB();
#pragma unroll
                  for (int j = 0; j < 2; ++j) { const int y0 = 16 * (ty0 + j) + q4; st4(Td, x, y0, tn[j]); if (lv == 0) st4(TTd, x, y0, ttn[j]); } }
                SC2_BAR();
            }
            { const Fr fAHTx = ldf(SC2_SLOT(SL_AHT), tx, lane), fAAKTx = ldf(SC2_SLOT(SL_AAKT), tx, lane); Fr fTy[2];
#pragma unroll
              for (int j = 0; j < 2; ++j) fTy[j] = ldf(SC2_SLOT(SL_T), ty0 + j, lane);
              SC2_SB();
              f32x4 p1[2], p2[2];
#pragma unroll
              for (int j = 0; j < 2; ++j) { p1[j] = mm(fTy[j], fAHTx, SC2_Z); p2[j] = mm(fTy[j], fAAKTx, SC2_Z); }
              SC2_SB();
#pragma unroll
              for (int j = 0; j < 2; ++j) { const int y0 = 16 * (ty0 + j) + q4; st4(SC2_SLOT(SL_P1T), x, y0, p1[j]); st4(SC2_SLOT(SL_P2T), x, y0, p2[j]); } }
            SC2_BAR();
            { const Fr fARBx = ldf(SC2_SLOT(SL_ARB), tx, lane), fBBTx = ldf(SC2_SLOT(SL_BBT), tx, lane); Fr fP1y[2], fP2y[2]; f32x4 q1[2], q2[2], ml[2], zx[2];
#pragma unroll
              for (int j = 0; j < 2; ++j) { const int y0 = 16 * (ty0 + j) + q4; fP1y[j] = ldf(SC2_SLOT(SL_P1T), ty0 + j, lane); fP2y[j] = ldf(SC2_SLOT(SL_P2T), ty0 + j, lane);
                  q1[j] = ld4(SC2_SLOT(SL_RH), x, y0); q2[j] = ld4(SC2_SLOT(SL_ARK), x, y0); zx[j] = ld4(SC2_SLOT(SL_KBT), x, y0); }
              SC2_SB();
#pragma unroll
              for (int j = 0; j < 2; ++j) { q1[j] = mm(fP1y[j], fARBx, q1[j]); q2[j] = mm(fP2y[j], fARBx, q2[j]); ml[j] = mm(fP1y[j], fBBTx, SC2_Z); zx[j] = mm(fP2y[j], fBBTx, zx[j]); }
              SC2_SB();
#pragma unroll
              for (int j = 0; j < 2; ++j) { const int y0 = 16 * (ty0 + j) + q4; st4(SC2_SLOT(SL_Q1), x, y0, q1[j]); st4(SC2_SLOT(SL_Q2), x, y0, q2[j]); st4(SC2_SLOT(SL_ML), x, y0, ml[j]); st4(SC2_SLOT(SL_ZX), x, y0, zx[j]); } }
            SC2_BAR();
            {
                const Fr fSt = ldf(SC2_SLOT(wave < 4 ? SL_S : SL_MT), cb, lane); Fr fVT = fSt; if (wave < 4) fVT = ldf(SC2_SLOT(SL_VT), cb, lane);
#pragma unroll
                for (int hf = 0; hf < 2; ++hf) { Fr fQ1[2], fQ2[2];
#pragma unroll
                  for (int t2 = 0; t2 < 2; ++t2) { const int tt = 2 * hf + t2; fQ1[t2] = ldf(SC2_SLOT(SL_Q1), tt, lane); fQ2[t2] = fQ1[t2]; if (wave < 4) fQ2[t2] = ldf(SC2_SLOT(SL_Q2), tt, lane); }
                  SC2_SB();
                  f32x4 yv[2];
#pragma unroll
                  for (int t2 = 0; t2 < 2; ++t2) { yv[t2] = mm(fSt, fQ1[t2], SC2_Z); if (wave < 4) yv[t2] = mm(fVT, fQ2[t2], yv[t2]); }
                  SC2_SB();
#pragma unroll
                  for (int t2 = 0; t2 < 2; ++t2) { const int tt = 2 * hf + t2; const int n = ck * CH + 16 * tt + l15;
                    if (wave < 4) {
                        if (ck >= CTX / CH) { const int row = scan_row_of(b, dir, n); h16x4 o; o[0] = (_Float16)yv[t2][0]; o[1] = (_Float16)yv[t2][1]; o[2] = (_Float16)yv[t2][2]; o[3] = (_Float16)yv[t2][3];
                            *(h16x4*)(YS + ((size_t)dir * ML + row) * 512 + head * 64 + 16 * cb + q4) = o; } }
                    else { u32x2 w; w.x = cvt_pk_bf16_n(yv[t2][0], yv[t2][1]); w.y = cvt_pk_bf16_n(yv[t2][2], yv[t2][3]); *(u32x2*)(QC + (size_t)n * 64 + 16 * cb + q4) = w; } } }
#pragma unroll
                for (int hf = 0; hf < 2; ++hf) { Fr fML[2], fZX[2]; f32x4 g[2];
#pragma unroll
                  for (int t2 = 0; t2 < 2; ++t2) { const int tk = 2 * hf + t2; fML[t2] = ldf(SC2_SLOT(SL_ML), tk, lane); fZX[t2] = fML[t2]; if (wave < 4) fZX[t2] = ldf(SC2_SLOT(SL_ZX), tk, lane); g[t2] = *(const LAS f32x4*)(gC + 16 * tk + q4); }
                  SC2_SB();
#pragma unroll
                  for (int t2 = 0; t2 < 2; ++t2) { const int tk = 2 * hf + t2; f32x4 xn = mm(fML[t2], fSt, mst[tk] * g[t2]); if (wave < 4) xn = mm(fZX[t2], fVT, xn); mst[tk] = xn; }
                  SC2_SB(); }
                SC2_BAR();
                LAS char* Sw = SC2_SLOT(wave < 4 ? SL_S : SL_MT);
#pragma unroll
                for (int tk = 0; tk < 4; ++tk) st4(Sw, 16 * cb + l15, 16 * tk + q4, mst[tk]);
            }
        }
        { float* dst = SEG + (wave < 4 ? 0 : 4096);
#pragma unroll
          for (int tk = 0; tk < 4; ++tk)
#pragma unroll
              for (int e = 0; e < 4; ++e) dst[(16 * tk + q4 + e) * 64 + 16 * cb + l15] = mst[tk][e]; }
        SC2_BAR();
    }
#undef SC2_LOADRAW
}

__device__ __forceinline__ void pass_b(KP p, LAS unsigned char* lds) {
    const int tid = threadIdx.x, lane = tid & 63, wave = __builtin_amdgcn_readfirstlane(tid >> 6), q4 = (lane >> 4) * 4, l15 = lane & 15;
    unsigned char* ws = p.ws;
    _Float16* YS = (_Float16*)((unsigned char*)p.out + DO_YS);
    LAS float* Xa = (LAS float*)lds; LAS float* Xb = Xa + 4096; LAS float* Mm = Xb + 4096;
    LAS char* Sst = (LAS char*)lds + 3 * 16384;
    for (int unit = blockIdx.x; unit < 256; unit += gridDim.x) {
        const int chain = unit >> 2, seg = unit & 3, dir = chain & 1, head = (chain >> 1) & 7, b = chain >> 4;
        if (seg == 0) continue;
        const bf16_t* QC = (const bf16_t*)(ws + (dir ? WS_QC1 : WS_QC0)) + (size_t)(chain >> 1) * SKV * 64;
        const float* SEG0 = (const float*)(ws + WS_SEG) + (size_t)(chain * 4) * 8192;
        for (int i = tid; i < 4096; i += NTHREADS) Xa[i] = SEG0[i];
        __syncthreads();
        LAS float* xc = Xa; LAS float* xn = Xb;
        for (int m = 1; m < seg; ++m) {
            const float* sg = SEG0 + (size_t)m * 8192;
            for (int i = tid; i < 4096; i += NTHREADS) Mm[i] = sg[4096 + i];
            __syncthreads();
            const int v = lane, k0 = wave * 8; float acc[8];
#pragma unroll
            for (int i = 0; i < 8; ++i) acc[i] = sg[(k0 + i) * 64 + v];
            for (int k2 = 0; k2 < 64; ++k2) { const float xv = xc[k2 * 64 + v];
#pragma unroll
                for (int i = 0; i < 8; ++i) acc[i] += Mm[(k0 + i) * 64 + k2] * xv; }
#pragma unroll
            for (int i = 0; i < 8; ++i) xn[(k0 + i) * 64 + v] = acc[i];
            __syncthreads();
            LAS float* tmp = xc; xc = xn; xn = tmp;
        }
        { const int v = lane, k0 = wave * 8; u32x4 o;
#pragma unroll
          for (int i = 0; i < 4; ++i) o[i] = cvt_pk_bf16_n(xc[(k0 + 2 * i) * 64 + v], xc[(k0 + 2 * i + 1) * 64 + v]);
          *(LAS u32x4*)(Sst + swz(v, k0 * 2)) = o; }
        SC2_BAR();
        const int cb = wave & 3, tt0 = (wave >> 2) * 2; const Fr fS = ldf(Sst, cb, lane);
        bf16x8 nb0[2], nb1[2]; h16x4 ny[2]; _Float16* nyp[2];
#define SC2_PBLOAD(ck_) do { _Pragma("unroll") for (int j = 0; j < 2; ++j) { const int n_ = (ck_) * CH + 16 * (tt0 + j) + l15; const bf16_t* qp_ = QC + (size_t)n_ * 64 + (lane >> 4) * 8; \
            nb0[j] = *(const bf16x8*)qp_; nb1[j] = *(const bf16x8*)(qp_ + 32); const int row_ = scan_row_of(b, dir, n_); \
            nyp[j] = YS + ((size_t)dir * ML + row_) * 512 + head * 64 + 16 * cb + q4; ny[j] = *(const h16x4*)nyp[j]; } } while (0)
        SC2_PBLOAD(seg * CPS);
        for (int ck = seg * CPS; ck < (seg + 1) * CPS; ++ck) {
            bf16x8 b0[2], b1[2]; h16x4 yv[2]; _Float16* yp[2];
#pragma unroll
            for (int j = 0; j < 2; ++j) { b0[j] = nb0[j]; b1[j] = nb1[j]; yv[j] = ny[j]; yp[j] = nyp[j]; }
            if (ck + 1 < (seg + 1) * CPS) SC2_PBLOAD(ck + 1);
#pragma unroll
            for (int j = 0; j < 2; ++j) {
                f32x4 acc = {0.f, 0.f, 0.f, 0.f};
                acc = __builtin_amdgcn_mfma_f32_16x16x32_bf16(fS.k0, b0[j], acc, 0, 0, 0);
                acc = __builtin_amdgcn_mfma_f32_16x16x32_bf16(fS.k1, b1[j], acc, 0, 0, 0);
                h16x4 o = yv[j]; o[0] = (_Float16)((float)o[0] + acc[0]); o[1] = (_Float16)((float)o[1] + acc[1]); o[2] = (_Float16)((float)o[2] + acc[2]); o[3] = (_Float16)((float)o[3] + acc[3]);
                *(h16x4*)yp[j] = o; }
        }
#undef SC2_PBLOAD
        __syncthreads();
    }
}
#undef SC2_SLOT
#undef SC2_BAR
}

__device__ __forceinline__ void ph_readout(KP p) {
    const int tid = threadIdx.x, lane = tid & 63, wave = tid >> 6;
    unsigned char* ws = p.ws;
    const _Float16* RKV = (const _Float16*)(ws + WS_RKV); const _Float16* A16 = (const _Float16*)(ws + WS_A16); const _Float16* G16 = (const _Float16*)(ws + WS_G16);
    const _Float16* YS = (const _Float16*)((const unsigned char*)p.out + DO_YS); bf16_t* MIX = (bf16_t*)((unsigned char*)p.out + DO_MIX);
    const int gw = blockIdx.x * NWAVES + wave, NGW = gridDim.x * NWAVES; const int c0 = lane * 8;
    float gng[8], gnb[8], ka_[8], rk_[8];
#pragma unroll
    for (int i = 0; i < 8; ++i) { gng[i] = p.in[I_GNG][c0 + i]; gnb[i] = p.in[I_GNB][c0 + i]; ka_[i] = p.in[I_KA][c0 + i]; rk_[i] = p.in[I_RK][c0 + i]; }
    ER(8) for (int row = gw; row < ML; row += NGW) {
        const h16x8 y0 = *(const h16x8*)(YS + (size_t)row * 512 + c0), y1 = *(const h16x8*)(YS + ((size_t)ML + row) * 512 + c0);
        const h16x8 r8 = *(const h16x8*)(RKV + (size_t)row * 1536 + c0), k8 = *(const h16x8*)(RKV + (size_t)row * 1536 + 512 + c0), v8 = *(const h16x8*)(RKV + (size_t)row * 1536 + 1024 + c0);
        const h16x8 a0 = *(const h16x8*)(A16 + (size_t)row * 512 + c0), a1 = *(const h16x8*)(A16 + ((size_t)MA + row) * 512 + c0), g8 = *(const h16x8*)(G16 + (size_t)row * 512 + c0);
        float y[8]; float s = 0.f, bo = 0.f;
#pragma unroll
        for (int i = 0; i < 8; ++i) { y[i] = (float)y0[i] + (float)y1[i]; s += y[i];
            const float ksum = (float)k8[i] * (2.0f + ((float)a0[i] + (float)a1[i] - 2.0f) * ka_[i]); bo += (float)r8[i] * ksum * rk_[i]; }
        s += __shfl_xor(s, 1); s += __shfl_xor(s, 2); s += __shfl_xor(s, 4);
        bo += __shfl_xor(bo, 1); bo += __shfl_xor(bo, 2); bo += __shfl_xor(bo, 4);
        const float mu = s * (1.f / 64.f); float q = 0.f;
#pragma unroll
        for (int i = 0; i < 8; ++i) { y[i] -= mu; q += y[i] * y[i]; }
        q += __shfl_xor(q, 1); q += __shfl_xor(q, 2); q += __shfl_xor(q, 4);
        const float rstd = 1.0f / sqrtf(q * (1.f / 64.f) + GN_EPS);
        float o[8];
#pragma unroll
        for (int i = 0; i < 8; ++i) o[i] = (y[i] * rstd * gng[i] + gnb[i] + bo * (float)v8[i]) * (float)g8[i];
        u32x4 w; w.x = cvt_pk_bf16(o[0], o[1]); w.y = cvt_pk_bf16(o[2], o[3]); w.z = cvt_pk_bf16(o[4], o[5]); w.w = cvt_pk_bf16(o[6], o[7]);
        *(u32x4*)(MIX + (size_t)row * 1024 + c0) = w;
    }
}

__device__ __forceinline__ void ph_ln1_router(KP p, LAS unsigned char* lds) {
    const int tid = threadIdx.x, lane = tid & 63, wave = tid >> 6;
    unsigned char* ws = p.ws;
    _Float16* X1 = (_Float16*)(ws + WS_X1); bf16_t* XM2 = (bf16_t*)(ws + WS_XM2);
    float* AFF = (float*)(ws + WS_AFF); int* SLOT = (int*)(ws + WS_SLOT); const float* mod = (const float*)(ws + WS_MOD);
    LAS float* rt = (LAS float*)lds;
    LAS float* vec = (LAS float*)(lds + 65536);
    for (int i = tid; i < 1024 * 16; i += NTHREADS) rt[(i & 15) * 1024 + (i >> 4)] = p.in[I_ROUTER][i];
    for (int i = tid; i < 2048; i += NTHREADS) vec[3072 + i] = i < 1024 ? p.in[I_LN1G][i] : p.in[I_LN1B][i - 1024];
    const int G = gridDim.x, RPB = (((ML + G - 1) / G) + 15) & ~15;
    const int r0 = blockIdx.x * RPB, r1 = (r0 + RPB < ML) ? r0 + RPB : ML;
    const bf16_t* MO = (const bf16_t*)(ws + WS_Y1); const float* Xin = p.in[I_X];
    int curb = -1;
    f32x4 xa[4], xb[4]; u32x2 ma[4], mb[4];
#define LN1_LOAD(X, M, row_) do { const int rr_ = (row_) < r1 ? (row_) : (r1 - 8 + wave); const size_t o_ = (size_t)rr_ * D + lane * 4; \
    _Pragma("unroll") for (int q = 0; q < 4; ++q) { X[q] = *(const f32x4*)(Xin + o_ + q * 256); M[q] = *(const u32x2*)(MO + o_ + q * 256); } } while (0)
    if (r0 < ML) { LN1_LOAD(xa, ma, r0 + wave); LN1_LOAD(xb, mb, r0 + 8 + wave); }
#define LN1_HEAD(X, M, U, row_, nxt_) do { const int row = (row_); \
        f32x4 v[4]; float s = 0.f; \
        _Pragma("unroll") for (int q = 0; q < 4; ++q) { const f32x4 gv = *(const LAS f32x4*)(lds + lb1 + q * 1024), mv = {bflo(M[q].x), bfhi(M[q].x), bflo(M[q].y), bfhi(M[q].y)}; \
            v[q] = X[q] * ALPHA + gv * mv; s += (v[q].x + v[q].y) + (v[q].z + v[q].w); } \
        LN1_LOAD(X, M, nxt_); \
        float mean = wave_sum(s) * (1.f / D); float s2 = 0.f; \
        _Pragma("unroll") for (int q = 0; q < 4; ++q) { v[q] = v[q] - mean; s2 += (v[q].x * v[q].x + v[q].y * v[q].y) + (v[q].z * v[q].z + v[q].w * v[q].w); } \
        float rstd = __builtin_amdgcn_rsqf(wave_sum(s2) * (1.f / D) + LN_EPS); \
        s = 0.f; \
        _Pragma("unroll") for (int q = 0; q < 4; ++q) { const int c = q * 256 + lane * 4; const f32x4 g = *(const LAS f32x4*)(lds + lb1 + 12288 + q * 1024), bb = *(const LAS f32x4*)(lds + lb1 + 16384 + q * 1024); \
            v[q] = v[q] * rstd * g + bb; { h16x4 hv_ = {(_Float16)v[q].x, (_Float16)v[q].y, (_Float16)v[q].z, (_Float16)v[q].w}; *(h16x4*)(X1 + (size_t)row * D + c) = hv_; } s += (v[q].x + v[q].y) + (v[q].z + v[q].w); } \
        mean = wave_sum(s) * (1.f / D); s2 = 0.f; \
        _Pragma("unroll") for (int q = 0; q < 4; ++q) { v[q] = v[q] - mean; s2 += (v[q].x * v[q].x + v[q].y * v[q].y) + (v[q].z * v[q].z + v[q].w * v[q].w); } \
        rstd = __builtin_amdgcn_rsqf(wave_sum(s2) * (1.f / D) + LN_EPS); \
        _Pragma("unroll") for (int q = 0; q < 4; ++q) { const int c = q * 256 + lane * 4; const f32x4 a1 = *(const LAS f32x4*)(lds + lb1 + 8192 + q * 1024), bsh = *(const LAS f32x4*)(lds + lb1 + 4096 + q * 1024); \
            U[q] = v[q] * rstd * a1 + bsh; \
            u32x2 w; w.x = cvt_pk_bf16(U[q].x, U[q].y); w.y = cvt_pk_bf16(U[q].z, U[q].w); *(u32x2*)(XM2 + (size_t)row * D + c) = w; } } while (0)
#define LN1_TAIL(CMP, row_) do { const int row = (row_); const int b = row >> 13, t = row & (T - 1); \
        float lg[16]; \
        _Pragma("unroll") for (int e = 0; e < 16; ++e) lg[e] = acc[e].CMP; \
        float t8[8], t4[4]; \
        _Pragma("unroll") for (int e = 0; e < 8; ++e) { const auto r = __builtin_amdgcn_permlane32_swap(__float_as_uint(lg[e]), __float_as_uint(lg[e + 8]), false, false); t8[e] = __uint_as_float(r[0]) + __uint_as_float(r[1]); } \
        _Pragma("unroll") for (int e = 0; e < 4; ++e) { const auto r = __builtin_amdgcn_permlane16_swap(__float_as_uint(t8[e]), __float_as_uint(t8[e + 4]), false, false); t4[e] = __uint_as_float(r[0]) + __uint_as_float(r[1]); } \
        const bool o0 = lane & 1, o1 = lane & 2; \
        const float w0 = (o0 ? t4[1] : t4[0]) + dppf<0xB1>(o0 ? t4[0] : t4[1]), w1 = (o0 ? t4[3] : t4[2]) + dppf<0xB1>(o0 ? t4[2] : t4[3]); \
        float z = (o1 ? w1 : w0) + dppf<0x4E>(o1 ? w0 : w1); \
        z += dppf<0x124>(z); z += dppf<0x128>(z); \
        float mx = fmaxf(z, dppf<0xB1>(z)); mx = fmaxf(mx, dppf<0x4E>(mx)); mx = fmaxf(mx, dppf<0x141>(mx)); mx = fmaxf(mx, dppf<0x140>(mx)); \
        { const auto r = __builtin_amdgcn_permlane16_swap(__float_as_uint(mx), __float_as_uint(mx), false, false); mx = fmaxf(__uint_as_float(r[0]), __uint_as_float(r[1])); } \
        { const auto r = __builtin_amdgcn_permlane32_swap(__float_as_uint(mx), __float_as_uint(mx), false, false); mx = fmaxf(__uint_as_float(r[0]), __uint_as_float(r[1])); } \
        const float ez = __expf(z - mx); const float den = wave_sum(ez) * 0.25f;          \
        if (((lane >> 2) & 3) == 0) { const int e = (lane & 3) + 4 * (lane >> 4); AFF[((size_t)b * 16 + e) * T + t] = ez * __builtin_amdgcn_rcpf(den); SLOT[(size_t)row * 16 + e] = -1; } } while (0)
    for (int rb = r0; rb < r1; rb += 16) {
        const int b = rb >> 13;
        if (b != curb) { __syncthreads();
            for (int i = tid; i < 3072; i += NTHREADS) { const float x = mod[b * 6144 + 2048 + i]; vec[i] = (i >= 2048) ? x + 1.0f : x; }
            __syncthreads(); curb = b; }
        int lb0 = lane * 16, lb1 = 65536 + lane * 16; asm volatile("" : "+v"(lb0), "+v"(lb1));
        f32x4 ua[4], ub[4];
        LN1_HEAD(xa, ma, ua, rb + wave, rb + 16 + wave);
        __builtin_amdgcn_sched_barrier(0);
        LN1_HEAD(xb, mb, ub, rb + 8 + wave, rb + 24 + wave);
        __builtin_amdgcn_sched_barrier(0);
        f32x2 acc[16];
#pragma unroll
        for (int e = 0; e < 16; ++e) acc[e] = (f32x2){0.f, 0.f};
#pragma unroll
        for (int q = 0; q < 4; ++q) {
            const f32x2 u0 = {ua[q].x, ub[q].x}, u1 = {ua[q].y, ub[q].y}, u2 = {ua[q].z, ub[q].z}, u3 = {ua[q].w, ub[q].w};
#pragma unroll
            for (int eh = 0; eh < 16; eh += 8) { f32x4 r[8];
#pragma unroll
                for (int e = 0; e < 8; ++e) r[e] = *(const LAS f32x4*)(lds + lb0 + (eh + e) * 4096 + q * 1024);
#pragma unroll
                for (int e = 0; e < 8; ++e) { f32x2 t = acc[eh + e];
                    t = __builtin_elementwise_fma(u0, (f32x2){r[e].x, r[e].x}, t); t = __builtin_elementwise_fma(u1, (f32x2){r[e].y, r[e].y}, t);
                    t = __builtin_elementwise_fma(u2, (f32x2){r[e].z, r[e].z}, t); t = __builtin_elementwise_fma(u3, (f32x2){r[e].w, r[e].w}, t); acc[eh + e] = t; }
                __builtin_amdgcn_sched_barrier(0); } }
        LN1_TAIL(x, rb + wave);
        __builtin_amdgcn_sched_barrier(0);
        LN1_TAIL(y, rb + 8 + wave);
        __builtin_amdgcn_sched_barrier(0);
    }
#undef LN1_HEAD
#undef LN1_TAIL
#undef LN1_LOAD
#undef LN1_ROW
}

__device__ __forceinline__ void ph_expert_weights(KP p, LAS unsigned char* lds) {
    const int tid = threadIdx.x, lane = tid & 63, wave = tid >> 6;
    unsigned char* ws = p.ws;
    const int gw = blockIdx.x * NWAVES + wave, NGW = gridDim.x * NWAVES;
    {
        LAS float* scr = (LAS float*)(lds + wave * 8448);
        bf16_t* WGU = (bf16_t*)(ws + WS_WGU); bf16_t* WD = (bf16_t*)(ws + WS_WD);
        constexpr int PER = 16 * 32;
#ifndef TOPK_ITEMS
#define TOPK_ITEMS 9
#endif
        constexpr int NIT = 3 * 16 * PER; const int G = gridDim.x, bx = blockIdx.x;
        int ibase, icnt;
        if (G == 256 && (NIT - 64 * 8 * TOPK_ITEMS) % (192 * 8) == 0) { constexpr int CN = (NIT - 64 * 8 * TOPK_ITEMS) / (192 * 8);
            if (bx < 64) { icnt = TOPK_ITEMS; ibase = 192 * 8 * CN + bx * 8 * TOPK_ITEMS; } else { icnt = CN; ibase = (bx - 64) * 8 * CN; } }
        else { icnt = (NIT + NGW - 1) / NGW; ibase = bx * 8 * icnt; }
        ER(11) for (int ii = 0; ii < icnt; ++ii) { const int it = ibase + ii * 8 + wave; if (it >= NIT) break;
            const int which = it / (16 * PER), r = it % (16 * PER), e = r / PER, kb = (r % PER) / 32, nb = r % 32;
            if (which < 2) { const float* W = p.in[which == 0 ? I_EG : I_EU] + (size_t)e * 1024 * 1024; const int f0 = nb * 32;
                const int drow = 256 * (f0 >> 7) + (which == 1 ? 128 : 0) + (f0 & 127);
                transpose_item(W, 1024, kb * 64, f0, WGU + ((size_t)e * 2048 + drow) * 1024 + kb * 64, 1024, nullptr, scr, lane); }
            else { const float* W = p.in[I_ED] + (size_t)e * 1024 * 1024;
                transpose_item(W, 1024, kb * 64, nb * 32, WD + ((size_t)e * 1024 + nb * 32) * 1024 + kb * 64, 1024, nullptr, scr, lane); }
        }
    }
}

__device__ __forceinline__ void ph_topk(KP p, LAS unsigned char* lds) {
    const int tid = threadIdx.x, lane = tid & 63, wave = tid >> 6;
    unsigned char* ws = p.ws;
    const float* AFF = (const float*)(ws + WS_AFF); int* SLOT = (int*)(ws + WS_SLOT); int* IDX = (int*)(ws + WS_IDX); float* GATE = (float*)(ws + WS_GATE);
    LAS unsigned* hist = (LAS unsigned*)lds;
    LAS unsigned* sh = (LAS unsigned*)(lds + 1024);
    for (int prob = blockIdx.x; prob < 64; prob += gridDim.x) {
        const int b = prob >> 4, e = prob & 15;
        const float* av = AFF + (size_t)prob * T;
        unsigned key[16];
#pragma unroll
        for (int i = 0; i < 4; ++i) { const u32x4 x = *(const u32x4*)(av + tid * 16 + i * 4); key[4 * i] = x.x; key[4 * i + 1] = x.y; key[4 * i + 2] = x.z; key[4 * i + 3] = x.w; }
        unsigned prefix = 0, kth = CAP;
        for (int pass = 0; pass < 4; ++pass) {
            const int shift = 24 - 8 * pass; const unsigned himask = pass == 0 ? 0u : (0xffffffffu << (shift + 8));
            if (tid < 256) hist[tid] = 0u;
            __syncthreads();
#pragma unroll
            for (int i = 0; i < 16; ++i) if ((key[i] & himask) == prefix) atomicAdd((unsigned*)&hist[(key[i] >> shift) & 255u], 1u);
            __syncthreads();
            if (wave == 0) {
                const u32x4 h4 = *(const LAS u32x4*)(hist + lane * 4); const unsigned sl = h4.x + h4.y + h4.z + h4.w; unsigned suf = sl;
#pragma unroll
                for (int o = 1; o < 64; o <<= 1) { const unsigned tt = __shfl_down(suf, o); if (lane + o < 64) suf += tt; }
                const unsigned above = suf - sl;
                if (above < kth && kth <= suf) { unsigned cum = above; int d;
                    if (cum + h4.w >= kth) d = 3; else { cum += h4.w; if (cum + h4.z >= kth) d = 2; else { cum += h4.z; if (cum + h4.y >= kth) d = 1; else { cum += h4.y; d = 0; } } }
                    sh[0] = prefix | ((unsigned)(4 * lane + d) << shift); sh[1] = kth - cum; } }
            __syncthreads();
            prefix = sh[0]; kth = sh[1];
            __syncthreads();
        }
        unsigned ngt = 0, neq = 0;
#pragma unroll
        for (int i = 0; i < 16; ++i) { ngt += key[i] > prefix; neq += key[i] == prefix; }
        unsigned ig = ngt, iq = neq;
#pragma unroll
        for (int o = 1; o < 64; o <<= 1) { const unsigned a = __shfl_up(ig, o), c = __shfl_up(iq, o); if (lane >= o) { ig += a; iq += c; } }
        if (lane == 63) { sh[8 + wave] = ig; sh[16 + wave] = iq; }
        __syncthreads();
        unsigned og = 0, oq = 0;
        for (int w = 0; w < wave; ++w) { og += sh[8 + w]; oq += sh[16 + w]; }
        unsigned eg = og + ig - ngt, eq = oq + iq - neq;
        const int sbase = (e * 4 + b) * CAP;
#pragma unroll
        for (int i = 0; i < 16; ++i) {
            const int t = tid * 16 + i; bool take = false;
            if (key[i] > prefix) take = true; else if (key[i] == prefix) { take = eq < kth; }
            if (take) { const unsigned eqsel = eq < kth ? eq : kth; const int c = (int)(eg + eqsel);
                IDX[sbase + c] = t; GATE[sbase + c] = __uint_as_float(key[i]); SLOT[((size_t)b * T + t) * 16 + e] = c; }
            if (key[i] > prefix) ++eg; else if (key[i] == prefix) ++eq;
        }
        __syncthreads();
    }
}

__device__ __forceinline__ void ph_final(KP p) {
    const int tid = threadIdx.x, lane = tid & 63, wave = tid >> 6;
    unsigned char* ws = p.ws;
    const _Float16* X1 = (const _Float16*)(ws + WS_X1); const bf16_t* YE = (const bf16_t*)(ws + WS_YE); const int* SLOT = (const int*)(ws + WS_SLOT); const float* mod = (const float*)(ws + WS_MOD);
    const int gw = blockIdx.x * NWAVES + wave, NGW = gridDim.x * NWAVES;
    if (gw >= ML) return;
#define FIN_ROWC(r_) ((r_) < ML ? (r_) : gw)
#define FIN_SLOTS(r_) (lane < 16 ? SLOT[(size_t)FIN_ROWC(r_) * 16 + lane] : -1)
#define FIN_GATHER(W, NE, REST, sl_, r_) do { unsigned long long act_ = __ballot((sl_) >= 0); const int b_ = FIN_ROWC(r_) >> 13; NE = 0; \
        _Pragma("unroll") for (int i = 0; i < 4; ++i) { const bool on_ = act_ != 0; const int e_ = on_ ? __builtin_ctzll(act_) : 0; if (on_) { act_ &= act_ - 1; NE = i + 1; } \
            const int c_ = __shfl((sl_), e_); const bf16_t* yr_ = YE + ((size_t)(e_ * 4 + b_) * CAP + (c_ < 0 ? 0 : c_)) * 1024; \
            if (on_) { _Pragma("unroll") for (int q = 0; q < 4; ++q) W[i][q] = *(const u32x2*)(yr_ + q * 256 + lane * 4); } } \
        REST = act_; } while (0)
    int s1 = FIN_SLOTS(gw), s2 = FIN_SLOTS(gw + NGW);
    f32x4 nx[4]; u32x2 nw[4][4]; int nne; unsigned long long nrest;
#pragma unroll
    for (int q = 0; q < 4; ++q) { const h16x4 hv_ = *(const h16x4*)(X1 + (size_t)gw * D + q * 256 + lane * 4); nx[q] = (f32x4){(float)hv_[0], (float)hv_[1], (float)hv_[2], (float)hv_[3]}; }
    FIN_GATHER(nw, nne, nrest, s1, gw);
    ER(14) for (int row = gw; row < ML; row += NGW) {
        const int b = row >> 13;
        const int myslot = s1; const int ne = nne; unsigned long long rest = nrest;
        f32x4 v[4]; u32x2 w[4][4];
#pragma unroll
        for (int q = 0; q < 4; ++q) v[q] = nx[q];
#pragma unroll
        for (int i = 0; i < 4; ++i)
#pragma unroll
            for (int q = 0; q < 4; ++q) w[i][q] = nw[i][q];
        s1 = s2; s2 = FIN_SLOTS(row + 2 * NGW);
        { const int nr = FIN_ROWC(row + NGW);
#pragma unroll
          for (int q = 0; q < 4; ++q) { const h16x4 hv_ = *(const h16x4*)(X1 + (size_t)nr * D + q * 256 + lane * 4); nx[q] = (f32x4){(float)hv_[0], (float)hv_[1], (float)hv_[2], (float)hv_[3]}; }
          FIN_GATHER(nw, nne, nrest, s1, row + NGW); }
        f32x4 m[4];
#pragma unroll
        for (int q = 0; q < 4; ++q) m[q] = (f32x4){0.f, 0.f, 0.f, 0.f};
#pragma unroll
        for (int i = 0; i < 4; ++i) if (i < ne) {
#pragma unroll
            for (int q = 0; q < 4; ++q) { m[q].x += bflo(w[i][q].x); m[q].y += bfhi(w[i][q].x); m[q].z += bflo(w[i][q].y); m[q].w += bfhi(w[i][q].y); } }
        while (rest) {
            const int e = __builtin_ctzll(rest); rest &= rest - 1;
            const int c = __shfl(myslot, e); const bf16_t* yr = YE + ((size_t)(e * 4 + b) * CAP + (c < 0 ? 0 : c)) * 1024;
#pragma unroll
            for (int q = 0; q < 4; ++q) { const u32x2 ww = *(const u32x2*)(yr + q * 256 + lane * 4); m[q].x += bflo(ww.x); m[q].y += bfhi(ww.x); m[q].z += bflo(ww.y); m[q].w += bfhi(ww.y); } }
        float s = 0.f;
#pragma unroll
        for (int q = 0; q < 4; ++q) { const int c = q * 256 + lane * 4; const f32x4 g2 = *(const f32x4*)(mod + b * 6144 + 5120 + c);
            v[q] = v[q] * ALPHA + g2 * m[q]; s += (v[q].x + v[q].y) + (v[q].z + v[q].w); }
        const float mean = wave_sum(s) * (1.f / D); float s2v = 0.f;
#pragma unroll
        for (int q = 0; q < 4; ++q) { v[q] = v[q] - mean; s2v += (v[q].x * v[q].x + v[q].y * v[q].y) + (v[q].z * v[q].z + v[q].w * v[q].w); }
        const float rstd = __builtin_amdgcn_rsqf(wave_sum(s2v) * (1.f / D) + LN_EPS);
#pragma unroll
        for (int q = 0; q < 4; ++q) { const int c = q * 256 + lane * 4; const f32x4 g = *(const f32x4*)(p.in[I_LN2G] + c), bb = *(const f32x4*)(p.in[I_LN2B] + c);
            *(f32x4*)(p.out + (size_t)row * D + c) = v[q] * rstd * g + bb; }
    }
#undef FIN_ROWC
#undef FIN_SLOTS
#undef FIN_GATHER
}

__global__ void __launch_bounds__(NTHREADS, 2) mega(Params p_unused) {
    const Params __attribute__((address_space(4)))* pq = (const Params __attribute__((address_space(4)))*)__builtin_amdgcn_kernarg_segment_ptr();
    KP p = *pq;
    extern __shared__ __attribute__((aligned(16))) unsigned char lds_raw[];
    LAS unsigned char* lds = (LAS unsigned char*)lds_raw;
    cg::grid_group grid = cg::this_grid();
    unsigned char* ws = p.ws;
    const int lo = p.ph_lo, hi = p.ph_hi;
    const int G = gridDim.x, bx = blockIdx.x;
    volatile LAS unsigned* xst = (volatile LAS unsigned*)(lds + LDS_BYTES - 64);
    if (threadIdx.x < 4) xst[threadIdx.x] = 0u;
    __syncthreads();
    const XcdBarrier xbar = xcd_barrier_post((unsigned*)(ws + WS_CTL), xst);
#ifndef PHMASK
#define PHMASK 0x7fff
#endif
#define IN(k) ((((PHMASK) >> (k)) & 1) && lo <= (k) && (k) < hi)
#define SEAM(k) do { if (IN(k) && IN((k) + 1)) { if (lo < 0) grid.sync(); else xcd_barrier(xbar); } } while (0)
#ifndef DUPMASK
#define DUPMASK 0
#endif
#ifndef GDUP
#define GDUP 0
#endif
#define GD(k) ((((GDUP) >> (k)) & 1) + 1)
#define REPL(k) for (int repl_ = 0; repl_ <= (((DUPMASK) >> (k)) & 1); ++repl_, __syncthreads())
#define REP(k) for (int rep_ = 0; rep_ <= (((DUPMASK) >> (k)) & 1); ++rep_, ((((DUPMASK) >> (k)) & 1) && rep_ == 1 ? grid.sync() : (void)0))
    if (IN(0)) REP(0) { ph_mod_and_weights(p, lds); } SEAM(0);
    if (IN(1)) REP(1) { ph_modulate1(p); } SEAM(1);
    if (IN(2)) REP(2) {
        pg8::Gemm g{(const bf16_t*)(ws + WS_XM), (const bf16_t*)(ws + WS_WIN), 1024, 1024}; pg8::DenseOrder S; S.init(MA, NHP, G, bx, GD(2));
        EpiH E{(bf16_t*)(ws + WS_H)}; pg8::gemm_phase(lds, g, S, E); } SEAM(2);
    if (IN(3)) REP(3) { ph_prepare(p); } SEAM(3);
    if (IN(4)) REP(4) {
        { pg8::Gemm g{(const bf16_t*)(ws + WS_H) + 1920, (const bf16_t*)(ws + WS_WUQ), 256, NHP}; pg8::DenseOrder S; S.init(ML, 768, G, bx, GD(4));
          EpiQ E{(bf16_t*)(ws + WS_Q), (const float*)(ws + WS_RSTDQ)}; pg8::gemm_phase(lds, g, S, E); }
        { pg8::Gemm g{(const bf16_t*)(ws + WS_H) + 2176, (const bf16_t*)(ws + WS_WUKV), 256, NHP}; pg8::DenseOrder S; S.init(MA, 1024, G, bx, GD(4));
          EpiKV E{(bf16_t*)(ws + WS_K), (bf16_t*)(ws + WS_V), (const float*)(ws + WS_RSTDKV)}; pg8::gemm_phase(lds, g, S, E); } } SEAM(4);
    if (IN(5)) REP(5) {
        pg8::Gemm g{(const bf16_t*)(ws + WS_ACT), (const bf16_t*)(ws + WS_WLORA), 128, 384}; pg8::LoraOrder S; S.init(MA, 2560, G, bx, GD(5));
        EpiLora E{(_Float16*)(ws + WS_E16), (_Float16*)(ws + WS_A16), (_Float16*)(ws + WS_G16), p.in[I_W0], p.in[I_A0]}; pg8::gemm_phase(lds, g, S, E); } SEAM(5);
    if (IN(6)) REP(6) {
        const int vcu = (G % 8 == 0) ? (bx % 8) * (G / 8) + bx / 8 : bx;
#ifndef MIXGRP
#define MIXGRP 2
#endif
        const int grp = (MIXGRP == 1) ? 0 : ((G % 8 == 0) ? (bx / 8) % MIXGRP : bx % MIXGRP);
        const int scan_slot = (MIXGRP == 1) ? 2 : (MIXGRP == 2 ? (grp == 0 ? 2 : 0) : 2 - grp);
        int au = vcu; const int natt = vcu < 512 ? (512 - vcu + G - 1) / G : 0; const int sslot = scan_slot < natt ? scan_slot : natt;
        for (int slot = 0; slot <= natt; ++slot) {
            if (slot == sslot) { sc2::pass_a(p, lds); __syncthreads(); }
            else { const int unit = au; au += G; const int bh = unit >> 5, qb = unit & 31; const int b = bh >> 2, hh = bh & 3;
                att2::attn_unit((const bf16_t*)(ws + WS_Q) + ((size_t)bh * T + qb * 256) * 192, (const bf16_t*)(ws + WS_K) + (size_t)bh * SKV * 192, (const bf16_t*)(ws + WS_V) + (size_t)bh * SKV * 128,
                               (bf16_t*)((unsigned char*)p.out + DO_MIX) + ((size_t)b * T + qb * 256) * 1024 + 512 + hh * 128, lds);
                __syncthreads(); }
        }
        } SEAM(6);
    if (IN(7)) REP(7) { sc2::pass_b(p, lds); } SEAM(7);
    if (IN(8)) REP(8) { ph_readout(p); } SEAM(8);
    if (IN(9)) REP(9) {
        pg8::Gemm g{(const bf16_t*)((unsigned char*)p.out + DO_MIX), (const bf16_t*)(ws + WS_WOUT), 1024, 1024}; pg8::DenseOrder S; S.init(ML, 1024, G, bx, GD(9));
        EpiMix E{(bf16_t*)(ws + WS_Y1)}; pg8::gemm_phase(lds, g, S, E); } SEAM(9);
    if (IN(10)) REP(10) { ph_ln1_router(p, lds); } SEAM(10);
    if (IN(11)) REP(11) { ph_topk(p, lds); __syncthreads(); ph_expert_weights(p, lds); } SEAM(11);
    if (IN(12)) REP(12) {
        pg8::Gemm g{(const bf16_t*)(ws + WS_XM2), (const bf16_t*)(ws + WS_WGU), 1024, 1024}; GuOrder S{G, bx, (const int*)(ws + WS_IDX), GD(12)};
        EpiHid E{(bf16_t*)(ws + WS_HID)}; pg8::gemm_phase(lds, g, S, E); } SEAM(12);
    if (IN(13)) REP(13) {
        pg8::Gemm g{(const bf16_t*)(ws + WS_HID), (const bf16_t*)(ws + WS_WD), 1024, 1024}; DnOrder S{G, bx, GD(13)};
        EpiYe E{(bf16_t*)(ws + WS_YE), (const float*)(ws + WS_GATE)}; pg8::gemm_phase(lds, g, S, E); } SEAM(13);
    if (IN(14)) REP(14) { ph_final(p); }
#undef IN
#undef SEAM
}

extern "C" void kernel_launch(void* const* d_in, const int* in_sizes, int n_in, void* d_out, int out_size, void* d_ws, size_t ws_size, hipStream_t stream) {
    static int grid_blocks = 0;
    if (grid_blocks == 0) {
        if (n_in != 32 || out_size != ML * D || ws_size < WS_END) { fprintf(stderr, "kernel_launch: unexpected shapes: n_in %d out %d ws %zu (need %zu)\n", n_in, out_size, ws_size, (size_t)WS_END); grid_blocks = -1; return; }
        int dev = 0, cus = 0, per_cu = 0;
        (void)hipGetDevice(&dev);
        (void)hipDeviceGetAttribute(&cus, hipDeviceAttributeMultiprocessorCount, dev);
        (void)hipFuncSetAttribute((const void*)mega, hipFuncAttributeMaxDynamicSharedMemorySize, LDS_BYTES);
        (void)hipOccupancyMaxActiveBlocksPerMultiprocessor(&per_cu, (const void*)mega, NTHREADS, LDS_BYTES);
        if (per_cu < 1) { fprintf(stderr, "kernel_launch: occupancy query says %d blocks per CU\n", per_cu); grid_blocks = -1; return; }
        grid_blocks = cus;
    }
    if (grid_blocks < 0) return;
    if (hipMemsetAsync((char*)d_ws + WS_CTL, 0, CTL_BYTES, stream) != hipSuccess) { fprintf(stderr, "kernel_launch: memset failed\n"); return; }
    Params p{};
    for (int i = 0; i < 32; ++i) p.in[i] = (const float*)d_in[i];
    p.out = (float*)d_out; p.ws = (unsigned char*)d_ws; p.ph_lo = 0; p.ph_hi = NPHASE;
    void* args[] = {&p};
    hipError_t e = hipLaunchCooperativeKernel((const void*)mega, dim3(grid_blocks), dim3(NTHREADS), args, LDS_BYTES, stream);
    if (e != hipSuccess) fprintf(stderr, "kernel_launch: cooperative launch failed: %s (grid %d)\n", hipGetErrorString(e), grid_blocks);
}
```

```cpp
#include <hip/hip_runtime.h>
#include <hip/hip_cooperative_groups.h>
#include <cstdio>
#include <cstdint>
namespace cg = cooperative_groups;
#ifndef EDUP
#define EDUP 0
#endif
#define ER(k) for (int er_ = 0; er_ <= (((EDUP) >> (k)) & 1); ++er_)

#define LAS __attribute__((address_space(3)))
typedef unsigned short bf16_t;
typedef short bf16x8 __attribute__((ext_vector_type(8)));
typedef short s16x4 __attribute__((ext_vector_type(4)));
typedef float f32x2 __attribute__((ext_vector_type(2)));
typedef float f32x4 __attribute__((ext_vector_type(4)));
typedef float f32x16 __attribute__((ext_vector_type(16)));
typedef unsigned u32x2 __attribute__((ext_vector_type(2)));
typedef unsigned u32x4 __attribute__((ext_vector_type(4)));
typedef _Float16 h16x8 __attribute__((ext_vector_type(8)));
typedef _Float16 h16x4 __attribute__((ext_vector_type(4)));

constexpr int NB = 4, T = 8192, D = 1024, CTX = 256, SKV = T + CTX;
constexpr int ML = NB * T, MC = NB * CTX, MA = ML + MC;
constexpr int NHP = 2560, IN_PROJ = 2496;
constexpr int NE = 16, CAP = 1024, NSLOT = NE * NB * CAP;
constexpr int NTHREADS = 512, NWAVES = 8;
constexpr int LDS_BYTES = 163840;
constexpr int NPHASE = 15;
#ifndef USE_DIRECT_SCAN
#define USE_DIRECT_SCAN 0
#endif
constexpr float LN_EPS = 1e-5f, RMS_EPS = 1e-6f, GN_EPS = 64e-5f;
constexpr float ALPHA = 1.189207115002721f;

constexpr size_t MiB = 1u << 20;
constexpr size_t WS_CTL = 0, CTL_BYTES = 16384;
constexpr size_t WS_MOD = 1 * MiB, WS_RSTDQ = 1 * MiB + 256 * 1024, WS_RSTDKV = 1 * MiB + 512 * 1024;
constexpr size_t WS_WIN = 2 * MiB, WS_WLORA = 7 * MiB, WS_WUQ = 9 * MiB, WS_WUKV = 9 * MiB + 512 * 1024, WS_WOUT = 10 * MiB;
constexpr size_t WS_RN = 12 * MiB;
constexpr size_t WS_H = 16 * MiB;
constexpr size_t SZ_L16 = (size_t)MA * 512 * 2;
constexpr size_t WS_E16 = WS_H, WS_A16 = WS_H + 2 * SZ_L16, WS_G16 = WS_H + 4 * SZ_L16;
constexpr size_t WS_Y1 = 16 * MiB, WS_HID = 16 * MiB;
constexpr size_t WS_WD = 144 * MiB, WS_WGU = 176 * MiB, WS_XM2 = 240 * MiB, WS_YE = 176 * MiB;
constexpr size_t WS_RKV = 181 * MiB;
constexpr size_t WS_XM = 280 * MiB, WS_ACT = 280 * MiB;
constexpr size_t WS_Q = 346 * MiB, WS_K = 394 * MiB, WS_V = 444 * MiB, WS_X1 = 346 * MiB;
constexpr size_t WS_AFF = 478 * MiB, WS_SLOT = 480 * MiB, WS_IDX = 482 * MiB, WS_GATE = 482 * MiB + 512 * 1024;
constexpr size_t WS_QC0 = 280 * MiB, WS_SEG = 314 * MiB, WS_QC1 = 477 * MiB;
constexpr size_t WS_END = 510 * MiB;
constexpr size_t DO_YS = 0, DO_MIX = 64 * MiB;

struct Params { const float* in[32]; float* out; unsigned char* ws; int ph_lo, ph_hi; };
typedef const Params __attribute__((address_space(4)))& KP;
enum { I_X = 0, I_C, I_CTX, I_CCTX, I_WADA, I_BADA, I_WIN, I_CONV, I_W0, I_WUP, I_A0, I_AUP, I_GUP, I_KK, I_KA, I_RK, I_GNG, I_GNB,
       I_QNORM, I_WUQ, I_KVNORM, I_WUK, I_WUV, I_WOUT, I_LN1G, I_LN1B, I_ROUTER, I_EG, I_EU, I_ED, I_LN2G, I_LN2B };

__device__ __forceinline__ unsigned cvt_pk_bf16(float lo, float hi) { unsigned r; asm volatile("v_cvt_pk_bf16_f32 %0, %1, %2" : "=v"(r) : "v"(lo), "v"(hi)); return r; }
typedef __bf16 bf16x2_t __attribute__((ext_vector_type(2)));
__device__ __forceinline__ unsigned cvt_pk_bf16_n(float lo, float hi) { const f32x2 v = {lo, hi}; const bf16x2_t b = __builtin_convertvector(v, bf16x2_t); return __builtin_bit_cast(unsigned, b); }
__device__ __forceinline__ float bf2f(unsigned short b) { return __uint_as_float(((unsigned)b) << 16); }
__device__ __forceinline__ float bflo(unsigned w) { return __uint_as_float(w << 16); }
__device__ __forceinline__ float bfhi(unsigned w) { return __uint_as_float(w & 0xffff0000u); }
template <int CTRL> __device__ __forceinline__ float dppf(float x) { return __int_as_float(__builtin_amdgcn_update_dpp(0, __float_as_int(x), CTRL, 0xF, 0xF, true)); }
__device__ __forceinline__ float allred16(float x) { x += dppf<0xB1>(x); x += dppf<0x4E>(x); x += dppf<0x141>(x); x += dppf<0x140>(x); return x; }
__device__ __forceinline__ float wave_sum(float v) {
    v = allred16(v);
    { const auto r16 = __builtin_amdgcn_permlane16_swap(__float_as_uint(v), __float_as_uint(v), false, false); v = __uint_as_float(r16[0]) + __uint_as_float(r16[1]); }
    const auto rr = __builtin_amdgcn_permlane32_swap(__float_as_uint(v), __float_as_uint(v), false, false);
    return __uint_as_float(rr[0]) + __uint_as_float(rr[1]);
}
__device__ __forceinline__ float sigmoidf_(float x) { return __builtin_amdgcn_rcpf(1.0f + __builtin_amdgcn_exp2f(-1.4426950408889634f * x)); }
#define LDS_WAIT() asm volatile("s_waitcnt lgkmcnt(0)" ::: "memory")


#define XB_TMO      128
#define XB_XCNT(j)  (256  + 64 * (j))
#define XB_XSUB(j)  (1280 + 64 * (j))
#define XB_XGEN(j)  (2304 + 64 * (j))
#define XB_TOP      3328
#define XB_TOPGEN   3392
#define XCD_BAR_WORDS 3456
#define XB_SPIN_CAP (1u << 18)
__device__ __forceinline__ unsigned xb_ld(unsigned* p)              { return __hip_atomic_load(p, __ATOMIC_RELAXED, __HIP_MEMORY_SCOPE_AGENT); }
__device__ __forceinline__ unsigned xb_add(unsigned* p, unsigned v) { return __hip_atomic_fetch_add(p, v, __ATOMIC_RELAXED, __HIP_MEMORY_SCOPE_AGENT); }
__device__ __forceinline__ unsigned xb_xcc_id() { return (unsigned)__builtin_amdgcn_s_getreg((3 << 11) | 20) & 0xFu; }
#define XB_SPIN(cond, bar) do { unsigned _sp = 0; while (cond) { __builtin_amdgcn_s_sleep(1); \
    if ((++_sp & 255u) == 0u) { if (xb_ld(&(bar)[XB_TMO])) break; if (_sp > XB_SPIN_CAP) { atomicAdd(&(bar)[XB_TMO], 1u); break; } } } } while (0)
struct XcdBarrier { unsigned* bar; unsigned x; volatile LAS unsigned* st; };
__device__ __forceinline__ XcdBarrier xcd_barrier_post(unsigned* bar, volatile LAS unsigned* st) {
    XcdBarrier b; b.bar = bar; b.x = xb_xcc_id(); b.st = st;
    if (threadIdx.x == 0) (void)xb_add(&bar[XB_XCNT(b.x)], 1u);
    return b;
}
__device__ __forceinline__ void xcd_barrier_complete(unsigned* bar, unsigned x, unsigned& nloc, unsigned& nx) {
    const unsigned G = gridDim.x * gridDim.y * gridDim.z;
    unsigned sum, cnt, mine, sp = 0u;
    for (;;) {
        sum = 0u; cnt = 0u; mine = 0u;
#pragma unroll
        for (unsigned j = 0; j < 16; ++j) { const unsigned c = xb_ld(&bar[XB_XCNT(j)]); sum += c; cnt += (c > 0u) ? 1u : 0u; mine = (j == x) ? c : mine; }
        if (sum == G) break;
        __builtin_amdgcn_s_sleep(1);
        if ((++sp & 255u) == 0u) { if (xb_ld(&bar[XB_TMO])) break; if (sp > XB_SPIN_CAP) { atomicAdd(&bar[XB_TMO], 1u); break; } }
    }
    nloc = mine > 0u ? mine : 1u; nx = cnt > 0u ? cnt : 1u;
}
__device__ __forceinline__ void xcd_barrier(const XcdBarrier& b) {
    asm volatile("s_waitcnt vmcnt(0)" ::: "memory");
    __syncthreads();
    if (threadIdx.x == 0) {
        unsigned* bar = b.bar;
        __builtin_amdgcn_s_waitcnt(0);
        unsigned nloc = b.st[0], nx = b.st[1];
        if (nloc == 0u) { xcd_barrier_complete(bar, b.x, nloc, nx); b.st[0] = nloc; b.st[1] = nx; }
        const unsigned old = xb_add(&bar[XB_XSUB(b.x)], 1u);
        const unsigned gen = old / nloc;
        if (old + 1u == (gen + 1u) * nloc) {
            __builtin_amdgcn_fence(__ATOMIC_RELEASE, "agent");
            asm volatile("s_waitcnt vmcnt(0)" ::: "memory");
            const unsigned og = xb_add(&bar[XB_TOP], 1u);
            const unsigned tg = og / nx;
            if (og + 1u == (tg + 1u) * nx) xb_add(&bar[XB_TOPGEN], 1u);
            else XB_SPIN(xb_ld(&bar[XB_TOPGEN]) == tg, bar);
            __builtin_amdgcn_fence(__ATOMIC_ACQUIRE, "agent");
            xb_add(&bar[XB_XGEN(b.x)], 1u);
            asm volatile("s_waitcnt vmcnt(0)" ::: "memory");
        } else {
            XB_SPIN(xb_ld(&bar[XB_XGEN(b.x)]) == gen, bar);
            __builtin_amdgcn_fence(__ATOMIC_ACQUIRE, "agent");
            asm volatile("s_waitcnt vmcnt(0)" ::: "memory");
        }
    }
    __syncthreads();
}

namespace pg8 {
constexpr int BM = 256, BK = 64, HALF = 128, HTB = HALF * BK * 2, STAGE_BYTES = 8 * HTB;
__device__ __forceinline__ int lds_byte(int r, int c) { const int st = (r >> 4) * 2 + (c >> 5), rr = r & 15, cc = c & 31, ob = rr * 64 + cc * 2; return st * 1024 + (ob ^ (((ob >> 9) & 1) << 5)); }
__device__ __forceinline__ void stage_rc(int b, int& R, int& C) { const int st = b / 1024, sb = b % 1024, swz = sb ^ (((sb >> 9) & 1) << 5); R = (st >> 1) * 16 + swz / 64; C = (st & 1) * 32 + (swz % 64) / 2; }
__device__ __forceinline__ int perm32(int rho) { const int n = rho >> 4, i = rho & 15; return 8 * (i >> 2) + 4 * n + (i & 3); }
struct Unit { int pm, pn; };
struct Gemm { const bf16_t* A; const bf16_t* Bt; int K, lda; };

struct DenseOrder {
    int nM, nN, nwg, G, c, dupf;
    __device__ void init(int M, int N, int G_, int c_, int dupf_ = 1) { nM = M / BM; nN = N / BM; nwg = nM * nN; G = G_; c = c_; dupf = dupf_; }
    __device__ bool next(int i, Unit& u) const {
        const long L = (long)i * G + c; if (L >= (long)nwg * dupf) return false;
        int wgid = (int)(L % nwg); { const int q = nwg / 8, r = nwg % 8, xcd = wgid % 8, off = wgid / 8; wgid = (xcd < r ? xcd * (q + 1) : r * (q + 1) + (xcd - r) * q) + off; }
        const int nig = 8 * nN, gid = wgid / nig, fm = gid * 8, gsz = (nM - fm) < 8 ? (nM - fm) : 8;
        u.pm = fm + ((wgid % nig) % gsz); u.pn = (wgid % nig) / gsz; return true;
    }
    __device__ __forceinline__ int arow(const Unit& u, int r) const { return u.pm * BM + r; }
    __device__ __forceinline__ int acol(const Unit&) const { return 0; }
};
struct LoraOrder : DenseOrder { __device__ __forceinline__ int acol(const Unit& u) const { return u.pn < 4 ? 0 : (u.pn < 8 ? 128 : 256); } };

template <class Epi, class Sched>
__device__ __forceinline__ void gemm_phase(LAS unsigned char* lds, const Gemm g, const Sched& S, const Epi& E) {
    const int tid = threadIdx.x, wid = __builtin_amdgcn_readfirstlane(tid >> 6), lane = tid & 63, wr = wid >> 2, wc = wid & 3, fr = lane & 15, fq = lane >> 4;
    int K = g.K; asm volatile("" : "+s"(K));
    const int nt = K / BK;
    int Rr[2], Cc[2]; unsigned voffB[2];
#pragma unroll
    for (int i = 0; i < 2; ++i) { int R, C; stage_rc(tid * 16 + i * 8192, R, C); Rr[i] = R; Cc[i] = C; const int Rb = Epi::PERM ? ((R & ~31) + perm32(R & 31)) : R; voffB[i] = (unsigned)(Rb * K + C) * 2u; }
    const size_t kstep = (size_t)(BK * 2);
    const size_t hstepB = (size_t)HALF * K * 2, tstepB = 2 * hstepB;
    const unsigned ldsw = (unsigned)wid * 1024u;
    const int aoff = lds_byte(wr * 64 + fr, fq * 8), boff = lds_byte(wc * 32 + fr, fq * 8);
#define PG8_SA(b, h) (((b) * 2 + (h)) * HTB)
#define PG8_SB(b, h) ((4 + (b) * 2 + (h)) * HTB)
#define PG8_STAGE(bufoff, gbase, voff) do { _Pragma("unroll") for (int _i = 0; _i < 2; ++_i) \
        __builtin_amdgcn_global_load_lds((const unsigned*)((const char*)(gbase) + (voff)[_i]), (LAS unsigned*)(lds + (bufoff) + ldsw + _i * 8192), 16, 0, 0); } while (0)
#define PG8_LDA(dst, b, h) do { _Pragma("unroll") for (int m = 0; m < 4; ++m) _Pragma("unroll") for (int k = 0; k < 2; ++k) dst[m][k] = *(const LAS bf16x8*)(lds + PG8_SA(b, h) + aoff + m * 2048 + k * 1024); } while (0)
#define PG8_LDB(dst, b, h) do { _Pragma("unroll") for (int n = 0; n < 2; ++n) _Pragma("unroll") for (int k = 0; k < 2; ++k) dst[n][k] = *(const LAS bf16x8*)(lds + PG8_SB(b, h) + boff + n * 2048 + k * 1024); } while (0)
#define PG8_MMA(ai, bj, At, Bt) do { __builtin_amdgcn_s_setprio(1); _Pragma("unroll") for (int m = 0; m < 4; ++m) _Pragma("unroll") for (int n = 0; n < 2; ++n) _Pragma("unroll") for (int k = 0; k < 2; ++k) \
        acc[ai][bj][m][n] = __builtin_amdgcn_mfma_f32_16x16x32_bf16(Bt[n][k], At[m][k], acc[ai][bj][m][n], 0, 0, 0); __builtin_amdgcn_s_setprio(0); } while (0)
#define PG8_WAIT_V(n) asm volatile("s_waitcnt vmcnt(" #n ")" ::: "memory")
#define PG8_WAIT_L(n) asm volatile("s_waitcnt lgkmcnt(" #n ")" ::: "memory")
#define PG8_BAR __builtin_amdgcn_s_barrier()
#define PG8_SCHED __builtin_amdgcn_sched_barrier(0)
#define PG8_LOADVO(dst, u) do { _Pragma("unroll") for (int _h = 0; _h < 2; ++_h) _Pragma("unroll") for (int _i = 0; _i < 2; ++_i) \
        dst[_h][_i] = ((unsigned)S.arow(u, _h * HALF + Rr[_i]) * (unsigned)g.lda + (unsigned)Cc[_i] + (unsigned)S.acol(u)) * 2u; } while (0)
    Unit cur, nxt; int ui = 0;
    if (!S.next(0, cur)) return;
    f32x4 acc[2][2][4][2];
#pragma unroll
    for (int a = 0; a < 2; ++a)
#pragma unroll
        for (int b = 0; b < 2; ++b)
#pragma unroll
            for (int m = 0; m < 4; ++m)
#pragma unroll
                for (int n = 0; n < 2; ++n) acc[a][b][m][n] = (f32x4){0.f, 0.f, 0.f, 0.f};
    bf16x8 At[4][2], B0[2][2], B1[2][2];
    unsigned voA[2][2], voN[2][2];
    PG8_LOADVO(voA, cur);
    const char* Ab = (const char*)g.A;
    const char* cB = (const char*)g.Bt + (size_t)cur.pn * tstepB;
    PG8_STAGE(PG8_SB(0, 0), cB, voffB); PG8_STAGE(PG8_SA(0, 0), Ab, voA[0]); PG8_STAGE(PG8_SB(0, 1), cB + hstepB, voffB); PG8_STAGE(PG8_SA(0, 1), Ab, voA[1]);
    if (wr == 1) PG8_BAR;
    PG8_WAIT_V(4); PG8_BAR;
    PG8_STAGE(PG8_SB(1, 0), cB + kstep, voffB); PG8_STAGE(PG8_SA(1, 0), Ab + kstep, voA[0]); PG8_STAGE(PG8_SB(1, 1), cB + hstepB + kstep, voffB);
    PG8_WAIT_V(6); PG8_BAR;
    for (;;) {
        const bool has_next = S.next(ui + 1, nxt);
        if (has_next) { PG8_LOADVO(voN, nxt); }
        else {
#pragma unroll
            for (int h = 0; h < 2; ++h)
#pragma unroll
                for (int i = 0; i < 2; ++i) voN[h][i] = voA[h][i]; }
        const char* nB = has_next ? (const char*)g.Bt + (size_t)nxt.pn * tstepB : cB;
#pragma unroll 1
        for (int t = 0; t < nt; t += 2) {
            const bool last = (t == nt - 2);
            const char* a1 = Ab + (size_t)(t + 1) * kstep;
            const char* a2 = last ? Ab : Ab + (size_t)(t + 2) * kstep; const char* b2 = last ? nB : cB + (size_t)(t + 2) * kstep;
            const char* a3 = a2 + kstep; const char* b3 = b2 + kstep;
            unsigned o2[2][2];
#pragma unroll
            for (int h = 0; h < 2; ++h)
#pragma unroll
                for (int i = 0; i < 2; ++i) o2[h][i] = last ? voN[h][i] : voA[h][i];
            PG8_LDB(B0, 0, 0); PG8_SCHED; PG8_LDA(At, 0, 0); PG8_STAGE(PG8_SA(1, 1), a1, voA[1]);
            PG8_WAIT_L(8); PG8_BAR; PG8_WAIT_L(0); PG8_MMA(0, 0, At, B0); PG8_BAR; PG8_SCHED;
            PG8_LDB(B1, 0, 1); PG8_STAGE(PG8_SB(0, 0), b2, voffB);
            PG8_BAR; PG8_WAIT_L(0); PG8_MMA(0, 1, At, B1); PG8_BAR;
            PG8_LDA(At, 0, 1); PG8_STAGE(PG8_SA(0, 0), a2, o2[0]);
            PG8_BAR; PG8_WAIT_L(0); PG8_MMA(1, 0, At, B0); PG8_BAR; PG8_SCHED;
            PG8_STAGE(PG8_SB(0, 1), b2 + hstepB, voffB);
            PG8_WAIT_V(6); PG8_BAR; PG8_MMA(1, 1, At, B1); PG8_BAR;
            PG8_LDB(B0, 1, 0); PG8_SCHED; PG8_LDA(At, 1, 0); PG8_STAGE(PG8_SA(0, 1), a2, o2[1]);
            PG8_WAIT_L(8); PG8_BAR; PG8_WAIT_L(0); PG8_MMA(0, 0, At, B0); PG8_BAR; PG8_SCHED;
            PG8_LDB(B1, 1, 1); PG8_STAGE(PG8_SB(1, 0), b3, voffB);
            PG8_BAR; PG8_WAIT_L(0); PG8_MMA(0, 1, At, B1); PG8_BAR;
            PG8_LDA(At, 1, 1); PG8_STAGE(PG8_SA(1, 0), a3, o2[0]);
            PG8_BAR; PG8_WAIT_L(0); PG8_MMA(1, 0, At, B0); PG8_BAR; PG8_SCHED;
            PG8_STAGE(PG8_SB(1, 1), b3 + hstepB, voffB);
            PG8_WAIT_V(6); PG8_BAR; PG8_MMA(1, 1, At, B1); PG8_BAR;
        }
        { int fr_ = fr, fq_ = fq; asm volatile("" : "+v"(fr_), "+v"(fq_)); E(acc, cur, wr, wc, fr_, fq_); }
        if (!has_next) break;
#pragma unroll
        for (int a = 0; a < 2; ++a)
#pragma unroll
            for (int b = 0; b < 2; ++b)
#pragma unroll
                for (int m = 0; m < 4; ++m)
#pragma unroll
                    for (int n = 0; n < 2; ++n) acc[a][b][m][n] = (f32x4){0.f, 0.f, 0.f, 0.f};
        cur = nxt; cB = nB; ++ui;
#pragma unroll
        for (int h = 0; h < 2; ++h)
#pragma unroll
            for (int i = 0; i < 2; ++i) voA[h][i] = voN[h][i];
    }
    PG8_WAIT_V(0);
    if (wr == 0) PG8_BAR;
    PG8_BAR;
#undef PG8_SA
#undef PG8_SB
#undef PG8_STAGE
#undef PG8_LDA
#undef PG8_LDB
#undef PG8_MMA
#undef PG8_WAIT_V
#undef PG8_WAIT_L
#undef PG8_BAR
#undef PG8_SCHED
#undef PG8_LOADVO
}
}
using pg8::Unit;

typedef const f32x4 (&AccRef)[2][2][4][2];

struct EpiH {
    static constexpr bool PERM = true; bf16_t* O;
    __device__ __forceinline__ void operator()(AccRef acc, const Unit& u, int wr, int wc, int fr, int fq) const {
        const int row0 = u.pm * 256 + wr * 64 + fr, col0 = u.pn * 256 + wc * 32 + 8 * fq;
#pragma unroll
        for (int ai = 0; ai < 2; ++ai)
#pragma unroll
            for (int m = 0; m < 4; ++m) { bf16_t* rowp = O + (size_t)(row0 + ai * 128 + m * 16) * NHP + col0;
#pragma unroll
                for (int bj = 0; bj < 2; ++bj) { const f32x4 v0 = acc[ai][bj][m][0], v1 = acc[ai][bj][m][1];
                    u32x4 w; w.x = cvt_pk_bf16(v0[0], v0[1]); w.y = cvt_pk_bf16(v0[2], v0[3]); w.z = cvt_pk_bf16(v1[0], v1[1]); w.w = cvt_pk_bf16(v1[2], v1[3]);
                    *(u32x4*)(rowp + bj * 128) = w; } }
    }
};

__device__ __forceinline__ float rope_invfreq(int j) { return __builtin_amdgcn_exp2f(-(float)(2 * j) * (13.287712379549449f / 32.0f)) * 0.15915494309189535f; }

struct EpiQ {
    static constexpr bool PERM = false; bf16_t* Q; const float* rstd;
    __device__ __forceinline__ void operator()(AccRef acc, const Unit& u, int wr, int wc, int fr, int fq) const {
        const int row0 = u.pm * 256 + wr * 64 + fr;
        float fr4[4];
#pragma unroll
        for (int i = 0; i < 4; ++i) fr4[i] = rope_invfreq(4 * fq + i);
#pragma unroll
        for (int ai = 0; ai < 2; ++ai)
#pragma unroll
            for (int m = 0; m < 4; ++m) {
                const int row = row0 + ai * 128 + m * 16; const int b = row >> 13, t = row & (T - 1);
                const float rs = rstd[row];
#pragma unroll
                for (int bj = 0; bj < 2; ++bj) {
                    const int cgp = u.pn * 8 + bj * 4 + wc;
                    const int head = cgp / 6, wg = cgp - head * 6;
                    bf16_t* qp = Q + ((size_t)(b * 4 + head) * T + t) * 192 + wg * 32 + 4 * fq;
                    f32x4 x1 = acc[ai][bj][m][0] * rs, x2 = acc[ai][bj][m][1] * rs;
                    if (wg >= 4) {
                        const float pos = (float)(wg == 4 ? (t >> 6) : (t & 63));
#pragma unroll
                        for (int i = 0; i < 4; ++i) { float rev = pos * fr4[i]; rev = rev - floorf(rev);
                            const float sn = __builtin_amdgcn_sinf(rev), cs = __builtin_amdgcn_cosf(rev);
                            const float a = x1[i], bb = x2[i]; x1[i] = a * cs - bb * sn; x2[i] = bb * cs + a * sn; }
                    }
                    u32x2 w0, w1; w0.x = cvt_pk_bf16(x1[0], x1[1]); w0.y = cvt_pk_bf16(x1[2], x1[3]); w1.x = cvt_pk_bf16(x2[0], x2[1]); w1.y = cvt_pk_bf16(x2[2], x2[3]);
                    *(u32x2*)qp = w0; *(u32x2*)(qp + 16) = w1;
                }
                asm volatile("" ::: "memory");
            }
    }
};

struct EpiKV {
    static constexpr bool PERM = true; bf16_t* Kb; bf16_t* Vb; const float* rstd;
    __device__ __forceinline__ void operator()(AccRef acc, const Unit& u, int wr, int wc, int fr, int fq) const {
        const int row0 = u.pm * 256 + wr * 64 + fr; const bool isv = u.pn >= 2; const int c0 = wc * 32 + 8 * fq;
#pragma unroll
        for (int ai = 0; ai < 2; ++ai)
#pragma unroll
            for (int m = 0; m < 4; ++m) {
                const int row = row0 + ai * 128 + m * 16; int b, key;
                if (row < ML) { b = row >> 13; key = CTX + (row & (T - 1)); } else { const int rc = row - ML; b = rc >> 8; key = rc & (CTX - 1); }
                const float rs = rstd[row];
#pragma unroll
                for (int bj = 0; bj < 2; ++bj) { const int head = ((u.pn & 1) << 1) + bj;
                    const f32x4 v0 = acc[ai][bj][m][0] * rs, v1 = acc[ai][bj][m][1] * rs;
                    u32x4 w; w.x = cvt_pk_bf16(v0[0], v0[1]); w.y = cvt_pk_bf16(v0[2], v0[3]); w.z = cvt_pk_bf16(v1[0], v1[1]); w.w = cvt_pk_bf16(v1[2], v1[3]);
                    const size_t kr = (size_t)(b * 4 + head) * SKV + key;
                    if (isv) *(u32x4*)(Vb + kr * 128 + c0) = w; else *(u32x4*)(Kb + kr * 192 + c0) = w; }
                asm volatile("" ::: "memory");
            }
    }
};

struct EpiLora {
    static constexpr bool PERM = true; _Float16* E16; _Float16* A16; _Float16* G16; const float* w0; const float* a0;
    __device__ __forceinline__ void operator()(AccRef acc, const Unit& u, int wr, int wc, int fr, int fq) const {
        const int row0 = u.pm * 256 + wr * 64 + fr; const int type = u.pn >> 1, dir = type & 1;
        _Float16* dst = type < 2 ? E16 + (size_t)dir * MA * 512 : (type < 4 ? A16 + (size_t)dir * MA * 512 : G16);
        const float* bias = type < 2 ? w0 + dir * 512 : a0 + dir * 512;
#pragma unroll
        for (int bj = 0; bj < 2; ++bj) { const int ch = (u.pn & 1) * 256 + bj * 128 + wc * 32 + 8 * fq;
            f32x4 b0 = {0.f, 0.f, 0.f, 0.f}, b1 = {0.f, 0.f, 0.f, 0.f};
            if (type < 4) { b0 = *(const f32x4*)(bias + ch); b1 = *(const f32x4*)(bias + ch + 4); }
#pragma unroll
            for (int ai = 0; ai < 2; ++ai)
#pragma unroll
                for (int m = 0; m < 4; ++m) { const int row = row0 + ai * 128 + m * 16;
                    f32x4 v0 = acc[ai][bj][m][0] + b0, v1 = acc[ai][bj][m][1] + b1;
                    if (type < 4) {
                        const float sc = type < 2 ? 0.6065306597126334f : 1.0f;
#pragma unroll
                        for (int i = 0; i < 4; ++i) { v0[i] = sc * sigmoidf_(v0[i]); v1[i] = sc * sigmoidf_(v1[i]); } }
                    h16x8 o; o[0] = (_Float16)v0[0]; o[1] = (_Float16)v0[1]; o[2] = (_Float16)v0[2]; o[3] = (_Float16)v0[3]; o[4] = (_Float16)v1[0]; o[5] = (_Float16)v1[1]; o[6] = (_Float16)v1[2]; o[7] = (_Float16)v1[3];
                    *(h16x8*)(dst + (size_t)row * 512 + ch) = o; asm volatile("" ::: "memory"); } }
    }
};

struct EpiMix {
    static constexpr bool PERM = true; bf16_t* O;
    __device__ __forceinline__ void operator()(AccRef acc, const Unit& u, int wr, int wc, int fr, int fq) const {
        const int row0 = u.pm * 256 + wr * 64 + fr, col0 = u.pn * 256 + wc * 32 + 8 * fq;
#pragma unroll
        for (int ai = 0; ai < 2; ++ai)
#pragma unroll
            for (int m = 0; m < 4; ++m) { bf16_t* rowp = O + (size_t)(row0 + ai * 128 + m * 16) * D + col0;
#pragma unroll
                for (int bj = 0; bj < 2; ++bj) { const f32x4 v0 = acc[ai][bj][m][0], v1 = acc[ai][bj][m][1];
                    u32x4 w; w.x = cvt_pk_bf16(v0[0], v0[1]); w.y = cvt_pk_bf16(v0[2], v0[3]); w.z = cvt_pk_bf16(v1[0], v1[1]); w.w = cvt_pk_bf16(v1[2], v1[3]);
                    *(u32x4*)(rowp + bj * 128) = w; } }
    }
};

struct EpiHid {
    static constexpr bool PERM = true; bf16_t* Hd;
    __device__ __forceinline__ void operator()(AccRef acc, const Unit& u, int wr, int wc, int fr, int fq) const {
        const int row0 = u.pm * 256 + wr * 64 + fr, col0 = (u.pn & 7) * 128 + wc * 32 + 8 * fq;
#pragma unroll
        for (int ai = 0; ai < 2; ++ai)
#pragma unroll
            for (int m = 0; m < 4; ++m) {
                f32x4 v0, v1;
#pragma unroll
                for (int i = 0; i < 4; ++i) { const float g0 = acc[ai][0][m][0][i], g1 = acc[ai][0][m][1][i];
                    v0[i] = g0 * sigmoidf_(g0) * acc[ai][1][m][0][i]; v1[i] = g1 * sigmoidf_(g1) * acc[ai][1][m][1][i]; }
                u32x4 w; w.x = cvt_pk_bf16(v0[0], v0[1]); w.y = cvt_pk_bf16(v0[2], v0[3]); w.z = cvt_pk_bf16(v1[0], v1[1]); w.w = cvt_pk_bf16(v1[2], v1[3]);
                *(u32x4*)(Hd + (size_t)(row0 + ai * 128 + m * 16) * 1024 + col0) = w; }
    }
};

struct EpiYe {
    static constexpr bool PERM = true; bf16_t* Ye; const float* gate;
    __device__ __forceinline__ void operator()(AccRef acc, const Unit& u, int wr, int wc, int fr, int fq) const {
        const int row0 = u.pm * 256 + wr * 64 + fr, col0 = (u.pn & 3) * 256 + wc * 32 + 8 * fq;
#pragma unroll
        for (int ai = 0; ai < 2; ++ai)
#pragma unroll
            for (int m = 0; m < 4; ++m) { const int row = row0 + ai * 128 + m * 16; const float gt = gate[row];
#pragma unroll
                for (int bj = 0; bj < 2; ++bj) { const f32x4 v0 = acc[ai][bj][m][0] * gt, v1 = acc[ai][bj][m][1] * gt;
                    u32x4 w; w.x = cvt_pk_bf16(v0[0], v0[1]); w.y = cvt_pk_bf16(v0[2], v0[3]); w.z = cvt_pk_bf16(v1[0], v1[1]); w.w = cvt_pk_bf16(v1[2], v1[3]);
                    *(u32x4*)(Ye + (size_t)row * 1024 + col0 + bj * 128) = w; } }
    }
};

struct GuOrder {
    int G, c; const int* idx; int dupf;
    __device__ bool next(int i, Unit& u) const { long L = (long)i * G + c; if (L >= 2048L * dupf) return false; L &= 2047;
        const int e = (int)L >> 7, w = (int)L & 127;
        const int xc = w & 7, k = w >> 3; u.pn = e * 8 + (xc & 3) * 2 + (k & 1); u.pm = e * 16 + (xc >> 2) * 8 + (k >> 1); return true; }
    __device__ __forceinline__ int arow(const Unit& u, int r) const { return ((u.pm >> 2) & 3) * T + idx[u.pm * 256 + r]; }
    __device__ __forceinline__ int acol(const Unit&) const { return 0; }
};
struct DnOrder {
    int G, c, dupf;
    __device__ bool next(int i, Unit& u) const { long L = (long)i * G + c; if (L >= 1024L * dupf) return false; L &= 1023;
        const int e = (int)L >> 6, w = (int)L & 63; u.pm = e * 16 + (w >> 2); u.pn = e * 4 + (w & 3); return true; }
    __device__ __forceinline__ int arow(const Unit& u, int r) const { return u.pm * 256 + r; }
    __device__ __forceinline__ int acol(const Unit&) const { return 0; }
};

namespace att {
constexpr int DQK = 192, DV = 128, KVBLK = 64, QBLK = 32;
constexpr float SCALE = 0.07216878364870322f;
constexpr float THR = 8.f;
constexpr int KPITCH = 400;
constexpr int SHM_V = KVBLK * DV * 2, SHM_K = KVBLK * KPITCH;
constexpr int SHM_ATTN = 2 * SHM_V + 2 * SHM_K + NWAVES * 64 * 4;
#define SBAR() __builtin_amdgcn_sched_barrier(0)
__device__ __forceinline__ int crow(int r, int hi) { return (r & 3) + 8 * (r >> 2) + 4 * hi; }
__device__ __forceinline__ void partialSM(f32x16& p0, f32x16& p1, float& m_reg, float& mn, float& alpha) {
    constexpr float C = SCALE * 1.4426950408889634f;
    float pmax = p0[0];
#pragma unroll
    for (int r = 1; r < 16; ++r) pmax = fmaxf(pmax, p0[r]);
#pragma unroll
    for (int r = 0; r < 16; ++r) pmax = fmaxf(pmax, p1[r]);
    { auto rr = __builtin_amdgcn_permlane32_swap(__float_as_uint(pmax), __float_as_uint(pmax), false, false);
      pmax = fmaxf(__uint_as_float(rr[0]), __uint_as_float(rr[1])); }
    if (__builtin_expect(__all(pmax - m_reg <= THR / SCALE), 1)) { mn = m_reg; alpha = 1.f; }
    else { mn = fmaxf(m_reg, pmax); alpha = __builtin_amdgcn_exp2f((m_reg - mn) * C); m_reg = mn; }
    const float mnC = -mn * C;
#pragma unroll
    for (int r = 0; r < 16; ++r) p0[r] = fmaf(p0[r], C, mnC);
#pragma unroll
    for (int r = 0; r < 16; ++r) p1[r] = fmaf(p1[r], C, mnC);
#pragma unroll
    for (int r = 0; r < 16; ++r) p0[r] = __builtin_amdgcn_exp2f(p0[r]);
}
__device__ __forceinline__ void finishSM(f32x16& p0, f32x16& p1, float alpha, float& l_reg, bf16x8& pa0, bf16x8& pa1, bf16x8& pa2, bf16x8& pa3) {
#pragma unroll
    for (int r = 0; r < 16; ++r) p1[r] = __builtin_amdgcn_exp2f(p1[r]);
    float ps = 0;
#pragma unroll
    for (int r = 0; r < 16; ++r) ps += p0[r];
#pragma unroll
    for (int r = 0; r < 16; ++r) ps += p1[r];
    { auto rr = __builtin_amdgcn_permlane32_swap(__float_as_uint(ps), __float_as_uint(ps), false, false);
      ps = __uint_as_float(rr[0]) + __uint_as_float(rr[1]); }
    l_reg = l_reg * alpha + ps;
#define PK4(P, BASE, OUT) do { unsigned a0 = cvt_pk_bf16(P[BASE + 0], P[BASE + 1]), a1 = cvt_pk_bf16(P[BASE + 2], P[BASE + 3]);   \
    unsigned b0 = cvt_pk_bf16(P[BASE + 4], P[BASE + 5]), b1 = cvt_pk_bf16(P[BASE + 6], P[BASE + 7]);                              \
    auto r0 = __builtin_amdgcn_permlane32_swap(a0, b0, false, false); auto r1 = __builtin_amdgcn_permlane32_swap(a1, b1, false, false); \
    u32x4 w = {r0[0], r1[0], r0[1], r1[1]}; OUT = *reinterpret_cast<bf16x8*>(&w); } while (0)
    PK4(p0, 0, pa0); PK4(p0, 8, pa1); PK4(p1, 0, pa2); PK4(p1, 8, pa3);
#undef PK4
}
__device__ __forceinline__ void qkt(f32x16& p0, f32x16& p1, const char* Ks, const bf16x8* qr, int r32, int hi) {
    p0 = f32x16{}; p1 = f32x16{};
#pragma unroll
    for (int d0 = 0; d0 < 12; ++d0) { const int cb = d0 * 32 + hi * 16;
        const bf16x8 b0 = *reinterpret_cast<const bf16x8*>(Ks + r32 * KPITCH + cb);
        const bf16x8 b1 = *reinterpret_cast<const bf16x8*>(Ks + (32 + r32) * KPITCH + cb);
        p0 = __builtin_amdgcn_mfma_f32_32x32x16_bf16(b0, qr[d0], p0, 0, 0, 0);
        p1 = __builtin_amdgcn_mfma_f32_32x32x16_bf16(b1, qr[d0], p1, 0, 0, 0); }
}
__device__ __forceinline__ int v_st(int k, int c) { const int kk = (k & ~0xC) | ((k & 4) << 1) | ((k & 8) >> 1); return ((kk >> 3) * 4 + (c >> 5)) * 512 + ((kk & 7) * 32 + (c & 31)) * 2; }
__device__ __forceinline__ int v_rd_base(int lane) { return ((lane & 3) << 3) | (((lane >> 2) & 3) << 6) | (((lane >> 4) & 1) << 5) | (((lane >> 5) & 1) << 8); }
constexpr int v_rd_off(int d0, int ks, int half) { return d0 * 512 + ks * 4096 + half * 2048; }
template <int OFF> __device__ __forceinline__ s16x4 tr_read(int vb) {
    s16x4 r; asm volatile("ds_read_b64_tr_b16 %0, %1 offset:%2" : "=&v"(r) : "v"(vb), "i"(OFF) : "memory"); return r;
}
template <int D0> __device__ __forceinline__ void pv_one(f32x16& od, int vb, bf16x8 pa0, bf16x8 pa1, bf16x8 pa2, bf16x8 pa3) {
    const s16x4 l0 = tr_read<v_rd_off(D0, 0, 0)>(vb), h0 = tr_read<v_rd_off(D0, 0, 1)>(vb), l1 = tr_read<v_rd_off(D0, 1, 0)>(vb), h1 = tr_read<v_rd_off(D0, 1, 1)>(vb);
    const s16x4 l2 = tr_read<v_rd_off(D0, 2, 0)>(vb), h2 = tr_read<v_rd_off(D0, 2, 1)>(vb), l3 = tr_read<v_rd_off(D0, 3, 0)>(vb), h3 = tr_read<v_rd_off(D0, 3, 1)>(vb);
    asm volatile("s_waitcnt lgkmcnt(0)" ::: "memory"); SBAR();
#define PK(L, H) (bf16x8){L[0], L[1], L[2], L[3], H[0], H[1], H[2], H[3]}
    od = __builtin_amdgcn_mfma_f32_32x32x16_bf16(pa0, PK(l0, h0), od, 0, 0, 0);
    od = __builtin_amdgcn_mfma_f32_32x32x16_bf16(pa1, PK(l1, h1), od, 0, 0, 0);
    od = __builtin_amdgcn_mfma_f32_32x32x16_bf16(pa2, PK(l2, h2), od, 0, 0, 0);
    od = __builtin_amdgcn_mfma_f32_32x32x16_bf16(pa3, PK(l3, h3), od, 0, 0, 0);
#undef PK
}
__device__ __forceinline__ void pv_d0(f32x16* o, int vb, bf16x8 pa0, bf16x8 pa1, bf16x8 pa2, bf16x8 pa3) {
    pv_one<0>(o[0], vb, pa0, pa1, pa2, pa3); pv_one<1>(o[1], vb, pa0, pa1, pa2, pa3); pv_one<2>(o[2], vb, pa0, pa1, pa2, pa3); pv_one<3>(o[3], vb, pa0, pa1, pa2, pa3);
}
__device__ __forceinline__ void attn_unit(const bf16_t* __restrict__ Qb, const bf16_t* __restrict__ Kh, const bf16_t* __restrict__ Vh, bf16_t* __restrict__ Ob, char* lds) {
    const int tid = threadIdx.x, wid = __builtin_amdgcn_readfirstlane(tid >> 6), lane = tid & 63, r32 = lane & 31, hi = lane >> 5;
    char* V_lds = lds; char* K_lds = lds + 2 * SHM_V;
    float* ws = (float*)(lds + 2 * SHM_V + 2 * SHM_K) + wid * 64; float* li_l = ws; float* al_l = ws + 32;
    float m_reg = -1e30f, l_reg = 0; f32x16 o[4] = {}; bf16x8 qr[12];
    const bf16_t* Qw = Qb + (size_t)(wid * QBLK + r32) * DQK + hi * 8;
#pragma unroll
    for (int d0 = 0; d0 < 12; ++d0) qr[d0] = *reinterpret_cast<const bf16x8*>(Qw + d0 * 16);
    const int sr = tid >> 4, sc = (tid & 15) * 8, vst0 = v_st(sr, sc);
    const int kd0 = tid * 16 + 16 * (tid / 24), kd1 = (tid + 512) * 16 + 16 * ((tid + 512) / 24), kd2 = (tid + 1024) * 16 + 16 * ((tid + 1024) / 24);
    const char* Kg = (const char*)Kh + tid * 16; const char* Vg = (const char*)Vh + tid * 16;
    const int vb0 = (int)(uintptr_t)V_lds + v_rd_base(lane);
    bf16x8 vs0, vs1, ks0, ks1, ks2;
#define SLOAD(k0) do { const char* vp = Vg + (size_t)(k0) * (DV * 2); const char* kp = Kg + (size_t)(k0) * (DQK * 2); \
    vs0 = *reinterpret_cast<const bf16x8*>(vp); vs1 = *reinterpret_cast<const bf16x8*>(vp + 8192); \
    ks0 = *reinterpret_cast<const bf16x8*>(kp); ks1 = *reinterpret_cast<const bf16x8*>(kp + 8192); ks2 = *reinterpret_cast<const bf16x8*>(kp + 16384); } while (0)
#define SWRITE(b) do { *(bf16x8*)(V_lds + (b) * SHM_V + vst0) = vs0; *(bf16x8*)(V_lds + (b) * SHM_V + vst0 + 8192) = vs1; \
    *(bf16x8*)(K_lds + (b) * SHM_K + kd0) = ks0; *(bf16x8*)(K_lds + (b) * SHM_K + kd1) = ks1; *(bf16x8*)(K_lds + (b) * SHM_K + kd2) = ks2; } while (0)
#define SWAIT() asm volatile("s_waitcnt vmcnt(0)" ::: "memory")
#define RESC(a) do { if (__any((a) < 1.f)) { if (hi == 0) al_l[r32] = (a); asm volatile("s_waitcnt lgkmcnt(0)" ::: "memory"); \
    _Pragma("unroll") for (int d = 0; d < 4; ++d) _Pragma("unroll") for (int r = 0; r < 16; ++r) o[d][r] *= al_l[crow(r, hi)]; } } while (0)
    f32x16 pA0, pA1, pB0, pB1; float mnA, mnB, alA, alB; bf16x8 pa0, pa1, pa2, pa3; constexpr int NT = SKV / KVBLK;
    SLOAD(0); SWAIT(); SWRITE(0); __syncthreads();
    qkt(pA0, pA1, K_lds, qr, r32, hi); partialSM(pA0, pA1, m_reg, mnA, alA);
    SLOAD(KVBLK);
    SWAIT(); SWRITE(1); __syncthreads();
    for (int j = 1; j + 1 < NT; j += 2) {
        SBAR(); qkt(pB0, pB1, K_lds + SHM_K, qr, r32, hi);
        finishSM(pA0, pA1, alA, l_reg, pa0, pa1, pa2, pa3); SBAR();
        SLOAD((j + 1) * KVBLK); SBAR();
        pv_d0(o, vb0, pa0, pa1, pa2, pa3); partialSM(pB0, pB1, m_reg, mnB, alB);
        __syncthreads(); SWAIT(); SWRITE(0);
        RESC(alB); __syncthreads();
        SBAR(); qkt(pA0, pA1, K_lds, qr, r32, hi);
        finishSM(pB0, pB1, alB, l_reg, pa0, pa1, pa2, pa3); SBAR();
        SLOAD((j + 2) * KVBLK); SBAR();
        pv_d0(o, vb0 + SHM_V, pa0, pa1, pa2, pa3); partialSM(pA0, pA1, m_reg, mnA, alA);
        __syncthreads(); SWAIT(); SWRITE(1);
        RESC(alA); __syncthreads();
    }
    SBAR(); qkt(pB0, pB1, K_lds + SHM_K, qr, r32, hi);
    finishSM(pA0, pA1, alA, l_reg, pa0, pa1, pa2, pa3); SBAR();
    pv_d0(o, vb0, pa0, pa1, pa2, pa3); partialSM(pB0, pB1, m_reg, mnB, alB);
    __syncthreads(); RESC(alB);
    finishSM(pB0, pB1, alB, l_reg, pa0, pa1, pa2, pa3); SBAR();
    pv_d0(o, vb0 + SHM_V, pa0, pa1, pa2, pa3);
    if (hi == 0) li_l[r32] = l_reg;
    asm volatile("s_waitcnt lgkmcnt(0)" ::: "memory");
    float rli[16];
#pragma unroll
    for (int r = 0; r < 16; ++r) rli[r] = __builtin_amdgcn_rcpf(li_l[crow(r, hi)]);
    bf16_t* Ow = Ob + (size_t)(wid * QBLK) * 1024;
#pragma unroll
    for (int r = 0; r < 16; ++r) { const int orow = crow(r, hi);
#pragma unroll
        for (int d0 = 0; d0 < 4; ++d0) Ow[(size_t)orow * 1024 + d0 * 32 + r32] = (bf16_t)(cvt_pk_bf16(o[d0][r] * rli[r], 0.f) & 0xffffu); }
#undef SLOAD
#undef SWRITE
#undef SWAIT
#undef RESC
}
}

namespace att2 {
using att::crow; using att::v_rd_base; using att::v_rd_off;
constexpr int DQK = 192, DV = 128, KVBLK = 64, QBLK = 32, NT = SKV / KVBLK;
constexpr float SCALE = 0.07216878364870322f, THR = 8.f, CL = SCALE * 1.4426950408889634f;
constexpr int KTB = KVBLK * DQK * 2, VTB = KVBLK * DV * 2, VRING = 4 * KTB, OFF_SCR = VRING + 3 * VTB;
#define SB2() __builtin_amdgcn_sched_barrier(0)
template <int I> __device__ __forceinline__ float pget(const f32x16& p0, const f32x16& p1) { if constexpr (I < 16) return p0[I]; else return p1[I - 16]; }
template <int I> __device__ __forceinline__ void pset(f32x16& p0, f32x16& p1, float v) { if constexpr (I < 16) p0[I] = v; else p1[I - 16] = v; }
template <int I> __device__ __forceinline__ void fexp(f32x16& p0, f32x16& p1) { pset<I>(p0, p1, __builtin_amdgcn_exp2f(pget<I>(p0, p1))); }
template <int I> __device__ __forceinline__ void fadd(const f32x16& p0, const f32x16& p1, float& psA, float& psB) { if constexpr (I < 16) psA += pget<I>(p0, p1); else psB += pget<I>(p0, p1); }
template <int B> __device__ __forceinline__ void fcvt(const f32x16& p0, const f32x16& p1, unsigned (&tw)[4]) {
    tw[0] = cvt_pk_bf16_n(pget<B>(p0, p1), pget<B + 1>(p0, p1)); tw[1] = cvt_pk_bf16_n(pget<B + 2>(p0, p1), pget<B + 3>(p0, p1));
    tw[2] = cvt_pk_bf16_n(pget<B + 4>(p0, p1), pget<B + 5>(p0, p1)); tw[3] = cvt_pk_bf16_n(pget<B + 6>(p0, p1), pget<B + 7>(p0, p1)); }
__device__ __forceinline__ bf16x8 fperm(const unsigned (&tw)[4]) {
    const auto r0 = __builtin_amdgcn_permlane32_swap(tw[0], tw[2], false, false); const auto r1 = __builtin_amdgcn_permlane32_swap(tw[1], tw[3], false, false);
    const u32x4 w = {r0[0], r1[0], r0[1], r1[1]}; return __builtin_bit_cast(bf16x8, w); }
template <int G> __device__ __forceinline__ void fin_gap(f32x16& p0, f32x16& p1, float& psA, float& psB, unsigned (&tw)[4], bf16x8 (&pa)[4], float& l_reg, float alO) {
    if constexpr (G == 0) { fexp<8>(p0, p1); fexp<9>(p0, p1); psA = pget<0>(p0, p1) + pget<1>(p0, p1); }
    if constexpr (G == 1) { fexp<10>(p0, p1); fexp<11>(p0, p1); fadd<2>(p0, p1, psA, psB); fadd<3>(p0, p1, psA, psB); }
    if constexpr (G == 2) { fexp<12>(p0, p1); fexp<13>(p0, p1); fadd<4>(p0, p1, psA, psB); fadd<5>(p0, p1, psA, psB); }
    if constexpr (G == 3) { fexp<14>(p0, p1); fexp<15>(p0, p1); fadd<6>(p0, p1, psA, psB); fadd<7>(p0, p1, psA, psB); }
    if constexpr (G == 4) { fcvt<0>(p0, p1, tw); fadd<8>(p0, p1, psA, psB); }
    if constexpr (G == 5) { pa[0] = fperm(tw); fexp<16>(p0, p1); fadd<9>(p0, p1, psA, psB); fadd<10>(p0, p1, psA, psB); }
    if constexpr (G == 6) { fexp<17>(p0, p1); fexp<18>(p0, p1); fadd<11>(p0, p1, psA, psB); fadd<12>(p0, p1, psA, psB); }
    if constexpr (G == 7) { fexp<19>(p0, p1); fexp<20>(p0, p1); fadd<13>(p0, p1, psA, psB); fadd<14>(p0, p1, psA, psB); }
    if constexpr (G == 8) { fcvt<8>(p0, p1, tw); fadd<15>(p0, p1, psA, psB); }
    if constexpr (G == 9) { pa[1] = fperm(tw); fexp<21>(p0, p1); psB = pget<16>(p0, p1) + pget<17>(p0, p1); }
    if constexpr (G == 10) { fexp<22>(p0, p1); fexp<23>(p0, p1); fadd<18>(p0, p1, psA, psB); fadd<19>(p0, p1, psA, psB); }
    if constexpr (G == 11) { fexp<24>(p0, p1); fexp<25>(p0, p1); fadd<20>(p0, p1, psA, psB); fadd<21>(p0, p1, psA, psB); }
    if constexpr (G == 12) { fcvt<16>(p0, p1, tw); fadd<22>(p0, p1, psA, psB); }
    if constexpr (G == 13) { pa[2] = fperm(tw); fexp<26>(p0, p1); fadd<23>(p0, p1, psA, psB); fadd<24>(p0, p1, psA, psB); }
    if constexpr (G == 14) { fexp<27>(p0, p1); fexp<28>(p0, p1); fadd<25>(p0, p1, psA, psB); fadd<26>(p0, p1, psA, psB); }
    if constexpr (G == 15) { fexp<29>(p0, p1); fexp<30>(p0, p1); fadd<27>(p0, p1, psA, psB); fadd<28>(p0, p1, psA, psB); }
    if constexpr (G == 16) { fexp<31>(p0, p1); fadd<29>(p0, p1, psA, psB); fadd<30>(p0, p1, psA, psB); }
    if constexpr (G == 17) { fadd<31>(p0, p1, psA, psB); fcvt<24>(p0, p1, tw); }
    if constexpr (G == 18) { pa[3] = fperm(tw); psA += psB; }
    if constexpr (G == 19) { const auto rr = __builtin_amdgcn_permlane32_swap(__float_as_uint(psA), __float_as_uint(psA), false, false);
                             l_reg = l_reg * alO + (__uint_as_float(rr[0]) + __uint_as_float(rr[1])); }
}
template <int G> __device__ __forceinline__ void par_gap(f32x16& n0, f32x16& n1, float& mA, float& mB, float& m_reg, float& alN, float& mnC) {
#define MX3(a, b, c) fmaxf(fmaxf(a, b), c)
#define NV(I) pget<I>(n0, n1)
    if constexpr (G == 0) { mA = MX3(NV(0), NV(1), NV(2)); mB = MX3(NV(16), NV(17), NV(18)); mA = MX3(mA, NV(3), NV(4)); mB = MX3(mB, NV(19), NV(20)); }
    if constexpr (G == 1) { mA = MX3(mA, NV(5), NV(6)); mB = MX3(mB, NV(21), NV(22)); mA = MX3(mA, NV(7), NV(8)); mB = MX3(mB, NV(23), NV(24)); }
    if constexpr (G == 2) { mA = MX3(mA, NV(9), NV(10)); mB = MX3(mB, NV(25), NV(26)); mA = MX3(mA, NV(11), NV(12)); mB = MX3(mB, NV(27), NV(28)); }
    if constexpr (G == 3) { mA = MX3(mA, NV(13), NV(14)); mB = MX3(mB, NV(29), NV(30)); mA = MX3(mA, NV(15), NV(31)); mA = fmaxf(mA, mB); }
    if constexpr (G == 4) { const auto rr = __builtin_amdgcn_permlane32_swap(__float_as_uint(mA), __float_as_uint(mA), false, false);
                            const float pmax = fmaxf(__uint_as_float(rr[0]), __uint_as_float(rr[1]));
                            const bool keep = __all(pmax - m_reg <= THR / SCALE); mB = keep ? m_reg : fmaxf(m_reg, pmax); }
    if constexpr (G == 5) { alN = __builtin_amdgcn_exp2f((m_reg - mB) * CL); m_reg = mB; mnC = -mB * CL; }
    if constexpr (G >= 6 && G <= 13) { constexpr int k = G - 6;
        pset<4 * k>(n0, n1, fmaf(NV(4 * k), CL, mnC)); pset<4 * k + 1>(n0, n1, fmaf(NV(4 * k + 1), CL, mnC));
        pset<4 * k + 2>(n0, n1, fmaf(NV(4 * k + 2), CL, mnC)); pset<4 * k + 3>(n0, n1, fmaf(NV(4 * k + 3), CL, mnC));
        fexp<k>(n0, n1); }
#undef MX3
#undef NV
}
template <int G> __device__ __forceinline__ bf16x8 kfrag(const LAS unsigned char* lds, const int (&kb)[4]) {
    constexpr int d0 = G >> 1, h = G & 1;
    return *(const LAS bf16x8*)(lds + kb[d0 & 3] + (d0 >> 2) * 128 + h * 12288);
}
template <int I> __device__ __forceinline__ bf16x8 vfrag(const LAS unsigned char* lds, int vb) {
    constexpr int d0 = I >> 2, ks = I & 3;
    const s16x4 l = __builtin_amdgcn_ds_read_tr16_b64_v4i16((LAS s16x4*)(lds + vb + v_rd_off(d0, ks, 0)));
    const s16x4 h = __builtin_amdgcn_ds_read_tr16_b64_v4i16((LAS s16x4*)(lds + vb + v_rd_off(d0, ks, 1)));
    return (bf16x8){l[0], l[1], l[2], l[3], h[0], h[1], h[2], h[3]};
}
struct VF { s16x4 l, h; };
template <int I> __device__ __forceinline__ void vfrag_asm(VF& f, int vaddr) {
    constexpr int d0 = I >> 2, ks = I & 3;
    asm volatile("ds_read_b64_tr_b16 %0, %1 offset:%2" : "=v"(f.l) : "v"(vaddr), "i"(v_rd_off(d0, ks, 0)) : "memory");
    asm volatile("ds_read_b64_tr_b16 %0, %1 offset:%2" : "=v"(f.h) : "v"(vaddr), "i"(v_rd_off(d0, ks, 1)) : "memory");
}
template <int N> __device__ __forceinline__ bf16x8 vwait(VF& f) { asm volatile("s_waitcnt lgkmcnt(%2)" : "+v"(f.l), "+v"(f.h) : "i"(N)); return (bf16x8){f.l[0], f.l[1], f.l[2], f.l[3], f.h[0], f.h[1], f.h[2], f.h[3]}; }
constexpr int seg2_maxissued(int i) { return i == 0 ? 1 : ((((i - 1) & ~1) == 0) ? 5 : ((((i - 1) & ~1) <= 10) ? ((i - 1) & ~1) + 5 : 15)); }
struct Dma { const char* Kg; const char* Vg; unsigned ko0, ko1, ko2, vo; int wid; };
__device__ __forceinline__ void dma_k(LAS unsigned char* lds, const Dma& d, int t, int so) {
    const unsigned kt = (unsigned)t * KTB;
    LAS unsigned char* kd = lds + so + d.wid * 3072;
    __builtin_amdgcn_global_load_lds((const unsigned*)(d.Kg + (d.ko0 + kt)), (LAS unsigned*)(kd), 16, 0, 0);
    __builtin_amdgcn_global_load_lds((const unsigned*)(d.Kg + (d.ko1 + kt)), (LAS unsigned*)(kd + 1024), 16, 0, 0);
    __builtin_amdgcn_global_load_lds((const unsigned*)(d.Kg + (d.ko2 + kt)), (LAS unsigned*)(kd + 2048), 16, 0, 0);
}
__device__ __forceinline__ void dma_v(LAS unsigned char* lds, const Dma& d, int t, int so) {
    const unsigned vt = (unsigned)t * VTB;
    LAS unsigned char* vd = lds + so + d.wid * 2048;
    __builtin_amdgcn_global_load_lds((const unsigned*)(d.Vg + (d.vo + vt)), (LAS unsigned*)(vd), 16, 0, 0);
    __builtin_amdgcn_global_load_lds((const unsigned*)(d.Vg + (d.vo + vt + 128u)), (LAS unsigned*)(vd + 1024), 16, 0, 0);
}
struct DmaIt { unsigned kt, vt; int soK, soV; };
template <int PIECE> __device__ __forceinline__ void dma_piece(LAS unsigned char* lds, const Dma& d, const DmaIt& it) {
    if constexpr (PIECE < 3) { LAS unsigned char* kd = lds + it.soK + d.wid * 3072 + PIECE * 1024; const unsigned ko = PIECE == 0 ? d.ko0 : PIECE == 1 ? d.ko1 : d.ko2;
        __builtin_amdgcn_global_load_lds((const unsigned*)(d.Kg + (ko + it.kt)), (LAS unsigned*)(kd), 16, 0, 0); }
    else { LAS unsigned char* vd = lds + it.soV + d.wid * 2048 + (PIECE - 3) * 1024;
        __builtin_amdgcn_global_load_lds((const unsigned*)(d.Vg + (d.vo + it.vt + (PIECE - 3) * 128u)), (LAS unsigned*)(vd), 16, 0, 0); }
}
#define PIN2(a, b) asm volatile("" : "+v"(a), "+v"(b))
template <int G, int DM> __device__ __forceinline__ void seg1_gaps(LAS unsigned char* lds, const Dma& dm, const DmaIt& dit, const int (&kb)[4], int vb, const bf16x8 (&qr)[12], f32x16& pN0, f32x16& pN1, f32x16& pO0, f32x16& pO1,
                                                           bf16x8& f0, bf16x8& f1, bf16x8& f2, bf16x8& f3, VF& v0, VF& v1, float& psA, float& psB, unsigned (&tw)[4], bf16x8 (&pa)[4], float& l_reg, float alO) {
    if constexpr (G < 24) {
        bf16x8& fc = (G & 3) == 0 ? f0 : (G & 3) == 1 ? f1 : (G & 3) == 2 ? f2 : f3;
        if constexpr ((G & 1) == 0) { if constexpr (G < 2) pN0 = __builtin_amdgcn_mfma_f32_32x32x16_bf16(fc, qr[G >> 1], f32x16{}, 0, 0, 0); else pN0 = __builtin_amdgcn_mfma_f32_32x32x16_bf16(fc, qr[G >> 1], pN0, 0, 0, 0); }
        else { if constexpr (G < 2) pN1 = __builtin_amdgcn_mfma_f32_32x32x16_bf16(fc, qr[G >> 1], f32x16{}, 0, 0, 0); else pN1 = __builtin_amdgcn_mfma_f32_32x32x16_bf16(fc, qr[G >> 1], pN1, 0, 0, 0); }
        if constexpr ((G & 1) == 0) {
            bf16x8& fa = ((G + 2) & 3) == 0 ? f0 : f2; bf16x8& fb = ((G + 2) & 3) == 0 ? f1 : f3;
            if constexpr (G + 3 < 24) { fa = kfrag<G + 2>(lds, kb); fb = kfrag<G + 3>(lds, kb); }
            else { vfrag_asm<0>(v0, vb); vfrag_asm<1>(v1, vb); }
        }
        if constexpr (G == 3 && (DM & 1)) dma_piece<0>(lds, dm, dit);
        if constexpr (G == 7 && (DM & 1)) dma_piece<1>(lds, dm, dit);
        if constexpr (G == 11 && (DM & 1)) dma_piece<2>(lds, dm, dit);
        if constexpr (G == 15 && (DM & 2)) dma_piece<3>(lds, dm, dit);
        if constexpr (G == 19 && (DM & 2)) dma_piece<4>(lds, dm, dit);
        fin_gap<G>(pO0, pO1, psA, psB, tw, pa, l_reg, alO);
        PIN2(pO0, pO1);
        SB2();
        seg1_gaps<G + 1, DM>(lds, dm, dit, kb, vb, qr, pN0, pN1, pO0, pO1, f0, f1, f2, f3, v0, v1, psA, psB, tw, pa, l_reg, alO);
    }
}
template <int I> __device__ __forceinline__ void seg2_gaps(int vb, f32x16 (&o)[4], const bf16x8 (&pa)[4], f32x16& pN0, f32x16& pN1,
                                                           VF& f0, VF& f1, VF& f2, VF& f3, VF& f4, VF& f5, float& mA, float& mB, float& m_reg, float& alN, float& mnC) {
    if constexpr (I < 16) {
        VF& fc = (I % 6) == 0 ? f0 : (I % 6) == 1 ? f1 : (I % 6) == 2 ? f2 : (I % 6) == 3 ? f3 : (I % 6) == 4 ? f4 : f5;
        const bf16x8 bv = vwait<2 * (seg2_maxissued(I) - I)>(fc);
        o[I >> 2] = __builtin_amdgcn_mfma_f32_32x32x16_bf16(pa[I & 3], bv, o[I >> 2], 0, 0, 0);
        if constexpr (I == 0) { vfrag_asm<2>(f2, vb); vfrag_asm<3>(f3, vb); vfrag_asm<4>(f4, vb); vfrag_asm<5>(f5, vb); }
        else if constexpr ((I & 1) == 0 && I + 5 < 16) {
            VF& fa = ((I + 4) % 6) == 0 ? f0 : ((I + 4) % 6) == 2 ? f2 : f4; VF& fb = ((I + 4) % 6) == 0 ? f1 : ((I + 4) % 6) == 2 ? f3 : f5;
            vfrag_asm<I + 4>(fa, vb); vfrag_asm<I + 5>(fb, vb);
        }
        par_gap<I>(pN0, pN1, mA, mB, m_reg, alN, mnC);
        PIN2(pN0, pN1);
        SB2();
        seg2_gaps<I + 1>(vb, o, pa, pN0, pN1, f0, f1, f2, f3, f4, f5, mA, mB, m_reg, alN, mnC);
    }
}
__device__ __forceinline__ void attn_unit(const bf16_t* __restrict__ Qb, const bf16_t* __restrict__ Kh, const bf16_t* __restrict__ Vh, bf16_t* __restrict__ Ob, LAS unsigned char* lds) {
    int tid_o = threadIdx.x; asm volatile("" : "+v"(tid_o));
    const int tid = tid_o, wid = __builtin_amdgcn_readfirstlane(tid >> 6), lane = tid & 63, r32 = lane & 31, hi = lane >> 5;
    LAS float* scr = (LAS float*)(lds + OFF_SCR) + wid * 64; LAS float* li_l = scr; LAS float* al_l = scr + 32;
    const int kbase = r32 * 384 + ((hi ^ ((r32 >> 1) & 7)) << 4);
    const int vbase = v_rd_base(lane);
    Dma dm; dm.Kg = (const char*)Kh; dm.Vg = (const char*)Vh; dm.wid = wid;
    { unsigned ko[3];
#pragma unroll
      for (int i = 0; i < 3; ++i) { const int L = (3 * wid + i) * 1024 + lane * 16, r = L / 384, cp = (L - r * 384) >> 4, c = (cp & ~7) | ((cp ^ (r >> 1)) & 7); ko[i] = (unsigned)(r * 384 + c * 16); }
      dm.ko0 = ko[0]; dm.ko1 = ko[1]; dm.ko2 = ko[2];
      const int L = (2 * wid) * 1024 + lane * 16, blk = L >> 9, wv = L & 511, kk = (blk >> 2) * 8 + (wv >> 6), c = (blk & 3) * 32 + ((wv & 63) >> 1);
      const int k = (kk & ~0xC) | ((kk & 4) << 1) | ((kk & 8) >> 1); dm.vo = (unsigned)(k * 256 + c * 2); }
    dma_k(lds, dm, 0, 0); dma_k(lds, dm, 1, KTB); dma_k(lds, dm, 2, 2 * KTB); dma_k(lds, dm, 3, 3 * KTB); dma_v(lds, dm, 0, VRING); dma_v(lds, dm, 1, VRING + VTB);
    float m_reg = -1e30f, l_reg = 0.f; f32x16 o[4] = {}; bf16x8 qr[12];
    { const bf16_t* Qw = Qb + (size_t)(wid * QBLK + r32) * DQK + hi * 8;
#pragma unroll
      for (int d0 = 0; d0 < 12; ++d0) qr[d0] = *reinterpret_cast<const bf16x8*>(Qw + d0 * 16); }
    asm volatile("s_waitcnt vmcnt(0)" ::: "memory"); __builtin_amdgcn_s_barrier(); SB2();
    f32x16 pA0, pA1, pB0, pB1; float alA = 1.f, alB = 1.f, mA, mB, mnC, psA, psB; unsigned tw[4]; bf16x8 pa[4], f0, f1, f2, f3; VF vf0, vf1, vf2, vf3, vf4, vf5;
    int kb[4];
#define KB_SET(so) do { kb[0] = kbase + (so); asm volatile("" : "+v"(kb[0])); kb[1] = kb[0] ^ 32; kb[2] = kb[0] ^ 64; kb[3] = kb[0] ^ 96; } while (0)
    KB_SET(0);
    pA0 = f32x16{}; pA1 = f32x16{};
#pragma unroll
    for (int d0 = 0; d0 < 12; ++d0) { const bf16x8 b0 = *(const LAS bf16x8*)(lds + kb[d0 & 3] + (d0 >> 2) * 128), b1 = *(const LAS bf16x8*)(lds + kb[d0 & 3] + (d0 >> 2) * 128 + 12288);
        pA0 = __builtin_amdgcn_mfma_f32_32x32x16_bf16(b0, qr[d0], pA0, 0, 0, 0); pA1 = __builtin_amdgcn_mfma_f32_32x32x16_bf16(b1, qr[d0], pA1, 0, 0, 0); }
    par_gap<0>(pA0, pA1, mA, mB, m_reg, alA, mnC); par_gap<1>(pA0, pA1, mA, mB, m_reg, alA, mnC); par_gap<2>(pA0, pA1, mA, mB, m_reg, alA, mnC); par_gap<3>(pA0, pA1, mA, mB, m_reg, alA, mnC);
    par_gap<4>(pA0, pA1, mA, mB, m_reg, alA, mnC); par_gap<5>(pA0, pA1, mA, mB, m_reg, alA, mnC); par_gap<6>(pA0, pA1, mA, mB, m_reg, alA, mnC); par_gap<7>(pA0, pA1, mA, mB, m_reg, alA, mnC);
    par_gap<8>(pA0, pA1, mA, mB, m_reg, alA, mnC); par_gap<9>(pA0, pA1, mA, mB, m_reg, alA, mnC); par_gap<10>(pA0, pA1, mA, mB, m_reg, alA, mnC); par_gap<11>(pA0, pA1, mA, mB, m_reg, alA, mnC);
    par_gap<12>(pA0, pA1, mA, mB, m_reg, alA, mnC); par_gap<13>(pA0, pA1, mA, mB, m_reg, alA, mnC);
    alA = 1.f;
    __builtin_amdgcn_s_barrier(); SB2();
    int sV = VRING, sD = VRING + 2 * VTB, sVn = VRING + VTB;
    KB_SET(KTB); f0 = kfrag<0>(lds, kb); f1 = kfrag<1>(lds, kb);
#define RESC2(a) do { if (__any((a) < 1.f)) { if (hi == 0) al_l[r32] = (a); asm volatile("s_waitcnt lgkmcnt(0)" ::: "memory"); \
    _Pragma("unroll") for (int d = 0; d < 4; ++d) _Pragma("unroll") for (int r = 0; r < 16; ++r) o[d][r] *= al_l[crow(r, hi)]; } } while (0)
#define ITER2(pO0, pO1, alO, pN0, pN1, alN, t_, DO_DMA, VMW, PRE) do { \
        int vb_ = vbase + sV + (int)(unsigned long)lds; asm volatile("" : "+v"(vb_)); \
        const DmaIt dit_ = {(unsigned)((t_) + 4) * KTB, (unsigned)((t_) + 2) * VTB, ((t_) & 3) * KTB, sD}; \
        SB2(); \
        seg1_gaps<0, DO_DMA>(lds, dm, dit_, kb, vb_, qr, pN0, pN1, pO0, pO1, f0, f1, f2, f3, vf0, vf1, psA, psB, tw, pa, l_reg, alO); \
        seg2_gaps<0>(vb_, o, pa, pN0, pN1, vf0, vf1, vf2, vf3, vf4, vf5, mA, mB, m_reg, alN, mnC); \
        if (PRE) { KB_SET((((t_) + 2) & 3) * KTB); f0 = kfrag<0>(lds, kb); f1 = kfrag<1>(lds, kb); }        \
        RESC2(alN); \
        asm volatile("s_waitcnt vmcnt(" #VMW ")" ::: "memory"); __builtin_amdgcn_s_barrier(); SB2(); \
        { const int t3_ = sV; sV = sVn; sVn = sD; sD = t3_; } } while (0)
    for (int t = 0; t < NT - 4; t += 2) {
        ITER2(pA0, pA1, alA, pB0, pB1, alB, t, 3, 5, true);
        ITER2(pB0, pB1, alB, pA0, pA1, alA, t + 1, 3, 5, true);
    }
    ITER2(pA0, pA1, alA, pB0, pB1, alB, NT - 4, 2, 2, true);
    ITER2(pB0, pB1, alB, pA0, pA1, alA, NT - 3, 2, 2, true);
    ITER2(pA0, pA1, alA, pB0, pB1, alB, NT - 2, 0, 0, false);
    { int vb_ = vbase + sV; asm volatile("" : "+v"(vb_));
      fin_gap<0>(pB0, pB1, psA, psB, tw, pa, l_reg, alB); fin_gap<1>(pB0, pB1, psA, psB, tw, pa, l_reg, alB); fin_gap<2>(pB0, pB1, psA, psB, tw, pa, l_reg, alB); fin_gap<3>(pB0, pB1, psA, psB, tw, pa, l_reg, alB);
      fin_gap<4>(pB0, pB1, psA, psB, tw, pa, l_reg, alB); fin_gap<5>(pB0, pB1, psA, psB, tw, pa, l_reg, alB); fin_gap<6>(pB0, pB1, psA, psB, tw, pa, l_reg, alB); fin_gap<7>(pB0, pB1, psA, psB, tw, pa, l_reg, alB);
      fin_gap<8>(pB0, pB1, psA, psB, tw, pa, l_reg, alB); fin_gap<9>(pB0, pB1, psA, psB, tw, pa, l_reg, alB); fin_gap<10>(pB0, pB1, psA, psB, tw, pa, l_reg, alB); fin_gap<11>(pB0, pB1, psA, psB, tw, pa, l_reg, alB);
      fin_gap<12>(pB0, pB1, psA, psB, tw, pa, l_reg, alB); fin_gap<13>(pB0, pB1, psA, psB, tw, pa, l_reg, alB); fin_gap<14>(pB0, pB1, psA, psB, tw, pa, l_reg, alB); fin_gap<15>(pB0, pB1, psA, psB, tw, pa, l_reg, alB);
      fin_gap<16>(pB0, pB1, psA, psB, tw, pa, l_reg, alB); fin_gap<17>(pB0, pB1, psA, psB, tw, pa, l_reg, alB); fin_gap<18>(pB0, pB1, psA, psB, tw, pa, l_reg, alB); fin_gap<19>(pB0, pB1, psA, psB, tw, pa, l_reg, alB);
#pragma unroll
      for (int d0 = 0; d0 < 4; ++d0) {
          const bf16x8 v0 = d0 == 0 ? vfrag<0>(lds, vb_) : d0 == 1 ? vfrag<4>(lds, vb_) : d0 == 2 ? vfrag<8>(lds, vb_) : vfrag<12>(lds, vb_);
          const bf16x8 v1 = d0 == 0 ? vfrag<1>(lds, vb_) : d0 == 1 ? vfrag<5>(lds, vb_) : d0 == 2 ? vfrag<9>(lds, vb_) : vfrag<13>(lds, vb_);
          const bf16x8 v2 = d0 == 0 ? vfrag<2>(lds, vb_) : d0 == 1 ? vfrag<6>(lds, vb_) : d0 == 2 ? vfrag<10>(lds, vb_) : vfrag<14>(lds, vb_);
          const bf16x8 v3 = d0 == 0 ? vfrag<3>(lds, vb_) : d0 == 1 ? vfrag<7>(lds, vb_) : d0 == 2 ? vfrag<11>(lds, vb_) : vfrag<15>(lds, vb_);
          o[d0] = __builtin_amdgcn_mfma_f32_32x32x16_bf16(pa[0], v0, o[d0], 0, 0, 0); o[d0] = __builtin_amdgcn_mfma_f32_32x32x16_bf16(pa[1], v1, o[d0], 0, 0, 0);
          o[d0] = __builtin_amdgcn_mfma_f32_32x32x16_bf16(pa[2], v2, o[d0], 0, 0, 0); o[d0] = __builtin_amdgcn_mfma_f32_32x32x16_bf16(pa[3], v3, o[d0], 0, 0, 0); } }
    if (hi == 0) li_l[r32] = l_reg;
    asm volatile("s_waitcnt lgkmcnt(0)" ::: "memory");
    float rli[16];
#pragma unroll
    for (int r = 0; r < 16; ++r) rli[r] = __builtin_amdgcn_rcpf(li_l[crow(r, hi)]);
    { LAS unsigned char* ost = lds + wid * 8192;
#pragma unroll
      for (int r = 0; r < 16; ++r) { const int orow = crow(r, hi);
#pragma unroll
          for (int d0 = 0; d0 < 4; ++d0) *(LAS unsigned short*)(ost + orow * 256 + (d0 * 32 + r32) * 2) = (unsigned short)(cvt_pk_bf16_n(o[d0][r] * rli[r], 0.f) & 0xffffu); }
      asm volatile("s_waitcnt lgkmcnt(0)" ::: "memory");
      bf16_t* Ow = Ob + (size_t)(wid * QBLK) * 1024;
#pragma unroll
      for (int j = 0; j < 8; ++j) { const int row = j * 4 + (lane >> 4); const u32x4 vv = *(const LAS u32x4*)(ost + row * 256 + (lane & 15) * 16);
          *(u32x4*)(Ow + (size_t)row * 1024 + (lane & 15) * 8) = vv; } }
#undef KB_SET
#undef RESC2
#undef ITER2
}
#undef SB2
}

__device__ __forceinline__ void transpose_item(const float* W, int ldw, int k0, int n0, bf16_t* dst, int ldd, const float* kscale, LAS float* scr, int lane) {
    float tv[32];
#pragma unroll
    for (int i = 0; i < 32; ++i) { const int kk = 2 * i + (lane >> 5); tv[i] = W[(size_t)(k0 + kk) * ldw + n0 + (lane & 31)]; }
#pragma unroll
    for (int i = 0; i < 32; ++i) { const int kk = 2 * i + (lane >> 5); float v = tv[i]; if (kscale) v *= kscale[k0 + kk]; scr[kk * 33 + (lane & 31)] = v; }
    LDS_WAIT(); asm volatile("" ::: "memory");
    const int c = lane & 7;
#pragma unroll
    for (int j = 0; j < 4; ++j) { const int n = (lane >> 3) + 8 * j; const LAS float* s = scr + (8 * c) * 33 + n;
        u32x4 o; o.x = cvt_pk_bf16(s[0 * 33], s[1 * 33]); o.y = cvt_pk_bf16(s[2 * 33], s[3 * 33]); o.z = cvt_pk_bf16(s[4 * 33], s[5 * 33]); o.w = cvt_pk_bf16(s[6 * 33], s[7 * 33]);
        *(u32x4*)(dst + (size_t)n * ldd + 8 * c) = o; }
    LDS_WAIT(); asm volatile("" ::: "memory");
}

__device__ __forceinline__ void ph_mod_and_weights(KP p, LAS unsigned char* lds) {
    const int tid = threadIdx.x, lane = tid & 63, wave = tid >> 6;
    unsigned char* ws = p.ws;
    float* mod = (float*)(ws + WS_MOD);
    {
        LAS float* sc = (LAS float*)lds;
        LAS float* red = (LAS float*)(lds + 20480);
        if ((int)blockIdx.x < 192) {
            for (int i = tid; i < 5 * 1024; i += NTHREADS) { const int j = i >> 10, k = i & 1023; const float v = j < 4 ? p.in[I_C][j * 1024 + k] : p.in[I_CCTX][k]; sc[i] = v * sigmoidf_(v); }
            __syncthreads();
            for (int unit = blockIdx.x; unit < 192; unit += gridDim.x) {
                const int c32 = tid & 31, kg = tid >> 5, col = unit * 32 + c32;
                float a0 = 0, a1 = 0, a2 = 0, a3 = 0, a4 = 0;
                const float* wp = p.in[I_WADA] + (size_t)(kg * 64) * 6144 + col;
#pragma unroll 8
                for (int kk = 0; kk < 64; ++kk) { const float w = wp[(size_t)kk * 6144]; const int k = kg * 64 + kk;
                    a0 += sc[k] * w; a1 += sc[1024 + k] * w; a2 += sc[2048 + k] * w; a3 += sc[3072 + k] * w; a4 += sc[4096 + k] * w; }
                LAS float* rp = red + (kg * 32 + c32) * 5; rp[0] = a0; rp[1] = a1; rp[2] = a2; rp[3] = a3; rp[4] = a4;
                __syncthreads();
                if (tid < 160) { const int cc = tid & 31, j = tid >> 5; float s = p.in[I_BADA][unit * 32 + cc];
                    for (int g = 0; g < 16; ++g) s += red[(g * 32 + cc) * 5 + j];
                    mod[j * 6144 + unit * 32 + cc] = s; }
                __syncthreads();
            }
        }
    }
    __syncthreads();
    {
        LAS float* scr = (LAS float*)(lds + wave * 8448);
        const int gw = blockIdx.x * NWAVES + wave, NGW = gridDim.x * NWAVES;
        bf16_t* WIN = (bf16_t*)(ws + WS_WIN); bf16_t* WLO = (bf16_t*)(ws + WS_WLORA); bf16_t* WUQ = (bf16_t*)(ws + WS_WUQ); bf16_t* WUKV = (bf16_t*)(ws + WS_WUKV); bf16_t* WOUT = (bf16_t*)(ws + WS_WOUT);
        constexpr int I_IN = 16 * 78, I_L = 16, I_G = 32, I_Q = 4 * 24, I_KV = 4 * 16, I_O = 16 * 32;
        constexpr int NITEMS = I_IN + 4 * I_L + I_G + I_Q + 2 * I_KV + I_O;
        for (int it = gw; it < NITEMS; it += NGW) {
            int r = it;
            if (r < I_IN) { const int kb = r / 78, nb = r % 78; transpose_item(p.in[I_WIN], IN_PROJ, kb * 64, nb * 32, WIN + (size_t)(nb * 32) * 1024 + kb * 64, 1024, nullptr, scr, lane); continue; } r -= I_IN;
            if (r < 2 * I_L) { const int d = r / 16, nb = r % 16; transpose_item(p.in[I_WUP] + (size_t)d * 64 * 512, 512, 0, nb * 32, WLO + (size_t)(d * 512 + nb * 32) * 128 + d * 64, 128, nullptr, scr, lane); continue; } r -= 2 * I_L;
            if (r < 2 * I_L) { const int d = r / 16, nb = r % 16; transpose_item(p.in[I_AUP] + (size_t)d * 64 * 512, 512, 0, nb * 32, WLO + (size_t)(1024 + d * 512 + nb * 32) * 128 + d * 64, 128, nullptr, scr, lane); continue; } r -= 2 * I_L;
            if (r < I_G) { const int kb = r / 16, nb = r % 16; transpose_item(p.in[I_GUP], 512, kb * 64, nb * 32, WLO + (size_t)(2048 + nb * 32) * 128 + kb * 64, 128, nullptr, scr, lane); continue; } r -= I_G;
            if (r < I_Q) { const int kb = r / 24, nb = r % 24; transpose_item(p.in[I_WUQ], 768, kb * 64, nb * 32, WUQ + (size_t)(nb * 32) * 256 + kb * 64, 256, p.in[I_QNORM], scr, lane); continue; } r -= I_Q;
            if (r < I_KV) { const int kb = r / 16, nb = r % 16; transpose_item(p.in[I_WUK], 512, kb * 64, nb * 32, WUKV + (size_t)(nb * 32) * 256 + kb * 64, 256, p.in[I_KVNORM], scr, lane); continue; } r -= I_KV;
            if (r < I_KV) { const int kb = r / 16, nb = r % 16; transpose_item(p.in[I_WUV], 512, kb * 64, nb * 32, WUKV + (size_t)(512 + nb * 32) * 256 + kb * 64, 256, p.in[I_KVNORM], scr, lane); continue; } r -= I_KV;
            { const int kb = r / 32, nb = r % 32; transpose_item(p.in[I_WOUT], 1024, kb * 64, nb * 32, WOUT + (size_t)(nb * 32) * 1024 + kb * 64, 1024, nullptr, scr, lane); }
        }
        const long gt = (long)blockIdx.x * NTHREADS + tid, gs = (long)gridDim.x * NTHREADS;
        const u32x4 z = {0u, 0u, 0u, 0u};
        for (long i = gt; i < 64 * 128; i += gs) *(u32x4*)(WIN + (size_t)IN_PROJ * 1024 + i * 8) = z;
        for (long i = gt; i < 2048 * 8; i += gs) { const int row = (int)(i >> 3), ch = (int)(i & 7), d = (row >> 9) & 1;
            *(u32x4*)(WLO + (size_t)row * 128 + (1 - d) * 64 + ch * 8) = z; }
    }
}

__device__ __forceinline__ void ph_modulate1(KP p) {
    const int tid = threadIdx.x, lane = tid & 63, wave = tid >> 6;
    const float* mod = (const float*)(p.ws + WS_MOD); bf16_t* XM = (bf16_t*)(p.ws + WS_XM);
    const int gw = blockIdx.x * NWAVES + wave, NGW = gridDim.x * NWAVES;
    ER(1) for (int row = gw; row < MA; row += NGW) {
        const float* xr; int j;
        if (row < ML) { xr = p.in[I_X] + (size_t)row * D; j = row >> 13; } else { xr = p.in[I_CTX] + (size_t)(row - ML) * D; j = 4; }
        const float* sh = mod + j * 6144, * sc = sh + 1024;
        f32x4 v[4]; float s = 0.f;
#pragma unroll
        for (int q = 0; q < 4; ++q) { v[q] = *(const f32x4*)(xr + q * 256 + lane * 4); s += (v[q].x + v[q].y) + (v[q].z + v[q].w); }
        const float mean = wave_sum(s) * (1.f / D); float s2 = 0.f;
#pragma unroll
        for (int q = 0; q < 4; ++q) { v[q] = v[q] - mean; s2 += (v[q].x * v[q].x + v[q].y * v[q].y) + (v[q].z * v[q].z + v[q].w * v[q].w); }
        const float rstd = 1.0f / sqrtf(wave_sum(s2) * (1.f / D) + LN_EPS);
#pragma unroll
        for (int q = 0; q < 4; ++q) { const int c = q * 256 + lane * 4; const f32x4 a = *(const f32x4*)(sc + c), bsh = *(const f32x4*)(sh + c);
            const f32x4 y = v[q] * rstd * (a + 1.0f) + bsh;
            u32x2 w; w.x = cvt_pk_bf16(y.x, y.y); w.y = cvt_pk_bf16(y.z, y.w); *(u32x2*)(XM + (size_t)row * D + c) = w; }
    }
}

__device__ __forceinline__ void ph_prepare(KP p) {
    const int tid = threadIdx.x, lane = tid & 63, wave = tid >> 6;
    unsigned char* ws = p.ws;
    const bf16_t* H = (const bf16_t*)(ws + WS_H); _Float16* RKV = (_Float16*)(ws + WS_RKV); bf16_t* ACT = (bf16_t*)(ws + WS_ACT);
    float* rq = (float*)(ws + WS_RSTDQ); float* rkv = (float*)(ws + WS_RSTDKV); bf16_t* Kb = (bf16_t*)(ws + WS_K);
    const float* cw = p.in[I_CONV]; float* rnp = (float*)(ws + WS_RN);
    const int gw = blockIdx.x * NWAVES + wave, NGW = gridDim.x * NWAVES;
    constexpr int STRIP = 17, NSTRIP = (MA + STRIP - 1) / STRIP;
    const u32x4 z4 = {0u, 0u, 0u, 0u};
    ER(3) for (int strip = gw; strip < NSTRIP; strip += NGW) {
        const int r0 = strip * STRIP, r1 = (r0 + STRIP < MA) ? r0 + STRIP : MA;
        u32x4 prv[3], cur[3], nxt[3]; u32x4 lx = z4; u32x2 qa, qc; unsigned short k1 = 0, k2 = 0;
#define PREP_LOADROW(dst, row_) do { const bf16_t* hp_ = H + (size_t)(row_) * NHP; _Pragma("unroll") for (int q = 0; q < 3; ++q) dst[q] = *(const u32x4*)(hp_ + q * 512 + lane * 8); } while (0)
#define PREP_LOADAUX(row_) do { const bf16_t* hp_ = H + (size_t)(row_) * NHP; if (lane < 48) lx = *(const u32x4*)(hp_ + 1536 + lane * 8); qa = *(const u32x2*)(hp_ + 1920 + lane * 4); qc = *(const u32x2*)(hp_ + 2176 + lane * 4); \
        if (lane < 32) { const int g_ = (lane >> 4) & 1, jj_ = lane & 15; k1 = hp_[2432 + g_ * 32 + jj_]; k2 = hp_[2432 + g_ * 32 + 16 + jj_]; } } while (0)
        PREP_LOADROW(cur, r0); PREP_LOADAUX(r0);
        if (r0 > 0) PREP_LOADROW(prv, r0 - 1); else { prv[0] = z4; prv[1] = z4; prv[2] = z4; }
        if (r0 + 1 < MA) PREP_LOADROW(nxt, r0 + 1); else { nxt[0] = z4; nxt[1] = z4; nxt[2] = z4; }
        for (int row = r0; row < r1; ++row) {
            int b, t, len, key;
            if (row < ML) { b = row >> 13; t = row & (T - 1); len = T; key = CTX + t; } else { const int rc = row - ML; b = rc >> 8; t = rc & (CTX - 1); len = CTX; key = t; }
            const u32x4 lxc = lx; const u32x2 qac = qa, qcc = qc; const unsigned short k1c = k1, k2c = k2;
            u32x4 nn[3]; nn[0] = z4; nn[1] = z4; nn[2] = z4;
            if (row + 2 < MA && row + 1 < r1) PREP_LOADROW(nn, row + 2);
            if (row + 1 < r1) PREP_LOADAUX(row + 1);
            const bool hasp = t > 0, hasn = t < len - 1;
#pragma unroll
            for (int q = 0; q < 3; ++q) { const int c = q * 512 + lane * 8;
                const u32x4 pv = hasp ? prv[q] : z4, nv = hasn ? nxt[q] : z4, cv = cur[q];
                h16x8 o;
#pragma unroll
                for (int i = 0; i < 4; ++i) { const int ch = c + 2 * i;
                    const float lo = cw[ch] * bflo(pv[i]) + cw[1536 + ch] * bflo(cv[i]) + cw[3072 + ch] * bflo(nv[i]);
                    const float hi = cw[ch + 1] * bfhi(pv[i]) + cw[1536 + ch + 1] * bfhi(cv[i]) + cw[3072 + ch + 1] * bfhi(nv[i]);
                    o[2 * i] = (_Float16)lo; o[2 * i + 1] = (_Float16)hi; }
                *(h16x8*)(RKV + (size_t)row * 1536 + c) = o;
                if (q == 1) {
                    float ss = 0.f;
#pragma unroll
                    for (int i = 0; i < 8; ++i) { const float kr = (float)o[i] * p.in[I_KK][lane * 8 + i]; ss += kr * kr; }
                    ss += __shfl_xor(ss, 1); ss += __shfl_xor(ss, 2); ss += __shfl_xor(ss, 4);
                    if ((lane & 7) == 0) rnp[(size_t)row * 8 + (lane >> 3)] = 1.0f / sqrtf(ss + 1e-12f); } }
            if (lane < 48) { u32x4 o;
#pragma unroll
                for (int i = 0; i < 4; ++i) { float lo = bflo(lxc[i]), hi = bfhi(lxc[i]);
                    if (lane < 16) { const float el = __builtin_amdgcn_exp2f(-2.885390081777927f * lo), eh = __builtin_amdgcn_exp2f(-2.885390081777927f * hi);
                        lo = 2.0f * __builtin_amdgcn_rcpf(1.0f + el) - 1.0f; hi = 2.0f * __builtin_amdgcn_rcpf(1.0f + eh) - 1.0f; }
                    else if (lane >= 32) { lo = sigmoidf_(lo); hi = sigmoidf_(hi); }
                    o[i] = cvt_pk_bf16(lo, hi); }
                *(u32x4*)(ACT + (size_t)row * 384 + lane * 8) = o; }
            { float sa = bflo(qac.x) * bflo(qac.x) + bfhi(qac.x) * bfhi(qac.x) + bflo(qac.y) * bflo(qac.y) + bfhi(qac.y) * bfhi(qac.y);
              float sb = bflo(qcc.x) * bflo(qcc.x) + bfhi(qcc.x) * bfhi(qcc.x) + bflo(qcc.y) * bflo(qcc.y) + bfhi(qcc.y) * bfhi(qcc.y);
              sa = wave_sum(sa); sb = wave_sum(sb);
              if (lane == 0) { rq[row] = 1.0f / sqrtf(sa * (1.f / 256.f) + RMS_EPS); rkv[row] = 1.0f / sqrtf(sb * (1.f / 256.f) + RMS_EPS); } }
            if (lane < 32) { float o1, o2; const int g = (lane >> 4) & 1, jj = lane & 15; const float x1 = bf2f(k1c), x2 = bf2f(k2c);
                if (row < ML) { const float pos = (float)(g == 0 ? (t >> 6) : (t & 63)); float rev = pos * rope_invfreq(jj); rev = rev - floorf(rev);
                    const float sn = __builtin_amdgcn_sinf(rev), cs = __builtin_amdgcn_cosf(rev); o1 = x1 * cs - x2 * sn; o2 = x2 * cs + x1 * sn; }
                else { o1 = x1; o2 = x2; }
                const bf16_t w1 = (bf16_t)(cvt_pk_bf16(o1, 0.f) & 0xffffu), w2 = (bf16_t)(cvt_pk_bf16(o2, 0.f) & 0xffffu);
#pragma unroll
                for (int hh = 0; hh < 4; ++hh) { bf16_t* kp = Kb + ((size_t)(b * 4 + hh) * SKV + key) * 192 + 128 + g * 32 + jj; kp[0] = w1; kp[16] = w2; } }
#pragma unroll
            for (int q = 0; q < 3; ++q) { prv[q] = cur[q]; cur[q] = nxt[q]; nxt[q] = nn[q]; }
        }
#undef PREP_LOADROW
#undef PREP_LOADAUX
    }
}

constexpr int SC_CH = 32, SC_TOKF = 344;
__device__ __forceinline__ int scan_row_of(int b, int dir, int n) {
    if (n < CTX) { const int tc = dir ? (CTX - 1 - n) : n; return ML + b * CTX + tc; }
    const int tl = dir ? (T - 1 - (n - CTX)) : (n - CTX); return b * T + tl;
}
__device__ __forceinline__ void ph_scan(KP p, LAS unsigned char* lds) {
    const int tid = threadIdx.x, lane = tid & 63, wave = tid >> 6;
    unsigned char* ws = p.ws;
    const _Float16* RKV = (const _Float16*)(ws + WS_RKV); const _Float16* E16 = (const _Float16*)(ws + WS_E16); const _Float16* A16 = (const _Float16*)(ws + WS_A16);
    _Float16* YS = (_Float16*)((unsigned char*)p.out + DO_YS);
    const float* kkp = p.in[I_KK]; const float* kap = p.in[I_KA];
    LAS float* buf = (LAS float*)lds;
    constexpr int NCHUNK = SKV / SC_CH;
    for (int unit = blockIdx.x; unit < 256; unit += gridDim.x) {
        const int chain = unit >> 2, rb = (unit & 3) * 16;
        const int dir = chain & 1, hh = (chain >> 1) & 3  ;
        const int b = chain >> 4, head = (chain >> 1) & 7;
        (void)hh;
#define SC_PREP(ck) do { const int pt = tid - 256; const int tt = pt >> 3, part = pt & 7;                                                        \
        const int row = scan_row_of(b, dir, (ck) * SC_CH + tt); const int ch0 = head * 64 + part * 8;                                            \
        const h16x8 r8 = *(const h16x8*)(RKV + (size_t)row * 1536 + ch0), k8 = *(const h16x8*)(RKV + (size_t)row * 1536 + 512 + ch0);          \
        const h16x8 a8 = *(const h16x8*)(A16 + ((size_t)dir * MA + row) * 512 + ch0), e8 = *(const h16x8*)(E16 + ((size_t)dir * MA + row) * 512 + ch0); \
        float kf[8], kkr[8]; float ss = 0.f;                                                                                                     \
        _Pragma("unroll") for (int i = 0; i < 8; ++i) { kf[i] = (float)k8[i]; kkr[i] = kf[i] * kkp[ch0 + i]; ss += kkr[i] * kkr[i]; }           \
        ss += __shfl_xor(ss, 1); ss += __shfl_xor(ss, 2); ss += __shfl_xor(ss, 4);                                                               \
        const float rn = 1.0f / sqrtf(ss + 1e-12f);                                                                                              \
        LAS float* rec = buf + ((ck) & 1) * (SC_CH * SC_TOKF) + tt * SC_TOKF; float c1 = 0.f, c2 = 0.f;                                         \
        _Pragma("unroll") for (int i = 0; i < 8; ++i) { const float a = (float)a8[i], r = (float)r8[i]; const float kk = kkr[i] * rn;           \
            const float w = __builtin_amdgcn_exp2f(-1.4426950408889634f * (float)e8[i]); const float ka = kk * a;                                \
            const float kd = kf[i] * (1.0f + (a - 1.0f) * kap[ch0 + i]);                                                                         \
            rec[part * 8 + i] = kk; rec[64 + part * 8 + i] = w * r; rec[128 + part * 8 + i] = w; rec[192 + part * 8 + i] = kd; rec[256 + part * 8 + i] = ka; \
            c1 += ka * r; c2 += kd * r; }                                                                                                        \
        c1 += __shfl_xor(c1, 1); c1 += __shfl_xor(c1, 2); c1 += __shfl_xor(c1, 4); c2 += __shfl_xor(c2, 1); c2 += __shfl_xor(c2, 2); c2 += __shfl_xor(c2, 4); \
        if (part == 0) { rec[336] = c1; rec[337] = c2; }                                                                                         \
        if (part < 2) { const h16x8 v8 = *(const h16x8*)(RKV + (size_t)row * 1536 + 1024 + head * 64 + rb + part * 8);                           \
            _Pragma("unroll") for (int i = 0; i < 8; ++i) rec[320 + part * 8 + i] = (float)v8[i]; } } while (0)
        if (wave >= 4) SC_PREP(0);
        __syncthreads();
        f32x2 S01 = {0.f, 0.f}, S23 = {0.f, 0.f};
        const int ri = (wave & 3) * 4 + (lane >> 4), q = lane & 15;
        for (int ck = 0; ck < NCHUNK; ++ck) {
            if (wave >= 4) { if (ck + 1 < NCHUNK) SC_PREP(ck + 1); }
            else {
                const LAS float* cb = buf + (ck & 1) * (SC_CH * SC_TOKF);
                float yk0 = 0.f, yk1 = 0.f;
#pragma unroll 4
                for (int tt = 0; tt < SC_CH; ++tt) {
                    const LAS float* rec = cb + tt * SC_TOKF;
                    const f32x4 kk4 = *(const LAS f32x4*)(rec + q * 4), wr4 = *(const LAS f32x4*)(rec + 64 + q * 4), w4 = *(const LAS f32x4*)(rec + 128 + q * 4);
                    const f32x4 kd4 = *(const LAS f32x4*)(rec + 192 + q * 4), ka4 = *(const LAS f32x4*)(rec + 256 + q * 4);
                    const float v = rec[320 + ri]; const f32x2 cc = *(const LAS f32x2*)(rec + 336);
                    f32x2 d1 = S01 * (f32x2){kk4.x, kk4.y}; d1 = S23 * (f32x2){kk4.z, kk4.w} + d1;
                    f32x2 d2 = S01 * (f32x2){wr4.x, wr4.y}; d2 = S23 * (f32x2){wr4.z, wr4.w} + d2;
                    const float sk = allred16(d1.x + d1.y), qv = allred16(d2.x + d2.y);
                    const float y = qv - sk * cc.x + v * cc.y;
                    const f32x2 vv = {v, v}, ns = {-sk, -sk};
                    S01 = S01 * (f32x2){w4.x, w4.y}; S01 = vv * (f32x2){kd4.x, kd4.y} + S01; S01 = ns * (f32x2){ka4.x, ka4.y} + S01;
                    S23 = S23 * (f32x2){w4.z, w4.w}; S23 = vv * (f32x2){kd4.z, kd4.w} + S23; S23 = ns * (f32x2){ka4.z, ka4.w} + S23;
                    if ((tt & 15) == q) { if (tt < 16) yk0 = y; else yk1 = y; }
                }
                if (ck >= CTX / SC_CH) {
                    const int r0 = scan_row_of(b, dir, ck * SC_CH + q), r1 = scan_row_of(b, dir, ck * SC_CH + 16 + q);
                    YS[((size_t)dir * ML + r0) * 512 + head * 64 + rb + ri] = (_Float16)yk0;
                    YS[((size_t)dir * ML + r1) * 512 + head * 64 + rb + ri] = (_Float16)yk1;
                }
            }
            __syncthreads();
        }
#undef SC_PREP
    }
}


#ifndef SC2_DUP
#define SC2_DUP 0
#endif
namespace sc2 {
constexpr int PITCH = 128, SLOT = 64 * PITCH;
constexpr int CPS = 33, CH = 64;
enum { SL_S = 0, SL_MT = 1, SL_AH = 2, SL_BH = 3, SL_KH = 4, SL_RH = 5, SL_AHT = 6, SL_BBT = 7, SL_VT = 8, SL_KBT = 9, SL_AAB = 10, SL_AAKT = 11, SL_ARB = 12, SL_ARK = 13, SL_P2T = 14,
       SL_TT = 2, SL_ET = 3, SL_T = 4, SL_Q1 = 2, SL_Q2 = 3, SL_ML = 4, SL_ZX = 6, SL_P1T = 10, SL_TB = 15, SL_TTB = 16 };
constexpr int GC_OFF = 17 * SLOT;
__device__ __forceinline__ int swz(int row, int byte) { return row * PITCH + ((((byte >> 4) ^ (row >> 1)) & 7) << 4) + (byte & 15); }
struct Fr { bf16x8 k0, k1; };
__device__ __forceinline__ Fr ldf(const LAS char* M, int tile, int lane) { const int row = 16 * tile + (lane & 15), cq = lane >> 4, sw = (row >> 1) & 7; Fr f;
    f.k0 = *(const LAS bf16x8*)(M + row * PITCH + ((cq ^ sw) << 4)); f.k1 = *(const LAS bf16x8*)(M + row * PITCH + (((cq + 4) ^ sw) << 4)); return f; }
__device__ __forceinline__ f32x4 mm(const Fr& A, const Fr& B, f32x4 acc) {
    acc = __builtin_amdgcn_mfma_f32_16x16x32_bf16(A.k0, B.k0, acc, 0, 0, 0); acc = __builtin_amdgcn_mfma_f32_16x16x32_bf16(A.k1, B.k1, acc, 0, 0, 0); return acc; }
__device__ __forceinline__ void st4(LAS char* M, int row, int col, f32x4 v) { u32x2 w; w.x = cvt_pk_bf16_n(v[0], v[1]); w.y = cvt_pk_bf16_n(v[2], v[3]); *(LAS u32x2*)(M + swz(row, col * 2)) = w; }
__device__ __forceinline__ f32x4 ld4(const LAS char* M, int row, int col) { const u32x2 w = *(const LAS u32x2*)(M + swz(row, col * 2)); return (f32x4){bflo(w.x), bfhi(w.x), bflo(w.y), bfhi(w.y)}; }
__device__ __forceinline__ void st1(LAS char* M, int row, int col, float v) { *(LAS unsigned short*)(M + swz(row, col * 2)) = (unsigned short)(cvt_pk_bf16_n(v, 0.f) & 0xffffu); }
#define SC2_SLOT(i) ((LAS char*)lds + (i) * SLOT)
#define SC2_BAR() do { asm volatile("s_waitcnt lgkmcnt(0)" ::: "memory"); __syncthreads(); } while (0)
#define SC2_Z ((f32x4){0.f, 0.f, 0.f, 0.f})
#define SC2_SB() __builtin_amdgcn_sched_barrier(0)

__device__ __forceinline__ void pass_a(KP p, LAS unsigned char* lds) {
    int tid_o = threadIdx.x; asm volatile("" : "+v"(tid_o));
    const int tid = tid_o, lane = tid & 63, wave = __builtin_amdgcn_readfirstlane(tid >> 6), q4 = (lane >> 4) * 4, l15 = lane & 15;
    unsigned char* ws = p.ws;
    const _Float16* RKV = (const _Float16*)(ws + WS_RKV); const _Float16* E16 = (const _Float16*)(ws + WS_E16); const _Float16* A16 = (const _Float16*)(ws + WS_A16);
    _Float16* YS = (_Float16*)((unsigned char*)p.out + DO_YS);
    LAS float* gC = (LAS float*)((LAS char*)lds + GC_OFF); const float* RN = (const float*)(ws + WS_RN);
    const int tx = wave >> 1, ty0 = (wave & 1) * 2;
    const int x = 16 * tx + l15;
    for (int unit = blockIdx.x; unit < 256; unit += gridDim.x) {
        const int chain = unit >> 2, seg = unit & 3, dir = chain & 1, head = (chain >> 1) & 7, b = chain >> 4;
        bf16_t* QC = (bf16_t*)(ws + (dir ? WS_QC1 : WS_QC0)) + (size_t)(chain >> 1) * SKV * 64;
        float* SEG = (float*)(ws + WS_SEG) + (size_t)unit * 8192;
        h16x8 e8n, a8n, r8n, k8n, v8n; float rnn;
#define SC2_LOADRAW(ck_) do { const int row_ = scan_row_of(b, dir, (ck_) * CH + lane); const size_t eo_ = ((size_t)dir * MA + row_) * 512 + head * 64 + wave * 8; \
        e8n = *(const h16x8*)(E16 + eo_); a8n = *(const h16x8*)(A16 + eo_); const _Float16* rp_ = RKV + (size_t)row_ * 1536 + head * 64 + wave * 8; \
        r8n = *(const h16x8*)rp_; k8n = *(const h16x8*)(rp_ + 512); v8n = *(const h16x8*)(rp_ + 1024); rnn = RN[(size_t)row_ * 8 + head]; } while (0)
        unsigned zo_ = 0u; asm volatile("" : "+v"(zo_)); const u32x4 zz4 = {zo_, zo_, zo_, zo_};
        for (int i = tid; i < 2 * SLOT / 16; i += NTHREADS) *(LAS u32x4*)((LAS char*)lds + i * 16) = zz4;
        SC2_BAR();
        if (tid < 64) st1(SC2_SLOT(SL_MT), tid, tid, 1.0f);
        const int cb = wave & 3;
        f32x4 mst[4];
#pragma unroll
        for (int tk = 0; tk < 4; ++tk) { mst[tk] = SC2_Z;
            if (wave >= 4) {
#pragma unroll
                for (int e = 0; e < 4; ++e) mst[tk][e] = (16 * tk + q4 + e == 16 * cb + l15) ? 1.0f : 0.0f; } }
        SC2_BAR();
        for (int ck = seg * CPS; ck < (seg + 1) * CPS; ++ck) {
            {
                SC2_LOADRAW(ck);
                const h16x8 e8 = e8n, a8 = a8n, r8 = r8n, k8 = k8n, v8 = v8n; const float rn = rnn;
                u32x4 wah, wrh, wbh, wkh; unsigned pa = 0, pr = 0, pb = 0, pk = 0;
                const f32x4 kk0 = *(const f32x4*)(p.in[I_KK] + head * 64 + wave * 8), kk1 = *(const f32x4*)(p.in[I_KK] + head * 64 + wave * 8 + 4), ka0 = *(const f32x4*)(p.in[I_KA] + head * 64 + wave * 8), ka1 = *(const f32x4*)(p.in[I_KA] + head * 64 + wave * 8 + 4);
#pragma unroll
                for (int j = 0; j < 8; ++j) {
                    const float ev = (float)e8[j];
                    float L = ev; L += dppf<0x111>(L); L += dppf<0x112>(L); L += dppf<0x114>(L); L += dppf<0x118>(L);
                    const float r0 = __int_as_float(__builtin_amdgcn_readlane(__float_as_int(L), 15)), r1 = __int_as_float(__builtin_amdgcn_readlane(__float_as_int(L), 31)), r2 = __int_as_float(__builtin_amdgcn_readlane(__float_as_int(L), 47));
                    L += (lane >= 16 ? r0 : 0.f) + (lane >= 32 ? r1 : 0.f) + (lane >= 48 ? r2 : 0.f);
                    const float tot = __int_as_float(__builtin_amdgcn_readlane(__float_as_int(L), 63));
                    const float gam = __builtin_amdgcn_exp2f(-1.4426950408889634f * L), gprev = __builtin_amdgcn_exp2f(-1.4426950408889634f * (L - ev));
                    const float ginv = __builtin_amdgcn_exp2f(1.4426950408889634f * L), gbar = __builtin_amdgcn_exp2f(1.4426950408889634f * (L - tot));
                    const float kf = (float)k8[j], af = (float)a8[j], kkn = kf * (j < 4 ? kk0[j & 3] : kk1[j & 3]) * rn;
                    const float ka = kkn * af, kd = kf * (1.0f + (af - 1.0f) * (j < 4 ? ka0[j & 3] : ka1[j & 3]));
                    const float Ah = -kkn * gprev, Rh = (float)r8[j] * gam, Bh = ka * ginv, Kh = kd * ginv, Bb = ka * gbar, Kb = kd * gbar;
                    const int c = wave * 8 + j;
                    st1(SC2_SLOT(SL_AHT), c, lane, Ah); st1(SC2_SLOT(SL_BBT), c, lane, Bb); st1(SC2_SLOT(SL_VT), c, lane, (float)v8[j]); st1(SC2_SLOT(SL_KBT), c, lane, Kb);
                    if (lane == 0) gC[c] = __builtin_amdgcn_exp2f(-1.4426950408889634f * tot);
                    if (j & 1) { wah[j >> 1] = cvt_pk_bf16_n(__uint_as_float(pa), Ah); wrh[j >> 1] = cvt_pk_bf16_n(__uint_as_float(pr), Rh); wbh[j >> 1] = cvt_pk_bf16_n(__uint_as_float(pb), Bh); wkh[j >> 1] = cvt_pk_bf16_n(__uint_as_float(pk), Kh); SC2_SB(); }
                    else { pa = __float_as_uint(Ah); pr = __float_as_uint(Rh); pb = __float_as_uint(Bh); pk = __float_as_uint(Kh); } }
                const int ro = swz(lane, wave * 16);
                *(LAS u32x4*)(SC2_SLOT(SL_AH) + ro) = wah; *(LAS u32x4*)(SC2_SLOT(SL_RH) + ro) = wrh; *(LAS u32x4*)(SC2_SLOT(SL_BH) + ro) = wbh; *(LAS u32x4*)(SC2_SLOT(SL_KH) + ro) = wkh;
            }
            SC2_BAR();
            { const Fr fAHx = ldf(SC2_SLOT(SL_AH), tx, lane), fKHx = ldf(SC2_SLOT(SL_KH), tx, lane), fRHx = ldf(SC2_SLOT(SL_RH), tx, lane);
#pragma unroll
              for (int j = 0; j < 2; ++j) { const int y0 = 16 * (ty0 + j) + q4;
                const Fr fBHy = ldf(SC2_SLOT(SL_BH), ty0 + j, lane), fAHy = ldf(SC2_SLOT(SL_AH), ty0 + j, lane), fKHy = ldf(SC2_SLOT(SL_KH), ty0 + j, lane);
                SC2_SB();
                f32x4 aab = mm(fBHy, fAHx, SC2_Z), aak = mm(fAHy, fKHx, SC2_Z), arb = mm(fBHy, fRHx, SC2_Z), ark = mm(fKHy, fRHx, SC2_Z);
                SC2_SB();
#pragma unroll
                for (int e = 0; e < 4; ++e) { const int y = y0 + e; if (!(y < x)) aab[e] = 0.f; if (!(x < y)) aak[e] = 0.f; if (!(y <= x)) { arb[e] = 0.f; ark[e] = 0.f; } }
                st4(SC2_SLOT(SL_AAB), x, y0, aab); st4(SC2_SLOT(SL_AAKT), x, y0, aak); st4(SC2_SLOT(SL_ARB), x, y0, arb); st4(SC2_SLOT(SL_ARK), x, y0, ark); } }
            SC2_BAR();
            if (wave == 0) {
                const int blk = lane >> 4, c = lane & 15; float X[16];
                const LAS char* am = SC2_SLOT(SL_AAB);
                { u32x4 ar0[9];
#pragma unroll
                  for (int r = 1; r < 9; ++r) ar0[r] = *(const LAS u32x4*)(am + swz(16 * blk + r, 32 * blk));
#pragma unroll
                  for (int r = 0; r < 9; ++r) { float xv = (r == c) ? 1.0f : 0.0f;
#pragma unroll
                      for (int s2 = 0; s2 < 8; ++s2) { if (s2 < r) { const unsigned wv = ar0[r][s2 >> 1]; xv += ((s2 & 1) ? bfhi(wv) : bflo(wv)) * X[s2]; } }
                      X[r] = xv; st1(SC2_SLOT(SL_T), 16 * blk + r, 16 * blk + c, xv); } }
                asm volatile("" ::: "memory");
                { u32x4 ar0[7], ar1[7];
#pragma unroll
                  for (int r = 9; r < 16; ++r) { ar0[r - 9] = *(const LAS u32x4*)(am + swz(16 * blk + r, 32 * blk)); ar1[r - 9] = *(const LAS u32x4*)(am + swz(16 * blk + r, 32 * blk + 16)); }
#pragma unroll
                  for (int r = 9; r < 16; ++r) { float xv = (r == c) ? 1.0f : 0.0f;
#pragma unroll
                      for (int s2 = 0; s2 < 16; ++s2) { if (s2 < r) { const unsigned wv = s2 < 8 ? ar0[r - 9][s2 >> 1] : ar1[r - 9][(s2 - 8) >> 1]; xv += ((s2 & 1) ? bfhi(wv) : bflo(wv)) * X[s2]; } }
                      X[r] = xv; st1(SC2_SLOT(SL_T), 16 * blk + r, 16 * blk + c, xv); } }
                u32x4 o0, o1;
#pragma unroll
                for (int i = 0; i < 4; ++i) { o0[i] = cvt_pk_bf16_n(X[2 * i], X[2 * i + 1]); o1[i] = cvt_pk_bf16_n(X[8 + 2 * i], X[9 + 2 * i]); }
                *(LAS u32x4*)(SC2_SLOT(SL_TT) + swz(16 * blk + c, 32 * blk)) = o0; *(LAS u32x4*)(SC2_SLOT(SL_TT) + swz(16 * blk + c, 32 * blk + 16)) = o1;
            } else {
                for (int i = tid - 64; i < 768; i += NTHREADS - 64) { const int m = i / 384, rem = i % 384, b12 = rem >> 5, rr = (rem & 31) >> 1, hf = rem & 1; const int bi = b12 / 3; int bj = b12 % 3; bj += (bj >= bi) ? 1 : 0;
                    *(LAS u32x4*)(SC2_SLOT(m ? SL_TT : SL_T) + swz(16 * bi + rr, 32 * bj + 16 * hf)) = zz4; }
            }
            SC2_BAR();
#pragma unroll
            for (int lv = 0; lv < 2; ++lv) { const int sh = 4 + lv;
                const LAS char* Ts = SC2_SLOT(lv ? SL_TB : SL_T); const LAS char* TTs = SC2_SLOT(lv ? SL_TTB : SL_TT); LAS char* Td = SC2_SLOT(lv ? SL_T : SL_TB); LAS char* TTd = SC2_SLOT(lv ? SL_TT : SL_TTB);
                { const Fr fTTx = ldf(TTs, tx, lane); Fr fABy[2];
#pragma unroll
                  for (int j = 0; j < 2; ++j) fABy[j] = ldf(SC2_SLOT(SL_AAB), ty0 + j, lane);
                  SC2_SB();
                  f32x4 ev[2];
#pragma unroll
                  for (int j = 0; j < 2; ++j) ev[j] = mm(fABy[j], fTTx, SC2_Z);
                  SC2_SB();
#pragma unroll
                  for (int j = 0; j < 2; ++j) { const int r0 = 16 * (ty0 + j) + q4;
#pragma unroll
                    for (int e = 0; e < 4; ++e) { const int r = r0 + e; const bool ok = ((r >> (sh + 1)) == (x >> (sh + 1))) && ((r >> sh) & 1) && !((x >> sh) & 1); if (!ok) ev[j][e] = 0.f; }
                    st4(SC2_SLOT(SL_ET), x, r0, ev[j]); } }
                SC2_BAR();
                { const Fr fTx = ldf(Ts, tx, lane), fETx = ldf(SC2_SLOT(SL_ET), tx, lane); Fr fETy[2], fTy[2]; f32x4 tn[2], ttn[2];
#pragma unroll
                  for (int j = 0; j < 2; ++j) { const int y0 = 16 * (ty0 + j) + q4; fETy[j] = ldf(SC2_SLOT(SL_ET), ty0 + j, lane); tn[j] = ld4(Ts, x, y0);
                      if (lv == 0) { fTy[j] = ldf(Ts, ty0 + j, lane); ttn[j] = ld4(TTs, x, y0); } }
                  SC2_SB();
#pragma unroll
                  for (int j = 0; j < 2; ++j) { tn[j] = mm(fETy[j], fTx, tn[j]);
                      if (lv == 0) ttn[j] = mm(fTy[j], fETx, ttn[j]); }
                  SC2_SB();
#pragma unroll
                  for (int j = 0; j < 2; ++j) { const int y0 = 16 * (ty0 + j) + q4; st4(Td, x, y0, tn[j]); if (lv == 0) st4(TTd, x, y0, ttn[j]); } }
                SC2_BAR();
            }
            { const Fr fAHTx = ldf(SC2_SLOT(SL_AHT), tx, lane), fAAKTx = ldf(SC2_SLOT(SL_AAKT), tx, lane); Fr fTy[2];
#pragma unroll
              for (int j = 0; j < 2; ++j) fTy[j] = ldf(SC2_SLOT(SL_T), ty0 + j, lane);
              SC2_SB();
              f32x4 p1[2], p2[2];
#pragma unroll
              for (int j = 0; j < 2; ++j) { p1[j] = mm(fTy[j], fAHTx, SC2_Z); p2[j] = mm(fTy[j], fAAKTx, SC2_Z); }
              SC2_SB();
#pragma unroll
              for (int j = 0; j < 2; ++j) { const int y0 = 16 * (ty0 + j) + q4; st4(SC2_SLOT(SL_P1T), x, y0, p1[j]); st4(SC2_SLOT(SL_P2T), x, y0, p2[j]); } }
            SC2_BAR();
            { const Fr fARBx = ldf(SC2_SLOT(SL_ARB), tx, lane), fBBTx = ldf(SC2_SLOT(SL_BBT), tx, lane); Fr fP1y[2], fP2y[2]; f32x4 q1[2], q2[2], ml[2], zx[2];
#pragma unroll
              for (int j = 0; j < 2; ++j) { const int y0 = 16 * (ty0 + j) + q4; fP1y[j] = ldf(SC2_SLOT(SL_P1T), ty0 + j, lane); fP2y[j] = ldf(SC2_SLOT(SL_P2T), ty0 + j, lane);
                  q1[j] = ld4(SC2_SLOT(SL_RH), x, y0); q2[j] = ld4(SC2_SLOT(SL_ARK), x, y0); zx[j] = ld4(SC2_SLOT(SL_KBT), x, y0); }
              SC2_SB();
#pragma unroll
              for (int j = 0; j < 2; ++j) { q1[j] = mm(fP1y[j], fARBx, q1[j]); q2[j] = mm(fP2y[j], fARBx, q2[j]); ml[j] = mm(fP1y[j], fBBTx, SC2_Z); zx[j] = mm(fP2y[j], fBBTx, zx[j]); }
              SC2_SB();
#pragma unroll
              for (int j = 0; j < 2; ++j) { const int y0 = 16 * (ty0 + j) + q4; st4(SC2_SLOT(SL_Q1), x, y0, q1[j]); st4(SC2_SLOT(SL_Q2), x, y0, q2[j]); st4(SC2_SLOT(SL_ML), x, y0, ml[j]); st4(SC2_SLOT(SL_ZX), x, y0, zx[j]); } }
            SC2_BAR();
            {
                const Fr fSt = ldf(SC2_SLOT(wave < 4 ? SL_S : SL_MT), cb, lane); Fr fVT = fSt; if (wave < 4) fVT = ldf(SC2_SLOT(SL_VT), cb, lane);
#pragma unroll
                for (int hf = 0; hf < 2; ++hf) { Fr fQ1[2], fQ2[2];
#pragma unroll
                  for (int t2 = 0; t2 < 2; ++t2) { const int tt = 2 * hf + t2; fQ1[t2] = ldf(SC2_SLOT(SL_Q1), tt, lane); fQ2[t2] = fQ1[t2]; if (wave < 4) fQ2[t2] = ldf(SC2_SLOT(SL_Q2), tt, lane); }
                  SC2_SB();
                  f32x4 yv[2];
#pragma unroll
                  for (int t2 = 0; t2 < 2; ++t2) { yv[t2] = mm(fSt, fQ1[t2], SC2_Z); if (wave < 4) yv[t2] = mm(fVT, fQ2[t2], yv[t2]); }
                  SC2_SB();
#pragma unroll
                  for (int t2 = 0; t2 < 2; ++t2) { const int tt = 2 * hf + t2; const int n = ck * CH + 16 * tt + l15;
                    if (wave < 4) {
                        if (ck >= CTX / CH) { const int row = scan_row_of(b, dir, n); h16x4 o; o[0] = (_Float16)yv[t2][0]; o[1] = (_Float16)yv[t2][1]; o[2] = (_Float16)yv[t2][2]; o[3] = (_Float16)yv[t2][3];
                            *(h16x4*)(YS + ((size_t)dir * ML + row) * 512 + head * 64 + 16 * cb + q4) = o; } }
                    else { u32x2 w; w.x = cvt_pk_bf16_n(yv[t2][0], yv[t2][1]); w.y = cvt_pk_bf16_n(yv[t2][2], yv[t2][3]); *(u32x2*)(QC + (size_t)n * 64 + 16 * cb + q4) = w; } } }
#pragma unroll
                for (int hf = 0; hf < 2; ++hf) { Fr fML[2], fZX[2]; f32x4 g[2];
#pragma unroll
                  for (int t2 = 0; t2 < 2; ++t2) { const int tk = 2 * hf + t2; fML[t2] = ldf(SC2_SLOT(SL_ML), tk, lane); fZX[t2] = fML[t2]; if (wave < 4) fZX[t2] = ldf(SC2_SLOT(SL_ZX), tk, lane); g[t2] = *(const LAS f32x4*)(gC + 16 * tk + q4); }
                  SC2_SB();
#pragma unroll
                  for (int t2 = 0; t2 < 2; ++t2) { const int tk = 2 * hf + t2; f32x4 xn = mm(fML[t2], fSt, mst[tk] * g[t2]); if (wave < 4) xn = mm(fZX[t2], fVT, xn); mst[tk] = xn; }
                  SC2_SB(); }
                SC2_BAR();
                LAS char* Sw = SC2_SLOT(wave < 4 ? SL_S : SL_MT);
#pragma unroll
                for (int tk = 0; tk < 4; ++tk) st4(Sw, 16 * cb + l15, 16 * tk + q4, mst[tk]);
            }
        }
        { float* dst = SEG + (wave < 4 ? 0 : 4096);
#pragma unroll
          for (int tk = 0; tk < 4; ++tk)
#pragma unroll
              for (int e = 0; e < 4; ++e) dst[(16 * tk + q4 + e) * 64 + 16 * cb + l15] = mst[tk][e]; }
        SC2_BAR();
    }
#undef SC2_LOADRAW
}

__device__ __forceinline__ void pass_b(KP p, LAS unsigned char* lds) {
    const int tid = threadIdx.x, lane = tid & 63, wave = __builtin_amdgcn_readfirstlane(tid >> 6), q4 = (lane >> 4) * 4, l15 = lane & 15;
    unsigned char* ws = p.ws;
    _Float16* YS = (_Float16*)((unsigned char*)p.out + DO_YS);
    LAS float* Xa = (LAS float*)lds; LAS float* Xb = Xa + 4096; LAS float* Mm = Xb + 4096;
    LAS char* Sst = (LAS char*)lds + 3 * 16384;
    for (int unit = blockIdx.x; unit < 256; unit += gridDim.x) {
        const int chain = unit >> 2, seg = unit & 3, dir = chain & 1, head = (chain >> 1) & 7, b = chain >> 4;
        if (seg == 0) continue;
        const bf16_t* QC = (const bf16_t*)(ws + (dir ? WS_QC1 : WS_QC0)) + (size_t)(chain >> 1) * SKV * 64;
        const float* SEG0 = (const float*)(ws + WS_SEG) + (size_t)(chain * 4) * 8192;
        for (int i = tid; i < 4096; i += NTHREADS) Xa[i] = SEG0[i];
        __syncthreads();
        LAS float* xc = Xa; LAS float* xn = Xb;
        for (int m = 1; m < seg; ++m) {
            const float* sg = SEG0 + (size_t)m * 8192;
            for (int i = tid; i < 4096; i += NTHREADS) Mm[i] = sg[4096 + i];
            __syncthreads();
            const int v = lane, k0 = wave * 8; float acc[8];
#pragma unroll
            for (int i = 0; i < 8; ++i) acc[i] = sg[(k0 + i) * 64 + v];
            for (int k2 = 0; k2 < 64; ++k2) { const float xv = xc[k2 * 64 + v];
#pragma unroll
                for (int i = 0; i < 8; ++i) acc[i] += Mm[(k0 + i) * 64 + k2] * xv; }
#pragma unroll
            for (int i = 0; i < 8; ++i) xn[(k0 + i) * 64 + v] = acc[i];
            __syncthreads();
            LAS float* tmp = xc; xc = xn; xn = tmp;
        }
        { const int v = lane, k0 = wave * 8; u32x4 o;
#pragma unroll
          for (int i = 0; i < 4; ++i) o[i] = cvt_pk_bf16_n(xc[(k0 + 2 * i) * 64 + v], xc[(k0 + 2 * i + 1) * 64 + v]);
          *(LAS u32x4*)(Sst + swz(v, k0 * 2)) = o; }
        SC2_BAR();
        const int cb = wave & 3, tt0 = (wave >> 2) * 2; const Fr fS = ldf(Sst, cb, lane);
        bf16x8 nb0[2], nb1[2]; h16x4 ny[2]; _Float16* nyp[2];
#define SC2_PBLOAD(ck_) do { _Pragma("unroll") for (int j = 0; j < 2; ++j) { const int n_ = (ck_) * CH + 16 * (tt0 + j) + l15; const bf16_t* qp_ = QC + (size_t)n_ * 64 + (lane >> 4) * 8; \
            nb0[j] = *(const bf16x8*)qp_; nb1[j] = *(const bf16x8*)(qp_ + 32); const int row_ = scan_row_of(b, dir, n_); \
            nyp[j] = YS + ((size_t)dir * ML + row_) * 512 + head * 64 + 16 * cb + q4; ny[j] = *(const h16x4*)nyp[j]; } } while (0)
        SC2_PBLOAD(seg * CPS);
        for (int ck = seg * CPS; ck < (seg + 1) * CPS; ++ck) {
            bf16x8 b0[2], b1[2]; h16x4 yv[2]; _Float16* yp[2];
#pragma unroll
            for (int j = 0; j < 2; ++j) { b0[j] = nb0[j]; b1[j] = nb1[j]; yv[j] = ny[j]; yp[j] = nyp[j]; }
            if (ck + 1 < (seg + 1) * CPS) SC2_PBLOAD(ck + 1);
#pragma unroll
            for (int j = 0; j < 2; ++j) {
                f32x4 acc = {0.f, 0.f, 0.f, 0.f};
                acc = __builtin_amdgcn_mfma_f32_16x16x32_bf16(fS.k0, b0[j], acc, 0, 0, 0);
                acc = __builtin_amdgcn_mfma_f32_16x16x32_bf16(fS.k1, b1[j], acc, 0, 0, 0);
                h16x4 o = yv[j]; o[0] = (_Float16)((float)o[0] + acc[0]); o[1] = (_Float16)((float)o[1] + acc[1]); o[2] = (_Float16)((float)o[2] + acc[2]); o[3] = (_Float16)((float)o[3] + acc[3]);
                *(h16x4*)yp[j] = o; }
        }
#undef SC2_PBLOAD
        __syncthreads();
    }
}
#undef SC2_SLOT
#undef SC2_BAR
}

__device__ __forceinline__ void ph_readout(KP p) {
    const int tid = threadIdx.x, lane = tid & 63, wave = tid >> 6;
    unsigned char* ws = p.ws;
    const _Float16* RKV = (const _Float16*)(ws + WS_RKV); const _Float16* A16 = (const _Float16*)(ws + WS_A16); const _Float16* G16 = (const _Float16*)(ws + WS_G16);
    const _Float16* YS = (const _Float16*)((const unsigned char*)p.out + DO_YS); bf16_t* MIX = (bf16_t*)((unsigned char*)p.out + DO_MIX);
    const int gw = blockIdx.x * NWAVES + wave, NGW = gridDim.x * NWAVES; const int c0 = lane * 8;
    float gng[8], gnb[8], ka_[8], rk_[8];
#pragma unroll
    for (int i = 0; i < 8; ++i) { gng[i] = p.in[I_GNG][c0 + i]; gnb[i] = p.in[I_GNB][c0 + i]; ka_[i] = p.in[I_KA][c0 + i]; rk_[i] = p.in[I_RK][c0 + i]; }
    ER(8) for (int row = gw; row < ML; row += NGW) {
        const h16x8 y0 = *(const h16x8*)(YS + (size_t)row * 512 + c0), y1 = *(const h16x8*)(YS + ((size_t)ML + row) * 512 + c0);
        const h16x8 r8 = *(const h16x8*)(RKV + (size_t)row * 1536 + c0), k8 = *(const h16x8*)(RKV + (size_t)row * 1536 + 512 + c0), v8 = *(const h16x8*)(RKV + (size_t)row * 1536 + 1024 + c0);
        const h16x8 a0 = *(const h16x8*)(A16 + (size_t)row * 512 + c0), a1 = *(const h16x8*)(A16 + ((size_t)MA + row) * 512 + c0), g8 = *(const h16x8*)(G16 + (size_t)row * 512 + c0);
        float y[8]; float s = 0.f, bo = 0.f;
#pragma unroll
        for (int i = 0; i < 8; ++i) { y[i] = (float)y0[i] + (float)y1[i]; s += y[i];
            const float ksum = (float)k8[i] * (2.0f + ((float)a0[i] + (float)a1[i] - 2.0f) * ka_[i]); bo += (float)r8[i] * ksum * rk_[i]; }
        s += __shfl_xor(s, 1); s += __shfl_xor(s, 2); s += __shfl_xor(s, 4);
        bo += __shfl_xor(bo, 1); bo += __shfl_xor(bo, 2); bo += __shfl_xor(bo, 4);
        const float mu = s * (1.f / 64.f); float q = 0.f;
#pragma unroll
        for (int i = 0; i < 8; ++i) { y[i] -= mu; q += y[i] * y[i]; }
        q += __shfl_xor(q, 1); q += __shfl_xor(q, 2); q += __shfl_xor(q, 4);
        const float rstd = 1.0f / sqrtf(q * (1.f / 64.f) + GN_EPS);
        float o[8];
#pragma unroll
        for (int i = 0; i < 8; ++i) o[i] = (y[i] * rstd * gng[i] + gnb[i] + bo * (float)v8[i]) * (float)g8[i];
        u32x4 w; w.x = cvt_pk_bf16(o[0], o[1]); w.y = cvt_pk_bf16(o[2], o[3]); w.z = cvt_pk_bf16(o[4], o[5]); w.w = cvt_pk_bf16(o[6], o[7]);
        *(u32x4*)(MIX + (size_t)row * 1024 + c0) = w;
    }
}

__device__ __forceinline__ void ph_ln1_router(KP p, LAS unsigned char* lds) {
    const int tid = threadIdx.x, lane = tid & 63, wave = tid >> 6;
    unsigned char* ws = p.ws;
    _Float16* X1 = (_Float16*)(ws + WS_X1); bf16_t* XM2 = (bf16_t*)(ws + WS_XM2);
    float* AFF = (float*)(ws + WS_AFF); int* SLOT = (int*)(ws + WS_SLOT); const float* mod = (const float*)(ws + WS_MOD);
    LAS float* rt = (LAS float*)lds;
    LAS float* vec = (LAS float*)(lds + 65536);
    for (int i = tid; i < 1024 * 16; i += NTHREADS) rt[(i & 15) * 1024 + (i >> 4)] = p.in[I_ROUTER][i];
    for (int i = tid; i < 2048; i += NTHREADS) vec[3072 + i] = i < 1024 ? p.in[I_LN1G][i] : p.in[I_LN1B][i - 1024];
    const int G = gridDim.x, RPB = (((ML + G - 1) / G) + 15) & ~15;
    const int r0 = blockIdx.x * RPB, r1 = (r0 + RPB < ML) ? r0 + RPB : ML;
    const bf16_t* MO = (const bf16_t*)(ws + WS_Y1); const float* Xin = p.in[I_X];
    int curb = -1;
    f32x4 xa[4], xb[4]; u32x2 ma[4], mb[4];
#define LN1_LOAD(X, M, row_) do { const int rr_ = (row_) < r1 ? (row_) : (r1 - 8 + wave); const size_t o_ = (size_t)rr_ * D + lane * 4; \
    _Pragma("unroll") for (int q = 0; q < 4; ++q) { X[q] = *(const f32x4*)(Xin + o_ + q * 256); M[q] = *(const u32x2*)(MO + o_ + q * 256); } } while (0)
    if (r0 < ML) { LN1_LOAD(xa, ma, r0 + wave); LN1_LOAD(xb, mb, r0 + 8 + wave); }
#define LN1_HEAD(X, M, U, row_, nxt_) do { const int row = (row_); \
        f32x4 v[4]; float s = 0.f; \
        _Pragma("unroll") for (int q = 0; q < 4; ++q) { const f32x4 gv = *(const LAS f32x4*)(lds + lb1 + q * 1024), mv = {bflo(M[q].x), bfhi(M[q].x), bflo(M[q].y), bfhi(M[q].y)}; \
            v[q] = X[q] * ALPHA + gv * mv; s += (v[q].x + v[q].y) + (v[q].z + v[q].w); } \
        LN1_LOAD(X, M, nxt_); \
        float mean = wave_sum(s) * (1.f / D); float s2 = 0.f; \
        _Pragma("unroll") for (int q = 0; q < 4; ++q) { v[q] = v[q] - mean; s2 += (v[q].x * v[q].x + v[q].y * v[q].y) + (v[q].z * v[q].z + v[q].w * v[q].w); } \
        float rstd = __builtin_amdgcn_rsqf(wave_sum(s2) * (1.f / D) + LN_EPS); \
        s = 0.f; \
        _Pragma("unroll") for (int q = 0; q < 4; ++q) { const int c = q * 256 + lane * 4; const f32x4 g = *(const LAS f32x4*)(lds + lb1 + 12288 + q * 1024), bb = *(const LAS f32x4*)(lds + lb1 + 16384 + q * 1024); \
            v[q] = v[q] * rstd * g + bb; { h16x4 hv_ = {(_Float16)v[q].x, (_Float16)v[q].y, (_Float16)v[q].z, (_Float16)v[q].w}; *(h16x4*)(X1 + (size_t)row * D + c) = hv_; } s += (v[q].x + v[q].y) + (v[q].z + v[q].w); } \
        mean = wave_sum(s) * (1.f / D); s2 = 0.f; \
        _Pragma("unroll") for (int q = 0; q < 4; ++q) { v[q] = v[q] - mean; s2 += (v[q].x * v[q].x + v[q].y * v[q].y) + (v[q].z * v[q].z + v[q].w * v[q].w); } \
        rstd = __builtin_amdgcn_rsqf(wave_sum(s2) * (1.f / D) + LN_EPS); \
        _Pragma("unroll") for (int q = 0; q < 4; ++q) { const int c = q * 256 + lane * 4; const f32x4 a1 = *(const LAS f32x4*)(lds + lb1 + 8192 + q * 1024), bsh = *(const LAS f32x4*)(lds + lb1 + 4096 + q * 1024); \
            U[q] = v[q] * rstd * a1 + bsh; \
            u32x2 w; w.x = cvt_pk_bf16(U[q].x, U[q].y); w.y = cvt_pk_bf16(U[q].z, U[q].w); *(u32x2*)(XM2 + (size_t)row * D + c) = w; } } while (0)
#define LN1_TAIL(CMP, row_) do { const int row = (row_); const int b = row >> 13, t = row & (T - 1); \
        float lg[16]; \
        _Pragma("unroll") for (int e = 0; e < 16; ++e) lg[e] = acc[e].CMP; \
        float t8[8], t4[4]; \
        _Pragma("unroll") for (int e = 0; e < 8; ++e) { const auto r = __builtin_amdgcn_permlane32_swap(__float_as_uint(lg[e]), __float_as_uint(lg[e + 8]), false, false); t8[e] = __uint_as_float(r[0]) + __uint_as_float(r[1]); } \
        _Pragma("unroll") for (int e = 0; e < 4; ++e) { const auto r = __builtin_amdgcn_permlane16_swap(__float_as_uint(t8[e]), __float_as_uint(t8[e + 4]), false, false); t4[e] = __uint_as_float(r[0]) + __uint_as_float(r[1]); } \
        const bool o0 = lane & 1, o1 = lane & 2; \
        const float w0 = (o0 ? t4[1] : t4[0]) + dppf<0xB1>(o0 ? t4[0] : t4[1]), w1 = (o0 ? t4[3] : t4[2]) + dppf<0xB1>(o0 ? t4[2] : t4[3]); \
        float z = (o1 ? w1 : w0) + dppf<0x4E>(o1 ? w0 : w1); \
        z += dppf<0x124>(z); z += dppf<0x128>(z); \
        float mx = fmaxf(z, dppf<0xB1>(z)); mx = fmaxf(mx, dppf<0x4E>(mx)); mx = fmaxf(mx, dppf<0x141>(mx)); mx = fmaxf(mx, dppf<0x140>(mx)); \
        { const auto r = __builtin_amdgcn_permlane16_swap(__float_as_uint(mx), __float_as_uint(mx), false, false); mx = fmaxf(__uint_as_float(r[0]), __uint_as_float(r[1])); } \
        { const auto r = __builtin_amdgcn_permlane32_swap(__float_as_uint(mx), __float_as_uint(mx), false, false); mx = fmaxf(__uint_as_float(r[0]), __uint_as_float(r[1])); } \
        const float ez = __expf(z - mx); const float den = wave_sum(ez) * 0.25f;          \
        if (((lane >> 2) & 3) == 0) { const int e = (lane & 3) + 4 * (lane >> 4); AFF[((size_t)b * 16 + e) * T + t] = ez * __builtin_amdgcn_rcpf(den); SLOT[(size_t)row * 16 + e] = -1; } } while (0)
    for (int rb = r0; rb < r1; rb += 16) {
        const int b = rb >> 13;
        if (b != curb) { __syncthreads();
            for (int i = tid; i < 3072; i += NTHREADS) { const float x = mod[b * 6144 + 2048 + i]; vec[i] = (i >= 2048) ? x + 1.0f : x; }
            __syncthreads(); curb = b; }
        int lb0 = lane * 16, lb1 = 65536 + lane * 16; asm volatile("" : "+v"(lb0), "+v"(lb1));
        f32x4 ua[4], ub[4];
        LN1_HEAD(xa, ma, ua, rb + wave, rb + 16 + wave);
        __builtin_amdgcn_sched_barrier(0);
        LN1_HEAD(xb, mb, ub, rb + 8 + wave, rb + 24 + wave);
        __builtin_amdgcn_sched_barrier(0);
        f32x2 acc[16];
#pragma unroll
        for (int e = 0; e < 16; ++e) acc[e] = (f32x2){0.f, 0.f};
#pragma unroll
        for (int q = 0; q < 4; ++q) {
            const f32x2 u0 = {ua[q].x, ub[q].x}, u1 = {ua[q].y, ub[q].y}, u2 = {ua[q].z, ub[q].z}, u3 = {ua[q].w, ub[q].w};
#pragma unroll
            for (int eh = 0; eh < 16; eh += 8) { f32x4 r[8];
#pragma unroll
                for (int e = 0; e < 8; ++e) r[e] = *(const LAS f32x4*)(lds + lb0 + (eh + e) * 4096 + q * 1024);
#pragma unroll
                for (int e = 0; e < 8; ++e) { f32x2 t = acc[eh + e];
                    t = __builtin_elementwise_fma(u0, (f32x2){r[e].x, r[e].x}, t); t = __builtin_elementwise_fma(u1, (f32x2){r[e].y, r[e].y}, t);
                    t = __builtin_elementwise_fma(u2, (f32x2){r[e].z, r[e].z}, t); t = __builtin_elementwise_fma(u3, (f32x2){r[e].w, r[e].w}, t); acc[eh + e] = t; }
                __builtin_amdgcn_sched_barrier(0); } }
        LN1_TAIL(x, rb + wave);
        __builtin_amdgcn_sched_barrier(0);
        LN1_TAIL(y, rb + 8 + wave);
        __builtin_amdgcn_sched_barrier(0);
    }
#undef LN1_HEAD
#undef LN1_TAIL
#undef LN1_LOAD
#undef LN1_ROW
}

__device__ __forceinline__ void ph_expert_weights(KP p, LAS unsigned char* lds) {
    const int tid = threadIdx.x, lane = tid & 63, wave = tid >> 6;
    unsigned char* ws = p.ws;
    const int gw = blockIdx.x * NWAVES + wave, NGW = gridDim.x * NWAVES;
    {
        LAS float* scr = (LAS float*)(lds + wave * 8448);
        bf16_t* WGU = (bf16_t*)(ws + WS_WGU); bf16_t* WD = (bf16_t*)(ws + WS_WD);
        constexpr int PER = 16 * 32;
#ifndef TOPK_ITEMS
#define TOPK_ITEMS 9
#endif
        constexpr int NIT = 3 * 16 * PER; const int G = gridDim.x, bx = blockIdx.x;
        int ibase, icnt;
        if (G == 256 && (NIT - 64 * 8 * TOPK_ITEMS) % (192 * 8) == 0) { constexpr int CN = (NIT - 64 * 8 * TOPK_ITEMS) / (192 * 8);
            if (bx < 64) { icnt = TOPK_ITEMS; ibase = 192 * 8 * CN + bx * 8 * TOPK_ITEMS; } else { icnt = CN; ibase = (bx - 64) * 8 * CN; } }
        else { icnt = (NIT + NGW - 1) / NGW; ibase = bx * 8 * icnt; }
        ER(11) for (int ii = 0; ii < icnt; ++ii) { const int it = ibase + ii * 8 + wave; if (it >= NIT) break;
            const int which = it / (16 * PER), r = it % (16 * PER), e = r / PER, kb = (r % PER) / 32, nb = r % 32;
            if (which < 2) { const float* W = p.in[which == 0 ? I_EG : I_EU] + (size_t)e * 1024 * 1024; const int f0 = nb * 32;
                const int drow = 256 * (f0 >> 7) + (which == 1 ? 128 : 0) + (f0 & 127);
                transpose_item(W, 1024, kb * 64, f0, WGU + ((size_t)e * 2048 + drow) * 1024 + kb * 64, 1024, nullptr, scr, lane); }
            else { const float* W = p.in[I_ED] + (size_t)e * 1024 * 1024;
                transpose_item(W, 1024, kb * 64, nb * 32, WD + ((size_t)e * 1024 + nb * 32) * 1024 + kb * 64, 1024, nullptr, scr, lane); }
        }
    }
}

__device__ __forceinline__ void ph_topk(KP p, LAS unsigned char* lds) {
    const int tid = threadIdx.x, lane = tid & 63, wave = tid >> 6;
    unsigned char* ws = p.ws;
    const float* AFF = (const float*)(ws + WS_AFF); int* SLOT = (int*)(ws + WS_SLOT); int* IDX = (int*)(ws + WS_IDX); float* GATE = (float*)(ws + WS_GATE);
    LAS unsigned* hist = (LAS unsigned*)lds;
    LAS unsigned* sh = (LAS unsigned*)(lds + 1024);
    for (int prob = blockIdx.x; prob < 64; prob += gridDim.x) {
        const int b = prob >> 4, e = prob & 15;
        const float* av = AFF + (size_t)prob * T;
        unsigned key[16];
#pragma unroll
        for (int i = 0; i < 4; ++i) { const u32x4 x = *(const u32x4*)(av + tid * 16 + i * 4); key[4 * i] = x.x; key[4 * i + 1] = x.y; key[4 * i + 2] = x.z; key[4 * i + 3] = x.w; }
        unsigned prefix = 0, kth = CAP;
        for (int pass = 0; pass < 4; ++pass) {
            const int shift = 24 - 8 * pass; const unsigned himask = pass == 0 ? 0u : (0xffffffffu << (shift + 8));
            if (tid < 256) hist[tid] = 0u;
            __syncthreads();
#pragma unroll
            for (int i = 0; i < 16; ++i) if ((key[i] & himask) == prefix) atomicAdd((unsigned*)&hist[(key[i] >> shift) & 255u], 1u);
            __syncthreads();
            if (wave == 0) {
                const u32x4 h4 = *(const LAS u32x4*)(hist + lane * 4); const unsigned sl = h4.x + h4.y + h4.z + h4.w; unsigned suf = sl;
#pragma unroll
                for (int o = 1; o < 64; o <<= 1) { const unsigned tt = __shfl_down(suf, o); if (lane + o < 64) suf += tt; }
                const unsigned above = suf - sl;
                if (above < kth && kth <= suf) { unsigned cum = above; int d;
                    if (cum + h4.w >= kth) d = 3; else { cum += h4.w; if (cum + h4.z >= kth) d = 2; else { cum += h4.z; if (cum + h4.y >= kth) d = 1; else { cum += h4.y; d = 0; } } }
                    sh[0] = prefix | ((unsigned)(4 * lane + d) << shift); sh[1] = kth - cum; } }
            __syncthreads();
            prefix = sh[0]; kth = sh[1];
            __syncthreads();
        }
        unsigned ngt = 0, neq = 0;
#pragma unroll
        for (int i = 0; i < 16; ++i) { ngt += key[i] > prefix; neq += key[i] == prefix; }
        unsigned ig = ngt, iq = neq;
#pragma unroll
        for (int o = 1; o < 64; o <<= 1) { const unsigned a = __shfl_up(ig, o), c = __shfl_up(iq, o); if (lane >= o) { ig += a; iq += c; } }
        if (lane == 63) { sh[8 + wave] = ig; sh[16 + wave] = iq; }
        __syncthreads();
        unsigned og = 0, oq = 0;
        for (int w = 0; w < wave; ++w) { og += sh[8 + w]; oq += sh[16 + w]; }
        unsigned eg = og + ig - ngt, eq = oq + iq - neq;
        const int sbase = (e * 4 + b) * CAP;
#pragma unroll
        for (int i = 0; i < 16; ++i) {
            const int t = tid * 16 + i; bool take = false;
            if (key[i] > prefix) take = true; else if (key[i] == prefix) { take = eq < kth; }
            if (take) { const unsigned eqsel = eq < kth ? eq : kth; const int c = (int)(eg + eqsel);
                IDX[sbase + c] = t; GATE[sbase + c] = __uint_as_float(key[i]); SLOT[((size_t)b * T + t) * 16 + e] = c; }
            if (key[i] > prefix) ++eg; else if (key[i] == prefix) ++eq;
        }
        __syncthreads();
    }
}

__device__ __forceinline__ void ph_final(KP p) {
    const int tid = threadIdx.x, lane = tid & 63, wave = tid >> 6;
    unsigned char* ws = p.ws;
    const _Float16* X1 = (const _Float16*)(ws + WS_X1); const bf16_t* YE = (const bf16_t*)(ws + WS_YE); const int* SLOT = (const int*)(ws + WS_SLOT); const float* mod = (const float*)(ws + WS_MOD);
    const int gw = blockIdx.x * NWAVES + wave, NGW = gridDim.x * NWAVES;
    if (gw >= ML) return;
#define FIN_ROWC(r_) ((r_) < ML ? (r_) : gw)
#define FIN_SLOTS(r_) (lane < 16 ? SLOT[(size_t)FIN_ROWC(r_) * 16 + lane] : -1)
#define FIN_GATHER(W, NE, REST, sl_, r_) do { unsigned long long act_ = __ballot((sl_) >= 0); const int b_ = FIN_ROWC(r_) >> 13; NE = 0; \
        _Pragma("unroll") for (int i = 0; i < 4; ++i) { const bool on_ = act_ != 0; const int e_ = on_ ? __builtin_ctzll(act_) : 0; if (on_) { act_ &= act_ - 1; NE = i + 1; } \
            const int c_ = __shfl((sl_), e_); const bf16_t* yr_ = YE + ((size_t)(e_ * 4 + b_) * CAP + (c_ < 0 ? 0 : c_)) * 1024; \
            if (on_) { _Pragma("unroll") for (int q = 0; q < 4; ++q) W[i][q] = *(const u32x2*)(yr_ + q * 256 + lane * 4); } } \
        REST = act_; } while (0)
    int s1 = FIN_SLOTS(gw), s2 = FIN_SLOTS(gw + NGW);
    f32x4 nx[4]; u32x2 nw[4][4]; int nne; unsigned long long nrest;
#pragma unroll
    for (int q = 0; q < 4; ++q) { const h16x4 hv_ = *(const h16x4*)(X1 + (size_t)gw * D + q * 256 + lane * 4); nx[q] = (f32x4){(float)hv_[0], (float)hv_[1], (float)hv_[2], (float)hv_[3]}; }
    FIN_GATHER(nw, nne, nrest, s1, gw);
    ER(14) for (int row = gw; row < ML; row += NGW) {
        const int b = row >> 13;
        const int myslot = s1; const int ne = nne; unsigned long long rest = nrest;
        f32x4 v[4]; u32x2 w[4][4];
#pragma unroll
        for (int q = 0; q < 4; ++q) v[q] = nx[q];
#pragma unroll
        for (int i = 0; i < 4; ++i)
#pragma unroll
            for (int q = 0; q < 4; ++q) w[i][q] = nw[i][q];
        s1 = s2; s2 = FIN_SLOTS(row + 2 * NGW);
        { const int nr = FIN_ROWC(row + NGW);
#pragma unroll
          for (int q = 0; q < 4; ++q) { const h16x4 hv_ = *(const h16x4*)(X1 + (size_t)nr * D + q * 256 + lane * 4); nx[q] = (f32x4){(float)hv_[0], (float)hv_[1], (float)hv_[2], (float)hv_[3]}; }
          FIN_GATHER(nw, nne, nrest, s1, row + NGW); }
        f32x4 m[4];
#pragma unroll
        for (int q = 0; q < 4; ++q) m[q] = (f32x4){0.f, 0.f, 0.f, 0.f};
#pragma unroll
        for (int i = 0; i < 4; ++i) if (i < ne) {
#pragma unroll
            for (int q = 0; q < 4; ++q) { m[q].x += bflo(w[i][q].x); m[q].y += bfhi(w[i][q].x); m[q].z += bflo(w[i][q].y); m[q].w += bfhi(w[i][q].y); } }
        while (rest) {
            const int e = __builtin_ctzll(rest); rest &= rest - 1;
            const int c = __shfl(myslot, e); const bf16_t* yr = YE + ((size_t)(e * 4 + b) * CAP + (c < 0 ? 0 : c)) * 1024;
#pragma unroll
            for (int q = 0; q < 4; ++q) { const u32x2 ww = *(const u32x2*)(yr + q * 256 + lane * 4); m[q].x += bflo(ww.x); m[q].y += bfhi(ww.x); m[q].z += bflo(ww.y); m[q].w += bfhi(ww.y); } }
        float s = 0.f;
#pragma unroll
        for (int q = 0; q < 4; ++q) { const int c = q * 256 + lane * 4; const f32x4 g2 = *(const f32x4*)(mod + b * 6144 + 5120 + c);
            v[q] = v[q] * ALPHA + g2 * m[q]; s += (v[q].x + v[q].y) + (v[q].z + v[q].w); }
        const float mean = wave_sum(s) * (1.f / D); float s2v = 0.f;
#pragma unroll
        for (int q = 0; q < 4; ++q) { v[q] = v[q] - mean; s2v += (v[q].x * v[q].x + v[q].y * v[q].y) + (v[q].z * v[q].z + v[q].w * v[q].w); }
        const float rstd = __builtin_amdgcn_rsqf(wave_sum(s2v) * (1.f / D) + LN_EPS);
#pragma unroll
        for (int q = 0; q < 4; ++q) { const int c = q * 256 + lane * 4; const f32x4 g = *(const f32x4*)(p.in[I_LN2G] + c), bb = *(const f32x4*)(p.in[I_LN2B] + c);
            *(f32x4*)(p.out + (size_t)row * D + c) = v[q] * rstd * g + bb; }
    }
#undef FIN_ROWC
#undef FIN_SLOTS
#undef FIN_GATHER
}

__global__ void __launch_bounds__(NTHREADS, 2) mega(Params p_unused) {
    const Params __attribute__((address_space(4)))* pq = (const Params __attribute__((address_space(4)))*)__builtin_amdgcn_kernarg_segment_ptr();
    KP p = *pq;
    extern __shared__ __attribute__((aligned(16))) unsigned char lds_raw[];
    LAS unsigned char* lds = (LAS unsigned char*)lds_raw;
    cg::grid_group grid = cg::this_grid();
    unsigned char* ws = p.ws;
    const int lo = p.ph_lo, hi = p.ph_hi;
    const int G = gridDim.x, bx = blockIdx.x;
    volatile LAS unsigned* xst = (volatile LAS unsigned*)(lds + LDS_BYTES - 64);
    if (threadIdx.x < 4) xst[threadIdx.x] = 0u;
    __syncthreads();
    const XcdBarrier xbar = xcd_barrier_post((unsigned*)(ws + WS_CTL), xst);
    if (lo < 0) grid.sync();
#ifndef PHMASK
#define PHMASK 0x7fff
#endif
#define IN(k) ((((PHMASK) >> (k)) & 1) && lo <= (k) && (k) < hi)
#define SEAM(k) do { if (IN(k) && IN((k) + 1)) xcd_barrier(xbar); } while (0)
#ifndef DUPMASK
#define DUPMASK 0
#endif
#ifndef GDUP
#define GDUP 0
#endif
#define GD(k) ((((GDUP) >> (k)) & 1) + 1)
#define REPL(k) for (int repl_ = 0; repl_ <= (((DUPMASK) >> (k)) & 1); ++repl_, __syncthreads())
#define REP(k) for (int rep_ = 0; rep_ <= (((DUPMASK) >> (k)) & 1); ++rep_, ((((DUPMASK) >> (k)) & 1) && rep_ == 1 ? grid.sync() : (void)0))
    if (IN(0)) REP(0) { ph_mod_and_weights(p, lds); } SEAM(0);
    if (IN(1)) REP(1) { ph_modulate1(p); } SEAM(1);
    if (IN(2)) REP(2) {
        pg8::Gemm g{(const bf16_t*)(ws + WS_XM), (const bf16_t*)(ws + WS_WIN), 1024, 1024}; pg8::DenseOrder S; S.init(MA, NHP, G, bx, GD(2));
        EpiH E{(bf16_t*)(ws + WS_H)}; pg8::gemm_phase(lds, g, S, E); } SEAM(2);
    if (IN(3)) REP(3) { ph_prepare(p); } SEAM(3);
    if (IN(4)) REP(4) {
        { pg8::Gemm g{(const bf16_t*)(ws + WS_H) + 1920, (const bf16_t*)(ws + WS_WUQ), 256, NHP}; pg8::DenseOrder S; S.init(ML, 768, G, bx, GD(4));
          EpiQ E{(bf16_t*)(ws + WS_Q), (const float*)(ws + WS_RSTDQ)}; pg8::gemm_phase(lds, g, S, E); }
        { pg8::Gemm g{(const bf16_t*)(ws + WS_H) + 2176, (const bf16_t*)(ws + WS_WUKV), 256, NHP}; pg8::DenseOrder S; S.init(MA, 1024, G, bx, GD(4));
          EpiKV E{(bf16_t*)(ws + WS_K), (bf16_t*)(ws + WS_V), (const float*)(ws + WS_RSTDKV)}; pg8::gemm_phase(lds, g, S, E); } } SEAM(4);
    if (IN(5)) REP(5) {
        pg8::Gemm g{(const bf16_t*)(ws + WS_ACT), (const bf16_t*)(ws + WS_WLORA), 128, 384}; pg8::LoraOrder S; S.init(MA, 2560, G, bx, GD(5));
        EpiLora E{(_Float16*)(ws + WS_E16), (_Float16*)(ws + WS_A16), (_Float16*)(ws + WS_G16), p.in[I_W0], p.in[I_A0]}; pg8::gemm_phase(lds, g, S, E); } SEAM(5);
    if (IN(6)) REP(6) {
        const int vcu = (G % 8 == 0) ? (bx % 8) * (G / 8) + bx / 8 : bx;
#ifndef MIXGRP
#define MIXGRP 2
#endif
        const int grp = (MIXGRP == 1) ? 0 : ((G % 8 == 0) ? (bx / 8) % MIXGRP : bx % MIXGRP);
        const int scan_slot = (MIXGRP == 1) ? 2 : (MIXGRP == 2 ? (grp == 0 ? 2 : 0) : 2 - grp);
        int au = vcu; const int natt = vcu < 512 ? (512 - vcu + G - 1) / G : 0; const int sslot = scan_slot < natt ? scan_slot : natt;
        for (int slot = 0; slot <= natt; ++slot) {
            if (slot == sslot) { sc2::pass_a(p, lds); __syncthreads(); }
            else { const int unit = au; au += G; const int bh = unit >> 5, qb = unit & 31; const int b = bh >> 2, hh = bh & 3;
                att2::attn_unit((const bf16_t*)(ws + WS_Q) + ((size_t)bh * T + qb * 256) * 192, (const bf16_t*)(ws + WS_K) + (size_t)bh * SKV * 192, (const bf16_t*)(ws + WS_V) + (size_t)bh * SKV * 128,
                               (bf16_t*)((unsigned char*)p.out + DO_MIX) + ((size_t)b * T + qb * 256) * 1024 + 512 + hh * 128, lds);
                __syncthreads(); }
        }
        } SEAM(6);
    if (IN(7)) REP(7) { sc2::pass_b(p, lds); } SEAM(7);
    if (IN(8)) REP(8) { ph_readout(p); } SEAM(8);
    if (IN(9)) REP(9) {
        pg8::Gemm g{(const bf16_t*)((unsigned char*)p.out + DO_MIX), (const bf16_t*)(ws + WS_WOUT), 1024, 1024}; pg8::DenseOrder S; S.init(ML, 1024, G, bx, GD(9));
        EpiMix E{(bf16_t*)(ws + WS_Y1)}; pg8::gemm_phase(lds, g, S, E); } SEAM(9);
    if (IN(10)) REP(10) { ph_ln1_router(p, lds); } SEAM(10);
    if (IN(11)) REP(11) { ph_topk(p, lds); __syncthreads(); ph_expert_weights(p, lds); } SEAM(11);
    if (IN(12)) REP(12) {
        pg8::Gemm g{(const bf16_t*)(ws + WS_XM2), (const bf16_t*)(ws + WS_WGU), 1024, 1024}; GuOrder S{G, bx, (const int*)(ws + WS_IDX), GD(12)};
        EpiHid E{(bf16_t*)(ws + WS_HID)}; pg8::gemm_phase(lds, g, S, E); } SEAM(12);
    if (IN(13)) REP(13) {
        pg8::Gemm g{(const bf16_t*)(ws + WS_HID), (const bf16_t*)(ws + WS_WD), 1024, 1024}; DnOrder S{G, bx, GD(13)};
        EpiYe E{(bf16_t*)(ws + WS_YE), (const float*)(ws + WS_GATE)}; pg8::gemm_phase(lds, g, S, E); } SEAM(13);
    if (IN(14)) REP(14) { ph_final(p); }
#undef IN
#undef SEAM
}

extern "C" void kernel_launch(void* const* d_in, const int* in_sizes, int n_in, void* d_out, int out_size, void* d_ws, size_t ws_size, hipStream_t stream) {
    static int grid_blocks = 0;
    if (grid_blocks == 0) {
        if (n_in != 32 || out_size != ML * D || ws_size < WS_END) { fprintf(stderr, "kernel_launch: unexpected shapes: n_in %d out %d ws %zu (need %zu)\n", n_in, out_size, ws_size, (size_t)WS_END); grid_blocks = -1; return; }
        int dev = 0, cus = 0, per_cu = 0;
        (void)hipGetDevice(&dev);
        (void)hipDeviceGetAttribute(&cus, hipDeviceAttributeMultiprocessorCount, dev);
        (void)hipFuncSetAttribute((const void*)mega, hipFuncAttributeMaxDynamicSharedMemorySize, LDS_BYTES);
        (void)hipOccupancyMaxActiveBlocksPerMultiprocessor(&per_cu, (const void*)mega, NTHREADS, LDS_BYTES);
        if (per_cu < 1) { fprintf(stderr, "kernel_launch: occupancy query says %d blocks per CU\n", per_cu); grid_blocks = -1; return; }
        grid_blocks = cus;
    }
    if (grid_blocks < 0) return;
    if (hipMemsetAsync((char*)d_ws + WS_CTL, 0, CTL_BYTES, stream) != hipSuccess) { fprintf(stderr, "kernel_launch: memset failed\n"); return; }
    Params p{};
    for (int i = 0; i < 32; ++i) p.in[i] = (const float*)d_in[i];
    p.out = (float*)d_out; p.ws = (unsigned char*)d_ws; p.ph_lo = 0; p.ph_hi = NPHASE;
    void* args[] = {&p};
    hipError_t e = hipLaunchCooperativeKernel((const void*)mega, dim3(grid_blocks), dim3(NTHREADS), args, LDS_BYTES, stream);
    if (e != hipSuccess) fprintf(stderr, "kernel_launch: cooperative launch failed: %s (grid %d)\n", hipGetErrorString(e), grid_blocks);
}
```

```cpp
#include <hip/hip_runtime.h>
#include <hip/hip_cooperative_groups.h>
#include <cstdio>
#include <cstdint>
namespace cg = cooperative_groups;
#ifndef EDUP
#define EDUP 0
#endif
#define ER(k) for (int er_ = 0; er_ <= (((EDUP) >> (k)) & 1); ++er_)

#define LAS __attribute__((address_space(3)))
typedef unsigned short bf16_t;
typedef short bf16x8 __attribute__((ext_vector_type(8)));
typedef short s16x4 __attribute__((ext_vector_type(4)));
typedef float f32x2 __attribute__((ext_vector_type(2)));
typedef float f32x4 __attribute__((ext_vector_type(4)));
typedef float f32x16 __attribute__((ext_vector_type(16)));
typedef unsigned u32x2 __attribute__((ext_vector_type(2)));
typedef unsigned u32x4 __attribute__((ext_vector_type(4)));
typedef _Float16 h16x8 __attribute__((ext_vector_type(8)));
typedef _Float16 h16x4 __attribute__((ext_vector_type(4)));

constexpr int NB = 4, T = 8192, D = 1024, CTX = 256, SKV = T + CTX;
constexpr int ML = NB * T, MC = NB * CTX, MA = ML + MC;
constexpr int NHP = 2560, IN_PROJ = 2496;
constexpr int NE = 16, CAP = 1024, NSLOT = NE * NB * CAP;
constexpr int NTHREADS = 512, NWAVES = 8;
constexpr int LDS_BYTES = 163840;
constexpr int NPHASE = 15;
#ifndef USE_DIRECT_SCAN
#define USE_DIRECT_SCAN 0
#endif
constexpr float LN_EPS = 1e-5f, RMS_EPS = 1e-6f, GN_EPS = 64e-5f;
constexpr float ALPHA = 1.189207115002721f;

constexpr size_t MiB = 1u << 20;
constexpr size_t WS_CTL = 0, CTL_BYTES = 16384;
constexpr size_t WS_MOD = 1 * MiB, WS_RSTDQ = 1 * MiB + 256 * 1024, WS_RSTDKV = 1 * MiB + 512 * 1024;
constexpr size_t WS_WIN = 2 * MiB, WS_WLORA = 7 * MiB, WS_WUQ = 9 * MiB, WS_WUKV = 9 * MiB + 512 * 1024, WS_WOUT = 10 * MiB;
constexpr size_t WS_RN = 12 * MiB;
constexpr size_t WS_H = 16 * MiB;
constexpr size_t SZ_L16 = (size_t)MA * 512 * 2;
constexpr size_t WS_E16 = WS_H, WS_A16 = WS_H + 2 * SZ_L16, WS_G16 = WS_H + 4 * SZ_L16;
constexpr size_t WS_Y1 = 16 * MiB, WS_HID = 16 * MiB;
constexpr size_t WS_WD = 144 * MiB, WS_WGU = 176 * MiB, WS_XM2 = 240 * MiB, WS_YE = 176 * MiB;
constexpr size_t WS_RKV = 181 * MiB;
constexpr size_t WS_XM = 280 * MiB, WS_ACT = 280 * MiB;
constexpr size_t WS_Q = 346 * MiB, WS_K = 394 * MiB, WS_V = 444 * MiB, WS_X1 = 346 * MiB;
constexpr size_t WS_AFF = 478 * MiB, WS_SLOT = 480 * MiB, WS_IDX = 482 * MiB, WS_GATE = 482 * MiB + 512 * 1024;
constexpr size_t WS_QC0 = 280 * MiB, WS_SEG = 314 * MiB, WS_QC1 = 477 * MiB;
constexpr size_t WS_END = 510 * MiB;
constexpr size_t DO_YS = 0, DO_MIX = 64 * MiB;

struct Params { const float* in[32]; float* out; unsigned char* ws; int ph_lo, ph_hi; };
typedef const Params __attribute__((address_space(4)))& KP;
enum { I_X = 0, I_C, I_CTX, I_CCTX, I_WADA, I_BADA, I_WIN, I_CONV, I_W0, I_WUP, I_A0, I_AUP, I_GUP, I_KK, I_KA, I_RK, I_GNG, I_GNB,
       I_QNORM, I_WUQ, I_KVNORM, I_WUK, I_WUV, I_WOUT, I_LN1G, I_LN1B, I_ROUTER, I_EG, I_EU, I_ED, I_LN2G, I_LN2B };

__device__ __forceinline__ unsigned cvt_pk_bf16(float lo, float hi) { unsigned r; asm volatile("v_cvt_pk_bf16_f32 %0, %1, %2" : "=v"(r) : "v"(lo), "v"(hi)); return r; }
typedef __bf16 bf16x2_t __attribute__((ext_vector_type(2)));
__device__ __forceinline__ unsigned cvt_pk_bf16_n(float lo, float hi) { const f32x2 v = {lo, hi}; const bf16x2_t b = __builtin_convertvector(v, bf16x2_t); return __builtin_bit_cast(unsigned, b); }
__device__ __forceinline__ float bf2f(unsigned short b) { return __uint_as_float(((unsigned)b) << 16); }
__device__ __forceinline__ float bflo(unsigned w) { return __uint_as_float(w << 16); }
__device__ __forceinline__ float bfhi(unsigned w) { return __uint_as_float(w & 0xffff0000u); }
template <int CTRL> __device__ __forceinline__ float dppf(float x) { return __int_as_float(__builtin_amdgcn_update_dpp(0, __float_as_int(x), CTRL, 0xF, 0xF, true)); }
__device__ __forceinline__ float allred16(float x) { x += dppf<0xB1>(x); x += dppf<0x4E>(x); x += dppf<0x141>(x); x += dppf<0x140>(x); return x; }
__device__ __forceinline__ float wave_sum(float v) {
    v = allred16(v);
    { const auto r16 = __builtin_amdgcn_permlane16_swap(__float_as_uint(v), __float_as_uint(v), false, false); v = __uint_as_float(r16[0]) + __uint_as_float(r16[1]); }
    const auto rr = __builtin_amdgcn_permlane32_swap(__float_as_uint(v), __float_as_uint(v), false, false);
    return __uint_as_float(rr[0]) + __uint_as_float(rr[1]);
}
__device__ __forceinline__ float sigmoidf_(float x) { return __builtin_amdgcn_rcpf(1.0f + __builtin_amdgcn_exp2f(-1.4426950408889634f * x)); }
#define LDS_WAIT() asm volatile("s_waitcnt lgkmcnt(0)" ::: "memory")


#define XB_TMO      128
#define XB_XCNT(j)  (256  + 64 * (j))
#define XB_XSUB(j)  (1280 + 64 * (j))
#define XB_XGEN(j)  (2304 + 64 * (j))
#define XB_TOP      3328
#define XB_TOPGEN   3392
#define XCD_BAR_WORDS 3456
#define XB_SPIN_CAP (1u << 18)
__device__ __forceinline__ unsigned xb_ld(unsigned* p)              { return __hip_atomic_load(p, __ATOMIC_RELAXED, __HIP_MEMORY_SCOPE_AGENT); }
__device__ __forceinline__ unsigned xb_add(unsigned* p, unsigned v) { return __hip_atomic_fetch_add(p, v, __ATOMIC_RELAXED, __HIP_MEMORY_SCOPE_AGENT); }
__device__ __forceinline__ unsigned xb_xcc_id() { return (unsigned)__builtin_amdgcn_s_getreg((3 << 11) | 20) & 0xFu; }
#define XB_SPIN(cond, bar) do { unsigned _sp = 0; while (cond) { __builtin_amdgcn_s_sleep(1); \
    if ((++_sp & 255u) == 0u) { if (xb_ld(&(bar)[XB_TMO])) break; if (_sp > XB_SPIN_CAP) { atomicAdd(&(bar)[XB_TMO], 1u); break; } } } } while (0)
struct XcdBarrier { unsigned* bar; unsigned x; volatile LAS unsigned* st; };
__device__ __forceinline__ XcdBarrier xcd_barrier_post(unsigned* bar, volatile LAS unsigned* st) {
    XcdBarrier b; b.bar = bar; b.x = xb_xcc_id(); b.st = st;
    if (threadIdx.x == 0) (void)xb_add(&bar[XB_XCNT(b.x)], 1u);
    return b;
}
__device__ __forceinline__ void xcd_barrier_complete(unsigned* bar, unsigned x, unsigned& nloc, unsigned& nx) {
    const unsigned G = gridDim.x * gridDim.y * gridDim.z;
    unsigned sum, cnt, mine, sp = 0u;
    for (;;) {
        sum = 0u; cnt = 0u; mine = 0u;
#pragma unroll
        for (unsigned j = 0; j < 16; ++j) { const unsigned c = xb_ld(&bar[XB_XCNT(j)]); sum += c; cnt += (c > 0u) ? 1u : 0u; mine = (j == x) ? c : mine; }
        if (sum == G) break;
        __builtin_amdgcn_s_sleep(1);
        if ((++sp & 255u) == 0u) { if (xb_ld(&bar[XB_TMO])) break; if (sp > XB_SPIN_CAP) { atomicAdd(&bar[XB_TMO], 1u); break; } }
    }
    nloc = mine > 0u ? mine : 1u; nx = cnt > 0u ? cnt : 1u;
}
__device__ __forceinline__ void xcd_barrier(const XcdBarrier& b) {
    asm volatile("s_waitcnt vmcnt(0)" ::: "memory");
    __syncthreads();
    if (threadIdx.x == 0) {
        unsigned* bar = b.bar;
        __builtin_amdgcn_s_waitcnt(0);
        unsigned nloc = b.st[0], nx = b.st[1];
        if (nloc == 0u) { xcd_barrier_complete(bar, b.x, nloc, nx); b.st[0] = nloc; b.st[1] = nx; }
        const unsigned old = xb_add(&bar[XB_XSUB(b.x)], 1u);
        const unsigned gen = old / nloc;
        if (old + 1u == (gen + 1u) * nloc) {
            __builtin_amdgcn_fence(__ATOMIC_RELEASE, "agent");
            asm volatile("s_waitcnt vmcnt(0)" ::: "memory");
            const unsigned og = xb_add(&bar[XB_TOP], 1u);
            const unsigned tg = og / nx;
            if (og + 1u == (tg + 1u) * nx) xb_add(&bar[XB_TOPGEN], 1u);
            else XB_SPIN(xb_ld(&bar[XB_TOPGEN]) == tg, bar);
            __builtin_amdgcn_fence(__ATOMIC_ACQUIRE, "agent");
            xb_add(&bar[XB_XGEN(b.x)], 1u);
            asm volatile("s_waitcnt vmcnt(0)" ::: "memory");
        } else {
            XB_SPIN(xb_ld(&bar[XB_XGEN(b.x)]) == gen, bar);
            __builtin_amdgcn_fence(__ATOMIC_ACQUIRE, "agent");
            asm volatile("s_waitcnt vmcnt(0)" ::: "memory");
        }
    }
    __syncthreads();
}

namespace pg8 {
constexpr int BM = 256, BK = 64, HALF = 128, HTB = HALF * BK * 2, STAGE_BYTES = 8 * HTB;
__device__ __forceinline__ int lds_byte(int r, int c) { const int st = (r >> 4) * 2 + (c >> 5), rr = r & 15, cc = c & 31, ob = rr * 64 + cc * 2; return st * 1024 + (ob ^ (((ob >> 9) & 1) << 5)); }
__device__ __forceinline__ void stage_rc(int b, int& R, int& C) { const int st = b / 1024, sb = b % 1024, swz = sb ^ (((sb >> 9) & 1) << 5); R = (st >> 1) * 16 + swz / 64; C = (st & 1) * 32 + (swz % 64) / 2; }
__device__ __forceinline__ int perm32(int rho) { const int n = rho >> 4, i = rho & 15; return 8 * (i >> 2) + 4 * n + (i & 3); }
struct Unit { int pm, pn; };
struct Gemm { const bf16_t* A; const bf16_t* Bt; int K, lda; };

struct DenseOrder {
    int nM, nN, nwg, G, c, dupf;
    __device__ void init(int M, int N, int G_, int c_, int dupf_ = 1) { nM = M / BM; nN = N / BM; nwg = nM * nN; G = G_; c = c_; dupf = dupf_; }
    __device__ bool next(int i, Unit& u) const {
        const long L = (long)i * G + c; if (L >= (long)nwg * dupf) return false;
        int wgid = (int)(L % nwg); { const int q = nwg / 8, r = nwg % 8, xcd = wgid % 8, off = wgid / 8; wgid = (xcd < r ? xcd * (q + 1) : r * (q + 1) + (xcd - r) * q) + off; }
        const int nig = 8 * nN, gid = wgid / nig, fm = gid * 8, gsz = (nM - fm) < 8 ? (nM - fm) : 8;
        u.pm = fm + ((wgid % nig) % gsz); u.pn = (wgid % nig) / gsz; return true;
    }
    __device__ __forceinline__ int arow(const Unit& u, int r) const { return u.pm * BM + r; }
    __device__ __forceinline__ int acol(const Unit&) const { return 0; }
};
struct LoraOrder : DenseOrder { __device__ __forceinline__ int acol(const Unit& u) const { return u.pn < 4 ? 0 : (u.pn < 8 ? 128 : 256); } };

template <class Epi, class Sched>
__device__ __forceinline__ void gemm_phase(LAS unsigned char* lds, const Gemm g, const Sched& S, const Epi& E) {
    const int tid = threadIdx.x, wid = __builtin_amdgcn_readfirstlane(tid >> 6), lane = tid & 63, wr = wid >> 2, wc = wid & 3, fr = lane & 15, fq = lane >> 4;
    int K = g.K; asm volatile("" : "+s"(K));
    const int nt = K / BK;
    int Rr[2], Cc[2]; unsigned voffB[2];
#pragma unroll
    for (int i = 0; i < 2; ++i) { int R, C; stage_rc(tid * 16 + i * 8192, R, C); Rr[i] = R; Cc[i] = C; const int Rb = Epi::PERM ? ((R & ~31) + perm32(R & 31)) : R; voffB[i] = (unsigned)(Rb * K + C) * 2u; }
    const size_t kstep = (size_t)(BK * 2);
    const size_t hstepB = (size_t)HALF * K * 2, tstepB = 2 * hstepB;
    const unsigned ldsw = (unsigned)wid * 1024u;
    const int aoff = lds_byte(wr * 64 + fr, fq * 8), boff = lds_byte(wc * 32 + fr, fq * 8);
#define PG8_SA(b, h) (((b) * 2 + (h)) * HTB)
#define PG8_SB(b, h) ((4 + (b) * 2 + (h)) * HTB)
#define PG8_STAGE(bufoff, gbase, voff) do { _Pragma("unroll") for (int _i = 0; _i < 2; ++_i) \
        __builtin_amdgcn_global_load_lds((const unsigned*)((const char*)(gbase) + (voff)[_i]), (LAS unsigned*)(lds + (bufoff) + ldsw + _i * 8192), 16, 0, 0); } while (0)
#define PG8_LDA(dst, b, h) do { _Pragma("unroll") for (int m = 0; m < 4; ++m) _Pragma("unroll") for (int k = 0; k < 2; ++k) dst[m][k] = *(const LAS bf16x8*)(lds + PG8_SA(b, h) + aoff + m * 2048 + k * 1024); } while (0)
#define PG8_LDB(dst, b, h) do { _Pragma("unroll") for (int n = 0; n < 2; ++n) _Pragma("unroll") for (int k = 0; k < 2; ++k) dst[n][k] = *(const LAS bf16x8*)(lds + PG8_SB(b, h) + boff + n * 2048 + k * 1024); } while (0)
#define PG8_MMA(ai, bj, At, Bt) do { __builtin_amdgcn_s_setprio(1); _Pragma("unroll") for (int m = 0; m < 4; ++m) _Pragma("unroll") for (int n = 0; n < 2; ++n) _Pragma("unroll") for (int k = 0; k < 2; ++k) \
        acc[ai][bj][m][n] = __builtin_amdgcn_mfma_f32_16x16x32_bf16(Bt[n][k], At[m][k], acc[ai][bj][m][n], 0, 0, 0); __builtin_amdgcn_s_setprio(0); } while (0)
#define PG8_WAIT_V(n) asm volatile("s_waitcnt vmcnt(" #n ")" ::: "memory")
#define PG8_WAIT_L(n) asm volatile("s_waitcnt lgkmcnt(" #n ")" ::: "memory")
#define PG8_BAR __builtin_amdgcn_s_barrier()
#define PG8_SCHED __builtin_amdgcn_sched_barrier(0)
#define PG8_LOADVO(dst, u) do { _Pragma("unroll") for (int _h = 0; _h < 2; ++_h) _Pragma("unroll") for (int _i = 0; _i < 2; ++_i) \
        dst[_h][_i] = ((unsigned)S.arow(u, _h * HALF + Rr[_i]) * (unsigned)g.lda + (unsigned)Cc[_i] + (unsigned)S.acol(u)) * 2u; } while (0)
    Unit cur, nxt; int ui = 0;
    if (!S.next(0, cur)) return;
    f32x4 acc[2][2][4][2];
#pragma unroll
    for (int a = 0; a < 2; ++a)
#pragma unroll
        for (int b = 0; b < 2; ++b)
#pragma unroll
            for (int m = 0; m < 4; ++m)
#pragma unroll
                for (int n = 0; n < 2; ++n) acc[a][b][m][n] = (f32x4){0.f, 0.f, 0.f, 0.f};
    bf16x8 At[4][2], B0[2][2], B1[2][2];
    unsigned voA[2][2], voN[2][2];
    PG8_LOADVO(voA, cur);
    const char* Ab = (const char*)g.A;
    const char* cB = (const char*)g.Bt + (size_t)cur.pn * tstepB;
    PG8_STAGE(PG8_SB(0, 0), cB, voffB); PG8_STAGE(PG8_SA(0, 0), Ab, voA[0]); PG8_STAGE(PG8_SB(0, 1), cB + hstepB, voffB); PG8_STAGE(PG8_SA(0, 1), Ab, voA[1]);
    if (wr == 1) PG8_BAR;
    PG8_WAIT_V(4); PG8_BAR;
    PG8_STAGE(PG8_SB(1, 0), cB + kstep, voffB); PG8_STAGE(PG8_SA(1, 0), Ab + kstep, voA[0]); PG8_STAGE(PG8_SB(1, 1), cB + hstepB + kstep, voffB);
    PG8_WAIT_V(6); PG8_BAR;
    for (;;) {
        const bool has_next = S.next(ui + 1, nxt);
        if (has_next) { PG8_LOADVO(voN, nxt); }
        else {
#pragma unroll
            for (int h = 0; h < 2; ++h)
#pragma unroll
                for (int i = 0; i < 2; ++i) voN[h][i] = voA[h][i]; }
        const char* nB = has_next ? (const char*)g.Bt + (size_t)nxt.pn * tstepB : cB;
#pragma unroll 1
        for (int t = 0; t < nt; t += 2) {
            const bool last = (t == nt - 2);
            const char* a1 = Ab + (size_t)(t + 1) * kstep;
            const char* a2 = last ? Ab : Ab + (size_t)(t + 2) * kstep; const char* b2 = last ? nB : cB + (size_t)(t + 2) * kstep;
            const char* a3 = a2 + kstep; const char* b3 = b2 + kstep;
            unsigned o2[2][2];
#pragma unroll
            for (int h = 0; h < 2; ++h)
#pragma unroll
                for (int i = 0; i < 2; ++i) o2[h][i] = last ? voN[h][i] : voA[h][i];
            PG8_LDB(B0, 0, 0); PG8_SCHED; PG8_LDA(At, 0, 0); PG8_STAGE(PG8_SA(1, 1), a1, voA[1]);
            PG8_WAIT_L(8); PG8_BAR; PG8_WAIT_L(0); PG8_MMA(0, 0, At, B0); PG8_BAR; PG8_SCHED;
            PG8_LDB(B1, 0, 1); PG8_STAGE(PG8_SB(0, 0), b2, voffB);
            PG8_BAR; PG8_WAIT_L(0); PG8_MMA(0, 1, At, B1); PG8_BAR;
            PG8_LDA(At, 0, 1); PG8_STAGE(PG8_SA(0, 0), a2, o2[0]);
            PG8_BAR; PG8_WAIT_L(0); PG8_MMA(1, 0, At, B0); PG8_BAR; PG8_SCHED;
            PG8_STAGE(PG8_SB(0, 1), b2 + hstepB, voffB);
            PG8_WAIT_V(6); PG8_BAR; PG8_MMA(1, 1, At, B1); PG8_BAR;
            PG8_LDB(B0, 1, 0); PG8_SCHED; PG8_LDA(At, 1, 0); PG8_STAGE(PG8_SA(0, 1), a2, o2[1]);
            PG8_WAIT_L(8); PG8_BAR; PG8_WAIT_L(0); PG8_MMA(0, 0, At, B0); PG8_BAR; PG8_SCHED;
            PG8_LDB(B1, 1, 1); PG8_STAGE(PG8_SB(1, 0), b3, voffB);
            PG8_BAR; PG8_WAIT_L(0); PG8_MMA(0, 1, At, B1); PG8_BAR;
            PG8_LDA(At, 1, 1); PG8_STAGE(PG8_SA(1, 0), a3, o2[0]);
            PG8_BAR; PG8_WAIT_L(0); PG8_MMA(1, 0, At, B0); PG8_BAR; PG8_SCHED;
            PG8_STAGE(PG8_SB(1, 1), b3 + hstepB, voffB);
            PG8_WAIT_V(6); PG8_BAR; PG8_MMA(1, 1, At, B1); PG8_BAR;
        }
        { int fr_ = fr, fq_ = fq; asm volatile("" : "+v"(fr_), "+v"(fq_)); E(acc, cur, wr, wc, fr_, fq_); }
        if (!has_next) break;
#pragma unroll
        for (int a = 0; a < 2; ++a)
#pragma unroll
            for (int b = 0; b < 2; ++b)
#pragma unroll
                for (int m = 0; m < 4; ++m)
#pragma unroll
                    for (int n = 0; n < 2; ++n) acc[a][b][m][n] = (f32x4){0.f, 0.f, 0.f, 0.f};
        cur = nxt; cB = nB; ++ui;
#pragma unroll
        for (int h = 0; h < 2; ++h)
#pragma unroll
            for (int i = 0; i < 2; ++i) voA[h][i] = voN[h][i];
    }
    PG8_WAIT_V(0);
    if (wr == 0) PG8_BAR;
    PG8_BAR;
#undef PG8_SA
#undef PG8_SB
#undef PG8_STAGE
#undef PG8_LDA
#undef PG8_LDB
#undef PG8_MMA
#undef PG8_WAIT_V
#undef PG8_WAIT_L
#undef PG8_BAR
#undef PG8_SCHED
#undef PG8_LOADVO
}
}
using pg8::Unit;

typedef const f32x4 (&AccRef)[2][2][4][2];

struct EpiH {
    static constexpr bool PERM = true; bf16_t* O;
    __device__ __forceinline__ void operator()(AccRef acc, const Unit& u, int wr, int wc, int fr, int fq) const {
        const int row0 = u.pm * 256 + wr * 64 + fr, col0 = u.pn * 256 + wc * 32 + 8 * fq;
#pragma unroll
        for (int ai = 0; ai < 2; ++ai)
#pragma unroll
            for (int m = 0; m < 4; ++m) { bf16_t* rowp = O + (size_t)(row0 + ai * 128 + m * 16) * NHP + col0;
#pragma unroll
                for (int bj = 0; bj < 2; ++bj) { const f32x4 v0 = acc[ai][bj][m][0], v1 = acc[ai][bj][m][1];
                    u32x4 w; w.x = cvt_pk_bf16(v0[0], v0[1]); w.y = cvt_pk_bf16(v0[2], v0[3]); w.z = cvt_pk_bf16(v1[0], v1[1]); w.w = cvt_pk_bf16(v1[2], v1[3]);
                    *(u32x4*)(rowp + bj * 128) = w; } }
    }
};

__device__ __forceinline__ float rope_invfreq(int j) { return __builtin_amdgcn_exp2f(-(float)(2 * j) * (13.287712379549449f / 32.0f)) * 0.15915494309189535f; }

struct EpiQ {
    static constexpr bool PERM = false; bf16_t* Q; const float* rstd;
    __device__ __forceinline__ void operator()(AccRef acc, const Unit& u, int wr, int wc, int fr, int fq) const {
        const int row0 = u.pm * 256 + wr * 64 + fr;
        float fr4[4];
#pragma unroll
        for (int i = 0; i < 4; ++i) fr4[i] = rope_invfreq(4 * fq + i);
#pragma unroll
        for (int ai = 0; ai < 2; ++ai)
#pragma unroll
            for (int m = 0; m < 4; ++m) {
                const int row = row0 + ai * 128 + m * 16; const int b = row >> 13, t = row & (T - 1);
                const float rs = rstd[row];
#pragma unroll
                for (int bj = 0; bj < 2; ++bj) {
                    const int cgp = u.pn * 8 + bj * 4 + wc;
                    const int head = cgp / 6, wg = cgp - head * 6;
                    bf16_t* qp = Q + ((size_t)(b * 4 + head) * T + t) * 192 + wg * 32 + 4 * fq;
                    f32x4 x1 = acc[ai][bj][m][0] * rs, x2 = acc[ai][bj][m][1] * rs;
                    if (wg >= 4) {
                        const float pos = (float)(wg == 4 ? (t >> 6) : (t & 63));
#pragma unroll
                        for (int i = 0; i < 4; ++i) { float rev = pos * fr4[i]; rev = rev - floorf(rev);
                            const float sn = __builtin_amdgcn_sinf(rev), cs = __builtin_amdgcn_cosf(rev);
                            const float a = x1[i], bb = x2[i]; x1[i] = a * cs - bb * sn; x2[i] = bb * cs + a * sn; }
                    }
                    u32x2 w0, w1; w0.x = cvt_pk_bf16(x1[0], x1[1]); w0.y = cvt_pk_bf16(x1[2], x1[3]); w1.x = cvt_pk_bf16(x2[0], x2[1]); w1.y = cvt_pk_bf16(x2[2], x2[3]);
                    *(u32x2*)qp = w0; *(u32x2*)(qp + 16) = w1;
                }
                asm volatile("" ::: "memory");
            }
    }
};

struct EpiKV {
    static constexpr bool PERM = true; bf16_t* Kb; bf16_t* Vb; const float* rstd;
    __device__ __forceinline__ void operator()(AccRef acc, const Unit& u, int wr, int wc, int fr, int fq) const {
        const int row0 = u.pm * 256 + wr * 64 + fr; const bool isv = u.pn >= 2; const int c0 = wc * 32 + 8 * fq;
#pragma unroll
        for (int ai = 0; ai < 2; ++ai)
#pragma unroll
            for (int m = 0; m < 4; ++m) {
                const int row = row0 + ai * 128 + m * 16; int b, key;
                if (row < ML) { b = row >> 13; key = CTX + (row & (T - 1)); } else { const int rc = row - ML; b = rc >> 8; key = rc & (CTX - 1); }
                const float rs = rstd[row];
#pragma unroll
                for (int bj = 0; bj < 2; ++bj) { const int head = ((u.pn & 1) << 1) + bj;
                    const f32x4 v0 = acc[ai][bj][m][0] * rs, v1 = acc[ai][bj][m][1] * rs;
                    u32x4 w; w.x = cvt_pk_bf16(v0[0], v0[1]); w.y = cvt_pk_bf16(v0[2], v0[3]); w.z = cvt_pk_bf16(v1[0], v1[1]); w.w = cvt_pk_bf16(v1[2], v1[3]);
                    const size_t kr = (size_t)(b * 4 + head) * SKV + key;
                    if (isv) *(u32x4*)(Vb + kr * 128 + c0) = w; else *(u32x4*)(Kb + kr * 192 + c0) = w; }
                asm volatile("" ::: "memory");
            }
    }
};

struct EpiLora {
    static constexpr bool PERM = true; _Float16* E16; _Float16* A16; _Float16* G16; const float* w0; const float* a0;
    __device__ __forceinline__ void operator()(AccRef acc, const Unit& u, int wr, int wc, int fr, int fq) const {
        const int row0 = u.pm * 256 + wr * 64 + fr; const int type = u.pn >> 1, dir = type & 1;
        _Float16* dst = type < 2 ? E16 + (size_t)dir * MA * 512 : (type < 4 ? A16 + (size_t)dir * MA * 512 : G16);
        const float* bias = type < 2 ? w0 + dir * 512 : a0 + dir * 512;
#pragma unroll
        for (int bj = 0; bj < 2; ++bj) { const int ch = (u.pn & 1) * 256 + bj * 128 + wc * 32 + 8 * fq;
            f32x4 b0 = {0.f, 0.f, 0.f, 0.f}, b1 = {0.f, 0.f, 0.f, 0.f};
            if (type < 4) { b0 = *(const f32x4*)(bias + ch); b1 = *(const f32x4*)(bias + ch + 4); }
#pragma unroll
            for (int ai = 0; ai < 2; ++ai)
#pragma unroll
                for (int m = 0; m < 4; ++m) { const int row = row0 + ai * 128 + m * 16;
                    f32x4 v0 = acc[ai][bj][m][0] + b0, v1 = acc[ai][bj][m][1] + b1;
                    if (type < 4) {
                        const float sc = type < 2 ? 0.6065306597126334f : 1.0f;
#pragma unroll
                        for (int i = 0; i < 4; ++i) { v0[i] = sc * sigmoidf_(v0[i]); v1[i] = sc * sigmoidf_(v1[i]); } }
                    h16x8 o; o[0] = (_Float16)v0[0]; o[1] = (_Float16)v0[1]; o[2] = (_Float16)v0[2]; o[3] = (_Float16)v0[3]; o[4] = (_Float16)v1[0]; o[5] = (_Float16)v1[1]; o[6] = (_Float16)v1[2]; o[7] = (_Float16)v1[3];
                    *(h16x8*)(dst + (size_t)row * 512 + ch) = o; asm volatile("" ::: "memory"); } }
    }
};

struct EpiMix {
    static constexpr bool PERM = true; bf16_t* O;
    __device__ __forceinline__ void operator()(AccRef acc, const Unit& u, int wr, int wc, int fr, int fq) const {
        const int row0 = u.pm * 256 + wr * 64 + fr, col0 = u.pn * 256 + wc * 32 + 8 * fq;
#pragma unroll
        for (int ai = 0; ai < 2; ++ai)
#pragma unroll
            for (int m = 0; m < 4; ++m) { bf16_t* rowp = O + (size_t)(row0 + ai * 128 + m * 16) * D + col0;
#pragma unroll
                for (int bj = 0; bj < 2; ++bj) { const f32x4 v0 = acc[ai][bj][m][0], v1 = acc[ai][bj][m][1];
                    u32x4 w; w.x = cvt_pk_bf16(v0[0], v0[1]); w.y = cvt_pk_bf16(v0[2], v0[3]); w.z = cvt_pk_bf16(v1[0], v1[1]); w.w = cvt_pk_bf16(v1[2], v1[3]);
                    *(u32x4*)(rowp + bj * 128) = w; } }
    }
};

struct EpiHid {
    static constexpr bool PERM = true; bf16_t* Hd;
    __device__ __forceinline__ void operator()(AccRef acc, const Unit& u, int wr, int wc, int fr, int fq) const {
        const int row0 = u.pm * 256 + wr * 64 + fr, col0 = (u.pn & 7) * 128 + wc * 32 + 8 * fq;
#pragma unroll
        for (int ai = 0; ai < 2; ++ai)
#pragma unroll
            for (int m = 0; m < 4; ++m) {
                f32x4 v0, v1;
#pragma unroll
                for (int i = 0; i < 4; ++i) { const float g0 = acc[ai][0][m][0][i], g1 = acc[ai][0][m][1][i];
                    v0[i] = g0 * sigmoidf_(g0) * acc[ai][1][m][0][i]; v1[i] = g1 * sigmoidf_(g1) * acc[ai][1][m][1][i]; }
                u32x4 w; w.x = cvt_pk_bf16(v0[0], v0[1]); w.y = cvt_pk_bf16(v0[2], v0[3]); w.z = cvt_pk_bf16(v1[0], v1[1]); w.w = cvt_pk_bf16(v1[2], v1[3]);
                *(u32x4*)(Hd + (size_t)(row0 + ai * 128 + m * 16) * 1024 + col0) = w; }
    }
};

struct EpiYe {
    static constexpr bool PERM = true; bf16_t* Ye; const float* gate;
    __device__ __forceinline__ void operator()(AccRef acc, const Unit& u, int wr, int wc, int fr, int fq) const {
        const int row0 = u.pm * 256 + wr * 64 + fr, col0 = (u.pn & 3) * 256 + wc * 32 + 8 * fq;
#pragma unroll
        for (int ai = 0; ai < 2; ++ai)
#pragma unroll
            for (int m = 0; m < 4; ++m) { const int row = row0 + ai * 128 + m * 16; const float gt = gate[row];
#pragma unroll
                for (int bj = 0; bj < 2; ++bj) { const f32x4 v0 = acc[ai][bj][m][0] * gt, v1 = acc[ai][bj][m][1] * gt;
                    u32x4 w; w.x = cvt_pk_bf16(v0[0], v0[1]); w.y = cvt_pk_bf16(v0[2], v0[3]); w.z = cvt_pk_bf16(v1[0], v1[1]); w.w = cvt_pk_bf16(v1[2], v1[3]);
                    *(u32x4*)(Ye + (size_t)row * 1024 + col0 + bj * 128) = w; } }
    }
};

struct GuOrder {
    int G, c; const int* idx; int dupf;
    __device__ bool next(int i, Unit& u) const { long L = (long)i * G + c; if (L >= 2048L * dupf) return false; L &= 2047;
        const int e = (int)L >> 7, w = (int)L & 127;
        const int xc = w & 7, k = w >> 3; u.pn = e * 8 + (xc & 3) * 2 + (k & 1); u.pm = e * 16 + (xc >> 2) * 8 + (k >> 1); return true; }
    __device__ __forceinline__ int arow(const Unit& u, int r) const { return ((u.pm >> 2) & 3) * T + idx[u.pm * 256 + r]; }
    __device__ __forceinline__ int acol(const Unit&) const { return 0; }
};
struct DnOrder {
    int G, c, dupf;
    __device__ bool next(int i, Unit& u) const { long L = (long)i * G + c; if (L >= 1024L * dupf) return false; L &= 1023;
        const int e = (int)L >> 6, w = (int)L & 63; u.pm = e * 16 + (w >> 2); u.pn = e * 4 + (w & 3); return true; }
    __device__ __forceinline__ int arow(const Unit& u, int r) const { return u.pm * 256 + r; }
    __device__ __forceinline__ int acol(const Unit&) const { return 0; }
};

namespace att {
constexpr int DQK = 192, DV = 128, KVBLK = 64, QBLK = 32;
constexpr float SCALE = 0.07216878364870322f;
constexpr float THR = 8.f;
constexpr int KPITCH = 400;
constexpr int SHM_V = KVBLK * DV * 2, SHM_K = KVBLK * KPITCH;
constexpr int SHM_ATTN = 2 * SHM_V + 2 * SHM_K + NWAVES * 64 * 4;
#define SBAR() __builtin_amdgcn_sched_barrier(0)
__device__ __forceinline__ int crow(int r, int hi) { return (r & 3) + 8 * (r >> 2) + 4 * hi; }
__device__ __forceinline__ void partialSM(f32x16& p0, f32x16& p1, float& m_reg, float& mn, float& alpha) {
    constexpr float C = SCALE * 1.4426950408889634f;
    float pmax = p0[0];
#pragma unroll
    for (int r = 1; r < 16; ++r) pmax = fmaxf(pmax, p0[r]);
#pragma unroll
    for (int r = 0; r < 16; ++r) pmax = fmaxf(pmax, p1[r]);
    { auto rr = __builtin_amdgcn_permlane32_swap(__float_as_uint(pmax), __float_as_uint(pmax), false, false);
      pmax = fmaxf(__uint_as_float(rr[0]), __uint_as_float(rr[1])); }
    if (__builtin_expect(__all(pmax - m_reg <= THR / SCALE), 1)) { mn = m_reg; alpha = 1.f; }
    else { mn = fmaxf(m_reg, pmax); alpha = __builtin_amdgcn_exp2f((m_reg - mn) * C); m_reg = mn; }
    const float mnC = -mn * C;
#pragma unroll
    for (int r = 0; r < 16; ++r) p0[r] = fmaf(p0[r], C, mnC);
#pragma unroll
    for (int r = 0; r < 16; ++r) p1[r] = fmaf(p1[r], C, mnC);
#pragma unroll
    for (int r = 0; r < 16; ++r) p0[r] = __builtin_amdgcn_exp2f(p0[r]);
}
__device__ __forceinline__ void finishSM(f32x16& p0, f32x16& p1, float alpha, float& l_reg, bf16x8& pa0, bf16x8& pa1, bf16x8& pa2, bf16x8& pa3) {
#pragma unroll
    for (int r = 0; r < 16; ++r) p1[r] = __builtin_amdgcn_exp2f(p1[r]);
    float ps = 0;
#pragma unroll
    for (int r = 0; r < 16; ++r) ps += p0[r];
#pragma unroll
    for (int r = 0; r < 16; ++r) ps += p1[r];
    { auto rr = __builtin_amdgcn_permlane32_swap(__float_as_uint(ps), __float_as_uint(ps), false, false);
      ps = __uint_as_float(rr[0]) + __uint_as_float(rr[1]); }
    l_reg = l_reg * alpha + ps;
#define PK4(P, BASE, OUT) do { unsigned a0 = cvt_pk_bf16(P[BASE + 0], P[BASE + 1]), a1 = cvt_pk_bf16(P[BASE + 2], P[BASE + 3]);   \
    unsigned b0 = cvt_pk_bf16(P[BASE + 4], P[BASE + 5]), b1 = cvt_pk_bf16(P[BASE + 6], P[BASE + 7]);                              \
    auto r0 = __builtin_amdgcn_permlane32_swap(a0, b0, false, false); auto r1 = __builtin_amdgcn_permlane32_swap(a1, b1, false, false); \
    u32x4 w = {r0[0], r1[0], r0[1], r1[1]}; OUT = *reinterpret_cast<bf16x8*>(&w); } while (0)
    PK4(p0, 0, pa0); PK4(p0, 8, pa1); PK4(p1, 0, pa2); PK4(p1, 8, pa3);
#undef PK4
}
__device__ __forceinline__ void qkt(f32x16& p0, f32x16& p1, const char* Ks, const bf16x8* qr, int r32, int hi) {
    p0 = f32x16{}; p1 = f32x16{};
#pragma unroll
    for (int d0 = 0; d0 < 12; ++d0) { const int cb = d0 * 32 + hi * 16;
        const bf16x8 b0 = *reinterpret_cast<const bf16x8*>(Ks + r32 * KPITCH + cb);
        const bf16x8 b1 = *reinterpret_cast<const bf16x8*>(Ks + (32 + r32) * KPITCH + cb);
        p0 = __builtin_amdgcn_mfma_f32_32x32x16_bf16(b0, qr[d0], p0, 0, 0, 0);
        p1 = __builtin_amdgcn_mfma_f32_32x32x16_bf16(b1, qr[d0], p1, 0, 0, 0); }
}
__device__ __forceinline__ int v_st(int k, int c) { const int kk = (k & ~0xC) | ((k & 4) << 1) | ((k & 8) >> 1); return ((kk >> 3) * 4 + (c >> 5)) * 512 + ((kk & 7) * 32 + (c & 31)) * 2; }
__device__ __forceinline__ int v_rd_base(int lane) { return ((lane & 3) << 3) | (((lane >> 2) & 3) << 6) | (((lane >> 4) & 1) << 5) | (((lane >> 5) & 1) << 8); }
constexpr int v_rd_off(int d0, int ks, int half) { return d0 * 512 + ks * 4096 + half * 2048; }
template <int OFF> __device__ __forceinline__ s16x4 tr_read(int vb) {
    s16x4 r; asm volatile("ds_read_b64_tr_b16 %0, %1 offset:%2" : "=&v"(r) : "v"(vb), "i"(OFF) : "memory"); return r;
}
template <int D0> __device__ __forceinline__ void pv_one(f32x16& od, int vb, bf16x8 pa0, bf16x8 pa1, bf16x8 pa2, bf16x8 pa3) {
    const s16x4 l0 = tr_read<v_rd_off(D0, 0, 0)>(vb), h0 = tr_read<v_rd_off(D0, 0, 1)>(vb), l1 = tr_read<v_rd_off(D0, 1, 0)>(vb), h1 = tr_read<v_rd_off(D0, 1, 1)>(vb);
    const s16x4 l2 = tr_read<v_rd_off(D0, 2, 0)>(vb), h2 = tr_read<v_rd_off(D0, 2, 1)>(vb), l3 = tr_read<v_rd_off(D0, 3, 0)>(vb), h3 = tr_read<v_rd_off(D0, 3, 1)>(vb);
    asm volatile("s_waitcnt lgkmcnt(0)" ::: "memory"); SBAR();
#define PK(L, H) (bf16x8){L[0], L[1], L[2], L[3], H[0], H[1], H[2], H[3]}
    od = __builtin_amdgcn_mfma_f32_32x32x16_bf16(pa0, PK(l0, h0), od, 0, 0, 0);
    od = __builtin_amdgcn_mfma_f32_32x32x16_bf16(pa1, PK(l1, h1), od, 0, 0, 0);
    od = __builtin_amdgcn_mfma_f32_32x32x16_bf16(pa2, PK(l2, h2), od, 0, 0, 0);
    od = __builtin_amdgcn_mfma_f32_32x32x16_bf16(pa3, PK(l3, h3), od, 0, 0, 0);
#undef PK
}
__device__ __forceinline__ void pv_d0(f32x16* o, int vb, bf16x8 pa0, bf16x8 pa1, bf16x8 pa2, bf16x8 pa3) {
    pv_one<0>(o[0], vb, pa0, pa1, pa2, pa3); pv_one<1>(o[1], vb, pa0, pa1, pa2, pa3); pv_one<2>(o[2], vb, pa0, pa1, pa2, pa3); pv_one<3>(o[3], vb, pa0, pa1, pa2, pa3);
}
__device__ __forceinline__ void attn_unit(const bf16_t* __restrict__ Qb, const bf16_t* __restrict__ Kh, const bf16_t* __restrict__ Vh, bf16_t* __restrict__ Ob, char* lds) {
    const int tid = threadIdx.x, wid = __builtin_amdgcn_readfirstlane(tid >> 6), lane = tid & 63, r32 = lane & 31, hi = lane >> 5;
    char* V_lds = lds; char* K_lds = lds + 2 * SHM_V;
    float* ws = (float*)(lds + 2 * SHM_V + 2 * SHM_K) + wid * 64; float* li_l = ws; float* al_l = ws + 32;
    float m_reg = -1e30f, l_reg = 0; f32x16 o[4] = {}; bf16x8 qr[12];
    const bf16_t* Qw = Qb + (size_t)(wid * QBLK + r32) * DQK + hi * 8;
#pragma unroll
    for (int d0 = 0; d0 < 12; ++d0) qr[d0] = *reinterpret_cast<const bf16x8*>(Qw + d0 * 16);
    const int sr = tid >> 4, sc = (tid & 15) * 8, vst0 = v_st(sr, sc);
    const int kd0 = tid * 16 + 16 * (tid / 24), kd1 = (tid + 512) * 16 + 16 * ((tid + 512) / 24), kd2 = (tid + 1024) * 16 + 16 * ((tid + 1024) / 24);
    const char* Kg = (const char*)Kh + tid * 16; const char* Vg = (const char*)Vh + tid * 16;
    const int vb0 = (int)(uintptr_t)V_lds + v_rd_base(lane);
    bf16x8 vs0, vs1, ks0, ks1, ks2;
#define SLOAD(k0) do { const char* vp = Vg + (size_t)(k0) * (DV * 2); const char* kp = Kg + (size_t)(k0) * (DQK * 2); \
    vs0 = *reinterpret_cast<const bf16x8*>(vp); vs1 = *reinterpret_cast<const bf16x8*>(vp + 8192); \
    ks0 = *reinterpret_cast<const bf16x8*>(kp); ks1 = *reinterpret_cast<const bf16x8*>(kp + 8192); ks2 = *reinterpret_cast<const bf16x8*>(kp + 16384); } while (0)
#define SWRITE(b) do { *(bf16x8*)(V_lds + (b) * SHM_V + vst0) = vs0; *(bf16x8*)(V_lds + (b) * SHM_V + vst0 + 8192) = vs1; \
    *(bf16x8*)(K_lds + (b) * SHM_K + kd0) = ks0; *(bf16x8*)(K_lds + (b) * SHM_K + kd1) = ks1; *(bf16x8*)(K_lds + (b) * SHM_K + kd2) = ks2; } while (0)
#define SWAIT() asm volatile("s_waitcnt vmcnt(0)" ::: "memory")
#define RESC(a) do { if (__any((a) < 1.f)) { if (hi == 0) al_l[r32] = (a); asm volatile("s_waitcnt lgkmcnt(0)" ::: "memory"); \
    _Pragma("unroll") for (int d = 0; d < 4; ++d) _Pragma("unroll") for (int r = 0; r < 16; ++r) o[d][r] *= al_l[crow(r, hi)]; } } while (0)
    f32x16 pA0, pA1, pB0, pB1; float mnA, mnB, alA, alB; bf16x8 pa0, pa1, pa2, pa3; constexpr int NT = SKV / KVBLK;
    SLOAD(0); SWAIT(); SWRITE(0); __syncthreads();
    qkt(pA0, pA1, K_lds, qr, r32, hi); partialSM(pA0, pA1, m_reg, mnA, alA);
    SLOAD(KVBLK);
    SWAIT(); SWRITE(1); __syncthreads();
    for (int j = 1; j + 1 < NT; j += 2) {
        SBAR(); qkt(pB0, pB1, K_lds + SHM_K, qr, r32, hi);
        finishSM(pA0, pA1, alA, l_reg, pa0, pa1, pa2, pa3); SBAR();
        SLOAD((j + 1) * KVBLK); SBAR();
        pv_d0(o, vb0, pa0, pa1, pa2, pa3); partialSM(pB0, pB1, m_reg, mnB, alB);
        __syncthreads(); SWAIT(); SWRITE(0);
        RESC(alB); __syncthreads();
        SBAR(); qkt(pA0, pA1, K_lds, qr, r32, hi);
        finishSM(pB0, pB1, alB, l_reg, pa0, pa1, pa2, pa3); SBAR();
        SLOAD((j + 2) * KVBLK); SBAR();
        pv_d0(o, vb0 + SHM_V, pa0, pa1, pa2, pa3); partialSM(pA0, pA1, m_reg, mnA, alA);
        __syncthreads(); SWAIT(); SWRITE(1);
        RESC(alA); __syncthreads();
    }
    SBAR(); qkt(pB0, pB1, K_lds + SHM_K, qr, r32, hi);
    finishSM(pA0, pA1, alA, l_reg, pa0, pa1, pa2, pa3); SBAR();
    pv_d0(o, vb0, pa0, pa1, pa2, pa3); partialSM(pB0, pB1, m_reg, mnB, alB);
    __syncthreads(); RESC(alB);
    finishSM(pB0, pB1, alB, l_reg, pa0, pa1, pa2, pa3); SBAR();
    pv_d0(o, vb0 + SHM_V, pa0, pa1, pa2, pa3);
    if (hi == 0) li_l[r32] = l_reg;
    asm volatile("s_waitcnt lgkmcnt(0)" ::: "memory");
    float rli[16];
#pragma unroll
    for (int r = 0; r < 16; ++r) rli[r] = __builtin_amdgcn_rcpf(li_l[crow(r, hi)]);
    bf16_t* Ow = Ob + (size_t)(wid * QBLK) * 1024;
#pragma unroll
    for (int r = 0; r < 16; ++r) { const int orow = crow(r, hi);
#pragma unroll
        for (int d0 = 0; d0 < 4; ++d0) Ow[(size_t)orow * 1024 + d0 * 32 + r32] = (bf16_t)(cvt_pk_bf16(o[d0][r] * rli[r], 0.f) & 0xffffu); }
#undef SLOAD
#undef SWRITE
#undef SWAIT
#undef RESC
}
}

namespace att2 {
using att::crow; using att::v_rd_base; using att::v_rd_off;
constexpr int DQK = 192, DV = 128, KVBLK = 64, QBLK = 32, NT = SKV / KVBLK;
constexpr float SCALE = 0.07216878364870322f, THR = 8.f, CL = SCALE * 1.4426950408889634f;
constexpr int KTB = KVBLK * DQK * 2, VTB = KVBLK * DV * 2, VRING = 4 * KTB, OFF_SCR = VRING + 3 * VTB;
#define SB2() __builtin_amdgcn_sched_barrier(0)
template <int I> __device__ __forceinline__ float pget(const f32x16& p0, const f32x16& p1) { if constexpr (I < 16) return p0[I]; else return p1[I - 16]; }
template <int I> __device__ __forceinline__ void pset(f32x16& p0, f32x16& p1, float v) { if constexpr (I < 16) p0[I] = v; else p1[I - 16] = v; }
template <int I> __device__ __forceinline__ void fexp(f32x16& p0, f32x16& p1) { pset<I>(p0, p1, __builtin_amdgcn_exp2f(pget<I>(p0, p1))); }
template <int I> __device__ __forceinline__ void fadd(const f32x16& p0, const f32x16& p1, float& psA, float& psB) { if constexpr (I < 16) psA += pget<I>(p0, p1); else psB += pget<I>(p0, p1); }
template <int B> __device__ __forceinline__ void fcvt(const f32x16& p0, const f32x16& p1, unsigned (&tw)[4]) {
    tw[0] = cvt_pk_bf16_n(pget<B>(p0, p1), pget<B + 1>(p0, p1)); tw[1] = cvt_pk_bf16_n(pget<B + 2>(p0, p1), pget<B + 3>(p0, p1));
    tw[2] = cvt_pk_bf16_n(pget<B + 4>(p0, p1), pget<B + 5>(p0, p1)); tw[3] = cvt_pk_bf16_n(pget<B + 6>(p0, p1), pget<B + 7>(p0, p1)); }
__device__ __forceinline__ bf16x8 fperm(const unsigned (&tw)[4]) {
    const auto r0 = __builtin_amdgcn_permlane32_swap(tw[0], tw[2], false, false); const auto r1 = __builtin_amdgcn_permlane32_swap(tw[1], tw[3], false, false);
    const u32x4 w = {r0[0], r1[0], r0[1], r1[1]}; return __builtin_bit_cast(bf16x8, w); }
template <int G> __device__ __forceinline__ void fin_gap(f32x16& p0, f32x16& p1, float& psA, float& psB, unsigned (&tw)[4], bf16x8 (&pa)[4], float& l_reg, float alO) {
    if constexpr (G == 0) { fexp<8>(p0, p1); fexp<9>(p0, p1); psA = pget<0>(p0, p1) + pget<1>(p0, p1); }
    if constexpr (G == 1) { fexp<10>(p0, p1); fexp<11>(p0, p1); fadd<2>(p0, p1, psA, psB); fadd<3>(p0, p1, psA, psB); }
    if constexpr (G == 2) { fexp<12>(p0, p1); fexp<13>(p0, p1); fadd<4>(p0, p1, psA, psB); fadd<5>(p0, p1, psA, psB); }
    if constexpr (G == 3) { fexp<14>(p0, p1); fexp<15>(p0, p1); fadd<6>(p0, p1, psA, psB); fadd<7>(p0, p1, psA, psB); }
    if constexpr (G == 4) { fcvt<0>(p0, p1, tw); fadd<8>(p0, p1, psA, psB); }
    if constexpr (G == 5) { pa[0] = fperm(tw); fexp<16>(p0, p1); fadd<9>(p0, p1, psA, psB); fadd<10>(p0, p1, psA, psB); }
    if constexpr (G == 6) { fexp<17>(p0, p1); fexp<18>(p0, p1); fadd<11>(p0, p1, psA, psB); fadd<12>(p0, p1, psA, psB); }
    if constexpr (G == 7) { fexp<19>(p0, p1); fexp<20>(p0, p1); fadd<13>(p0, p1, psA, psB); fadd<14>(p0, p1, psA, psB); }
    if constexpr (G == 8) { fcvt<8>(p0, p1, tw); fadd<15>(p0, p1, psA, psB); }
    if constexpr (G == 9) { pa[1] = fperm(tw); fexp<21>(p0, p1); psB = pget<16>(p0, p1) + pget<17>(p0, p1); }
    if constexpr (G == 10) { fexp<22>(p0, p1); fexp<23>(p0, p1); fadd<18>(p0, p1, psA, psB); fadd<19>(p0, p1, psA, psB); }
    if constexpr (G == 11) { fexp<24>(p0, p1); fexp<25>(p0, p1); fadd<20>(p0, p1, psA, psB); fadd<21>(p0, p1, psA, psB); }
    if constexpr (G == 12) { fcvt<16>(p0, p1, tw); fadd<22>(p0, p1, psA, psB); }
    if constexpr (G == 13) { pa[2] = fperm(tw); fexp<26>(p0, p1); fadd<23>(p0, p1, psA, psB); fadd<24>(p0, p1, psA, psB); }
    if constexpr (G == 14) { fexp<27>(p0, p1); fexp<28>(p0, p1); fadd<25>(p0, p1, psA, psB); fadd<26>(p0, p1, psA, psB); }
    if constexpr (G == 15) { fexp<29>(p0, p1); fexp<30>(p0, p1); fadd<27>(p0, p1, psA, psB); fadd<28>(p0, p1, psA, psB); }
    if constexpr (G == 16) { fexp<31>(p0, p1); fadd<29>(p0, p1, psA, psB); fadd<30>(p0, p1, psA, psB); }
    if constexpr (G == 17) { fadd<31>(p0, p1, psA, psB); fcvt<24>(p0, p1, tw); }
    if constexpr (G == 18) { pa[3] = fperm(tw); psA += psB; }
    if constexpr (G == 19) { const auto rr = __builtin_amdgcn_permlane32_swap(__float_as_uint(psA), __float_as_uint(psA), false, false);
                             l_reg = l_reg * alO + (__uint_as_float(rr[0]) + __uint_as_float(rr[1])); }
}
template <int G> __device__ __forceinline__ void par_gap(f32x16& n0, f32x16& n1, float& mA, float& mB, float& m_reg, float& alN, float& mnC) {
#define MX3(a, b, c) fmaxf(fmaxf(a, b), c)
#define NV(I) pget<I>(n0, n1)
    if constexpr (G == 0) { mA = MX3(NV(0), NV(1), NV(2)); mB = MX3(NV(16), NV(17), NV(18)); mA = MX3(mA, NV(3), NV(4)); mB = MX3(mB, NV(19), NV(20)); }
    if constexpr (G == 1) { mA = MX3(mA, NV(5), NV(6)); mB = MX3(mB, NV(21), NV(22)); mA = MX3(mA, NV(7), NV(8)); mB = MX3(mB, NV(23), NV(24)); }
    if constexpr (G == 2) { mA = MX3(mA, NV(9), NV(10)); mB = MX3(mB, NV(25), NV(26)); mA = MX3(mA, NV(11), NV(12)); mB = MX3(mB, NV(27), NV(28)); }
    if constexpr (G == 3) { mA = MX3(mA, NV(13), NV(14)); mB = MX3(mB, NV(29), NV(30)); mA = MX3(mA, NV(15), NV(31)); mA = fmaxf(mA, mB); }
    if constexpr (G == 4) { const auto rr = __builtin_amdgcn_permlane32_swap(__float_as_uint(mA), __float_as_uint(mA), false, false);
                            const float pmax = fmaxf(__uint_as_float(rr[0]), __uint_as_float(rr[1]));
                            const bool keep = __all(pmax - m_reg <= THR / SCALE); mB = keep ? m_reg : fmaxf(m_reg, pmax); }
    if constexpr (G == 5) { alN = __builtin_amdgcn_exp2f((m_reg - mB) * CL); m_reg = mB; mnC = -mB * CL; }
    if constexpr (G >= 6 && G <= 13) { constexpr int k = G - 6;
        pset<4 * k>(n0, n1, fmaf(NV(4 * k), CL, mnC)); pset<4 * k + 1>(n0, n1, fmaf(NV(4 * k + 1), CL, mnC));
        pset<4 * k + 2>(n0, n1, fmaf(NV(4 * k + 2), CL, mnC)); pset<4 * k + 3>(n0, n1, fmaf(NV(4 * k + 3), CL, mnC));
        fexp<k>(n0, n1); }
#undef MX3
#undef NV
}
template <int G> __device__ __forceinline__ bf16x8 kfrag(const LAS unsigned char* lds, const int (&kb)[4]) {
    constexpr int d0 = G >> 1, h = G & 1;
    return *(const LAS bf16x8*)(lds + kb[d0 & 3] + (d0 >> 2) * 128 + h * 12288);
}
template <int I> __device__ __forceinline__ bf16x8 vfrag(const LAS unsigned char* lds, int vb) {
    constexpr int d0 = I >> 2, ks = I & 3;
    const s16x4 l = __builtin_amdgcn_ds_read_tr16_b64_v4i16((LAS s16x4*)(lds + vb + v_rd_off(d0, ks, 0)));
    const s16x4 h = __builtin_amdgcn_ds_read_tr16_b64_v4i16((LAS s16x4*)(lds + vb + v_rd_off(d0, ks, 1)));
    return (bf16x8){l[0], l[1], l[2], l[3], h[0], h[1], h[2], h[3]};
}
struct VF { s16x4 l, h; };
template <int I> __device__ __forceinline__ void vfrag_asm(VF& f, int vaddr) {
    constexpr int d0 = I >> 2, ks = I & 3;
    asm volatile("ds_read_b64_tr_b16 %0, %1 offset:%2" : "=v"(f.l) : "v"(vaddr), "i"(v_rd_off(d0, ks, 0)) : "memory");
    asm volatile("ds_read_b64_tr_b16 %0, %1 offset:%2" : "=v"(f.h) : "v"(vaddr), "i"(v_rd_off(d0, ks, 1)) : "memory");
}
template <int N> __device__ __forceinline__ bf16x8 vwait(VF& f) { asm volatile("s_waitcnt lgkmcnt(%2)" : "+v"(f.l), "+v"(f.h) : "i"(N)); return (bf16x8){f.l[0], f.l[1], f.l[2], f.l[3], f.h[0], f.h[1], f.h[2], f.h[3]}; }
constexpr int seg2_maxissued(int i) { return i == 0 ? 1 : ((((i - 1) & ~1) == 0) ? 5 : ((((i - 1) & ~1) <= 10) ? ((i - 1) & ~1) + 5 : 15)); }
struct Dma { const char* Kg; const char* Vg; unsigned ko0, ko1, ko2, vo; int wid; };
__device__ __forceinline__ void dma_k(LAS unsigned char* lds, const Dma& d, int t, int so) {
    const unsigned kt = (unsigned)t * KTB;
    LAS unsigned char* kd = lds + so + d.wid * 3072;
    __builtin_amdgcn_global_load_lds((const unsigned*)(d.Kg + (d.ko0 + kt)), (LAS unsigned*)(kd), 16, 0, 0);
    __builtin_amdgcn_global_load_lds((const unsigned*)(d.Kg + (d.ko1 + kt)), (LAS unsigned*)(kd + 1024), 16, 0, 0);
    __builtin_amdgcn_global_load_lds((const unsigned*)(d.Kg + (d.ko2 + kt)), (LAS unsigned*)(kd + 2048), 16, 0, 0);
}
__device__ __forceinline__ void dma_v(LAS unsigned char* lds, const Dma& d, int t, int so) {
    const unsigned vt = (unsigned)t * VTB;
    LAS unsigned char* vd = lds + so + d.wid * 2048;
    __builtin_amdgcn_global_load_lds((const unsigned*)(d.Vg + (d.vo + vt)), (LAS unsigned*)(vd), 16, 0, 0);
    __builtin_amdgcn_global_load_lds((const unsigned*)(d.Vg + (d.vo + vt + 128u)), (LAS unsigned*)(vd + 1024), 16, 0, 0);
}
struct DmaIt { unsigned kt, vt; int soK, soV; };
template <int PIECE> __device__ __forceinline__ void dma_piece(LAS unsigned char* lds, const Dma& d, const DmaIt& it) {
    if constexpr (PIECE < 3) { LAS unsigned char* kd = lds + it.soK + d.wid * 3072 + PIECE * 1024; const unsigned ko = PIECE == 0 ? d.ko0 : PIECE == 1 ? d.ko1 : d.ko2;
        __builtin_amdgcn_global_load_lds((const unsigned*)(d.Kg + (ko + it.kt)), (LAS unsigned*)(kd), 16, 0, 0); }
    else { LAS unsigned char* vd = lds + it.soV + d.wid * 2048 + (PIECE - 3) * 1024;
        __builtin_amdgcn_global_load_lds((const unsigned*)(d.Vg + (d.vo + it.vt + (PIECE - 3) * 128u)), (LAS unsigned*)(vd), 16, 0, 0); }
}
#define PIN2(a, b) asm volatile("" : "+v"(a), "+v"(b))
template <int G, int DM> __device__ __forceinline__ void seg1_gaps(LAS unsigned char* lds, const Dma& dm, const DmaIt& dit, const int (&kb)[4], int vb, const bf16x8 (&qr)[12], f32x16& pN0, f32x16& pN1, f32x16& pO0, f32x16& pO1,
                                                           bf16x8& f0, bf16x8& f1, bf16x8& f2, bf16x8& f3, VF& v0, VF& v1, float& psA, float& psB, unsigned (&tw)[4], bf16x8 (&pa)[4], float& l_reg, float alO) {
    if constexpr (G < 24) {
        bf16x8& fc = (G & 3) == 0 ? f0 : (G & 3) == 1 ? f1 : (G & 3) == 2 ? f2 : f3;
        if constexpr ((G & 1) == 0) { if constexpr (G < 2) pN0 = __builtin_amdgcn_mfma_f32_32x32x16_bf16(fc, qr[G >> 1], f32x16{}, 0, 0, 0); else pN0 = __builtin_amdgcn_mfma_f32_32x32x16_bf16(fc, qr[G >> 1], pN0, 0, 0, 0); }
        else { if constexpr (G < 2) pN1 = __builtin_amdgcn_mfma_f32_32x32x16_bf16(fc, qr[G >> 1], f32x16{}, 0, 0, 0); else pN1 = __builtin_amdgcn_mfma_f32_32x32x16_bf16(fc, qr[G >> 1], pN1, 0, 0, 0); }
        if constexpr ((G & 1) == 0) {
            bf16x8& fa = ((G + 2) & 3) == 0 ? f0 : f2; bf16x8& fb = ((G + 2) & 3) == 0 ? f1 : f3;
            if constexpr (G + 3 < 24) { fa = kfrag<G + 2>(lds, kb); fb = kfrag<G + 3>(lds, kb); }
            else { vfrag_asm<0>(v0, vb); vfrag_asm<1>(v1, vb); }
        }
        if constexpr (G == 3 && (DM & 1)) dma_piece<0>(lds, dm, dit);
        if constexpr (G == 7 && (DM & 1)) dma_piece<1>(lds, dm, dit);
        if constexpr (G == 11 && (DM & 1)) dma_piece<2>(lds, dm, dit);
        if constexpr (G == 15 && (DM & 2)) dma_piece<3>(lds, dm, dit);
        if constexpr (G == 19 && (DM & 2)) dma_piece<4>(lds, dm, dit);
        fin_gap<G>(pO0, pO1, psA, psB, tw, pa, l_reg, alO);
        PIN2(pO0, pO1);
        SB2();
        seg1_gaps<G + 1, DM>(lds, dm, dit, kb, vb, qr, pN0, pN1, pO0, pO1, f0, f1, f2, f3, v0, v1, psA, psB, tw, pa, l_reg, alO);
    }
}
template <int I> __device__ __forceinline__ void seg2_gaps(int vb, f32x16 (&o)[4], const bf16x8 (&pa)[4], f32x16& pN0, f32x16& pN1,
                                                           VF& f0, VF& f1, VF& f2, VF& f3, VF& f4, VF& f5, float& mA, float& mB, float& m_reg, float& alN, float& mnC) {
    if constexpr (I < 16) {
        VF& fc = (I % 6) == 0 ? f0 : (I % 6) == 1 ? f1 : (I % 6) == 2 ? f2 : (I % 6) == 3 ? f3 : (I % 6) == 4 ? f4 : f5;
        const bf16x8 bv = vwait<2 * (seg2_maxissued(I) - I)>(fc);
        o[I >> 2] = __builtin_amdgcn_mfma_f32_32x32x16_bf16(pa[I & 3], bv, o[I >> 2], 0, 0, 0);
        if constexpr (I == 0) { vfrag_asm<2>(f2, vb); vfrag_asm<3>(f3, vb); vfrag_asm<4>(f4, vb); vfrag_asm<5>(f5, vb); }
        else if constexpr ((I & 1) == 0 && I + 5 < 16) {
            VF& fa = ((I + 4) % 6) == 0 ? f0 : ((I + 4) % 6) == 2 ? f2 : f4; VF& fb = ((I + 4) % 6) == 0 ? f1 : ((I + 4) % 6) == 2 ? f3 : f5;
            vfrag_asm<I + 4>(fa, vb); vfrag_asm<I + 5>(fb, vb);
        }
        par_gap<I>(pN0, pN1, mA, mB, m_reg, alN, mnC);
        PIN2(pN0, pN1);
        SB2();
        seg2_gaps<I + 1>(vb, o, pa, pN0, pN1, f0, f1, f2, f3, f4, f5, mA, mB, m_reg, alN, mnC);
    }
}
__device__ __forceinline__ void attn_unit(const bf16_t* __restrict__ Qb, const bf16_t* __restrict__ Kh, const bf16_t* __restrict__ Vh, bf16_t* __restrict__ Ob, LAS unsigned char* lds) {
    int tid_o = threadIdx.x; asm volatile("" : "+v"(tid_o));
    const int tid = tid_o, wid = __builtin_amdgcn_readfirstlane(tid >> 6), lane = tid & 63, r32 = lane & 31, hi = lane >> 5;
    LAS float* scr = (LAS float*)(lds + OFF_SCR) + wid * 64; LAS float* li_l = scr; LAS float* al_l = scr + 32;
    const int kbase = r32 * 384 + ((hi ^ ((r32 >> 1) & 7)) << 4);
    const int vbase = v_rd_base(lane);
    Dma dm; dm.Kg = (const char*)Kh; dm.Vg = (const char*)Vh; dm.wid = wid;
    { unsigned ko[3];
#pragma unroll
      for (int i = 0; i < 3; ++i) { const int L = (3 * wid + i) * 1024 + lane * 16, r = L / 384, cp = (L - r * 384) >> 4, c = (cp & ~7) | ((cp ^ (r >> 1)) & 7); ko[i] = (unsigned)(r * 384 + c * 16); }
      dm.ko0 = ko[0]; dm.ko1 = ko[1]; dm.ko2 = ko[2];
      const int L = (2 * wid) * 1024 + lane * 16, blk = L >> 9, wv = L & 511, kk = (blk >> 2) * 8 + (wv >> 6), c = (blk & 3) * 32 + ((wv & 63) >> 1);
      const int k = (kk & ~0xC) | ((kk & 4) << 1) | ((kk & 8) >> 1); dm.vo = (unsigned)(k * 256 + c * 2); }
    dma_k(lds, dm, 0, 0); dma_k(lds, dm, 1, KTB); dma_k(lds, dm, 2, 2 * KTB); dma_k(lds, dm, 3, 3 * KTB); dma_v(lds, dm, 0, VRING); dma_v(lds, dm, 1, VRING + VTB);
    float m_reg = -1e30f, l_reg = 0.f; f32x16 o[4] = {}; bf16x8 qr[12];
    { const bf16_t* Qw = Qb + (size_t)(wid * QBLK + r32) * DQK + hi * 8;
#pragma unroll
      for (int d0 = 0; d0 < 12; ++d0) qr[d0] = *reinterpret_cast<const bf16x8*>(Qw + d0 * 16); }
    asm volatile("s_waitcnt vmcnt(0)" ::: "memory"); __builtin_amdgcn_s_barrier(); SB2();
    f32x16 pA0, pA1, pB0, pB1; float alA = 1.f, alB = 1.f, mA, mB, mnC, psA, psB; unsigned tw[4]; bf16x8 pa[4], f0, f1, f2, f3; VF vf0, vf1, vf2, vf3, vf4, vf5;
    int kb[4];
#define KB_SET(so) do { kb[0] = kbase + (so); asm volatile("" : "+v"(kb[0])); kb[1] = kb[0] ^ 32; kb[2] = kb[0] ^ 64; kb[3] = kb[0] ^ 96; } while (0)
    KB_SET(0);
    pA0 = f32x16{}; pA1 = f32x16{};
#pragma unroll
    for (int d0 = 0; d0 < 12; ++d0) { const bf16x8 b0 = *(const LAS bf16x8*)(lds + kb[d0 & 3] + (d0 >> 2) * 128), b1 = *(const LAS bf16x8*)(lds + kb[d0 & 3] + (d0 >> 2) * 128 + 12288);
        pA0 = __builtin_amdgcn_mfma_f32_32x32x16_bf16(b0, qr[d0], pA0, 0, 0, 0); pA1 = __builtin_amdgcn_mfma_f32_32x32x16_bf16(b1, qr[d0], pA1, 0, 0, 0); }
    par_gap<0>(pA0, pA1, mA, mB, m_reg, alA, mnC); par_gap<1>(pA0, pA1, mA, mB, m_reg, alA, mnC); par_gap<2>(pA0, pA1, mA, mB, m_reg, alA, mnC); par_gap<3>(pA0, pA1, mA, mB, m_reg, alA, mnC);
    par_gap<4>(pA0, pA1, mA, mB, m_reg, alA, mnC); par_gap<5>(pA0, pA1, mA, mB, m_reg, alA, mnC); par_gap<6>(pA0, pA1, mA, mB, m_reg, alA, mnC); par_gap<7>(pA0, pA1, mA, mB, m_reg, alA, mnC);
    par_gap<8>(pA0, pA1, mA, mB, m_reg, alA, mnC); par_gap<9>(pA0, pA1, mA, mB, m_reg, alA, mnC); par_gap<10>(pA0, pA1, mA, mB, m_reg, alA, mnC); par_gap<11>(pA0, pA1, mA, mB, m_reg, alA, mnC);
    par_gap<12>(pA0, pA1, mA, mB, m_reg, alA, mnC); par_gap<13>(pA0, pA1, mA, mB, m_reg, alA, mnC);
    alA = 1.f;
    __builtin_amdgcn_s_barrier(); SB2();
    int sV = VRING, sD = VRING + 2 * VTB, sVn = VRING + VTB;
    KB_SET(KTB); f0 = kfrag<0>(lds, kb); f1 = kfrag<1>(lds, kb);
#define RESC2(a) do { if (__any((a) < 1.f)) { if (hi == 0) al_l[r32] = (a); asm volatile("s_waitcnt lgkmcnt(0)" ::: "memory"); \
    _Pragma("unroll") for (int d = 0; d < 4; ++d) _Pragma("unroll") for (int r = 0; r < 16; ++r) o[d][r] *= al_l[crow(r, hi)]; } } while (0)
#define ITER2(pO0, pO1, alO, pN0, pN1, alN, t_, DO_DMA, VMW, PRE) do { \
        int vb_ = vbase + sV + (int)(unsigned long)lds; asm volatile("" : "+v"(vb_)); \
        const DmaIt dit_ = {(unsigned)((t_) + 4) * KTB, (unsigned)((t_) + 2) * VTB, ((t_) & 3) * KTB, sD}; \
        SB2(); \
        seg1_gaps<0, DO_DMA>(lds, dm, dit_, kb, vb_, qr, pN0, pN1, pO0, pO1, f0, f1, f2, f3, vf0, vf1, psA, psB, tw, pa, l_reg, alO); \
        seg2_gaps<0>(vb_, o, pa, pN0, pN1, vf0, vf1, vf2, vf3, vf4, vf5, mA, mB, m_reg, alN, mnC); \
        if (PRE) { KB_SET((((t_) + 2) & 3) * KTB); f0 = kfrag<0>(lds, kb); f1 = kfrag<1>(lds, kb); }        \
        RESC2(alN); \
        asm volatile("s_waitcnt vmcnt(" #VMW ")" ::: "memory"); __builtin_amdgcn_s_barrier(); SB2(); \
        { const int t3_ = sV; sV = sVn; sVn = sD; sD = t3_; } } while (0)
    for (int t = 0; t < NT - 4; t += 2) {
        ITER2(pA0, pA1, alA, pB0, pB1, alB, t, 3, 5, true);
        ITER2(pB0, pB1, alB, pA0, pA1, alA, t + 1, 3, 5, true);
    }
    ITER2(pA0, pA1, alA, pB0, pB1, alB, NT - 4, 2, 2, true);
    ITER2(pB0, pB1, alB, pA0, pA1, alA, NT - 3, 2, 2, true);
    ITER2(pA0, pA1, alA, pB0, pB1, alB, NT - 2, 0, 0, false);
    { int vb_ = vbase + sV; asm volatile("" : "+v"(vb_));
      fin_gap<0>(pB0, pB1, psA, psB, tw, pa, l_reg, alB); fin_gap<1>(pB0, pB1, psA, psB, tw, pa, l_reg, alB); fin_gap<2>(pB0, pB1, psA, psB, tw, pa, l_reg, alB); fin_gap<3>(pB0, pB1, psA, psB, tw, pa, l_reg, alB);
      fin_gap<4>(pB0, pB1, psA, psB, tw, pa, l_reg, alB); fin_gap<5>(pB0, pB1, psA, psB, tw, pa, l_reg, alB); fin_gap<6>(pB0, pB1, psA, psB, tw, pa, l_reg, alB); fin_gap<7>(pB0, pB1, psA, psB, tw, pa, l_reg, alB);
      fin_gap<8>(pB0, pB1, psA, psB, tw, pa, l_reg, alB); fin_gap<9>(pB0, pB1, psA, psB, tw, pa, l_reg, alB); fin_gap<10>(pB0, pB1, psA, psB, tw, pa, l_reg, alB); fin_gap<11>(pB0, pB1, psA, psB, tw, pa, l_reg, alB);
      fin_gap<12>(pB0, pB1, psA, psB, tw, pa, l_reg, alB); fin_gap<13>(pB0, pB1, psA, psB, tw, pa, l_reg, alB); fin_gap<14>(pB0, pB1, psA, psB, tw, pa, l_reg, alB); fin_gap<15>(pB0, pB1, psA, psB, tw, pa, l_reg, alB);
      fin_gap<16>(pB0, pB1, psA, psB, tw, pa, l_reg, alB); fin_gap<17>(pB0, pB1, psA, psB, tw, pa, l_reg, alB); fin_gap<18>(pB0, pB1, psA, psB, tw, pa, l_reg, alB); fin_gap<19>(pB0, pB1, psA, psB, tw, pa, l_reg, alB);
#pragma unroll
      for (int d0 = 0; d0 < 4; ++d0) {
          const bf16x8 v0 = d0 == 0 ? vfrag<0>(lds, vb_) : d0 == 1 ? vfrag<4>(lds, vb_) : d0 == 2 ? vfrag<8>(lds, vb_) : vfrag<12>(lds, vb_);
          const bf16x8 v1 = d0 == 0 ? vfrag<1>(lds, vb_) : d0 == 1 ? vfrag<5>(lds, vb_) : d0 == 2 ? vfrag<9>(lds, vb_) : vfrag<13>(lds, vb_);
          const bf16x8 v2 = d0 == 0 ? vfrag<2>(lds, vb_) : d0 == 1 ? vfrag<6>(lds, vb_) : d0 == 2 ? vfrag<10>(lds, vb_) : vfrag<14>(lds, vb_);
          const bf16x8 v3 = d0 == 0 ? vfrag<3>(lds, vb_) : d0 == 1 ? vfrag<7>(lds, vb_) : d0 == 2 ? vfrag<11>(lds, vb_) : vfrag<15>(lds, vb_);
          o[d0] = __builtin_amdgcn_mfma_f32_32x32x16_bf16(pa[0], v0, o[d0], 0, 0, 0); o[d0] = __builtin_amdgcn_mfma_f32_32x32x16_bf16(pa[1], v1, o[d0], 0, 0, 0);
          o[d0] = __builtin_amdgcn_mfma_f32_32x32x16_bf16(pa[2], v2, o[d0], 0, 0, 0); o[d0] = __builtin_amdgcn_mfma_f32_32x32x16_bf16(pa[3], v3, o[d0], 0, 0, 0); } }
    if (hi == 0) li_l[r32] = l_reg;
    asm volatile("s_waitcnt lgkmcnt(0)" ::: "memory");
    float rli[16];
#pragma unroll
    for (int r = 0; r < 16; ++r) rli[r] = __builtin_amdgcn_rcpf(li_l[crow(r, hi)]);
    { LAS unsigned char* ost = lds + wid * 8192;
#pragma unroll
      for (int r = 0; r < 16; ++r) { const int orow = crow(r, hi);
#pragma unroll
          for (int d0 = 0; d0 < 4; ++d0) *(LAS unsigned short*)(ost + orow * 256 + (d0 * 32 + r32) * 2) = (unsigned short)(cvt_pk_bf16_n(o[d0][r] * rli[r], 0.f) & 0xffffu); }
      asm volatile("s_waitcnt lgkmcnt(0)" ::: "memory");
      bf16_t* Ow = Ob + (size_t)(wid * QBLK) * 1024;
#pragma unroll
      for (int j = 0; j < 8; ++j) { const int row = j * 4 + (lane >> 4); const u32x4 vv = *(const LAS u32x4*)(ost + row * 256 + (lane & 15) * 16);
          *(u32x4*)(Ow + (size_t)row * 1024 + (lane & 15) * 8) = vv; } }
#undef KB_SET
#undef RESC2
#undef ITER2
}
#undef SB2
}

__device__ __forceinline__ void transpose_item(const float* W, int ldw, int k0, int n0, bf16_t* dst, int ldd, const float* kscale, LAS float* scr, int lane) {
    float tv[32];
#pragma unroll
    for (int i = 0; i < 32; ++i) { const int kk = 2 * i + (lane >> 5); tv[i] = __builtin_nontemporal_load(W + (size_t)(k0 + kk) * ldw + n0 + (lane & 31)); }
#pragma unroll
    for (int i = 0; i < 32; ++i) { const int kk = 2 * i + (lane >> 5); float v = tv[i]; if (kscale) v *= kscale[k0 + kk]; scr[kk * 33 + (lane & 31)] = v; }
    LDS_WAIT(); asm volatile("" ::: "memory");
    const int c = lane & 7;
#pragma unroll
    for (int j = 0; j < 4; ++j) { const int n = (lane >> 3) + 8 * j; const LAS float* s = scr + (8 * c) * 33 + n;
        u32x4 o; o.x = cvt_pk_bf16(s[0 * 33], s[1 * 33]); o.y = cvt_pk_bf16(s[2 * 33], s[3 * 33]); o.z = cvt_pk_bf16(s[4 * 33], s[5 * 33]); o.w = cvt_pk_bf16(s[6 * 33], s[7 * 33]);
        *(u32x4*)(dst + (size_t)n * ldd + 8 * c) = o; }
    LDS_WAIT(); asm volatile("" ::: "memory");
}

__device__ __forceinline__ void ph_mod_and_weights(KP p, LAS unsigned char* lds) {
    const int tid = threadIdx.x, lane = tid & 63, wave = tid >> 6;
    unsigned char* ws = p.ws;
    float* mod = (float*)(ws + WS_MOD);
    {
        LAS float* sc = (LAS float*)lds;
        LAS float* red = (LAS float*)(lds + 20480);
        if ((int)blockIdx.x < 192) {
            for (int i = tid; i < 5 * 1024; i += NTHREADS) { const int j = i >> 10, k = i & 1023; const float v = j < 4 ? p.in[I_C][j * 1024 + k] : p.in[I_CCTX][k]; sc[i] = v * sigmoidf_(v); }
            __syncthreads();
            for (int unit = blockIdx.x; unit < 192; unit += gridDim.x) {
                const int c32 = tid & 31, kg = tid >> 5, col = unit * 32 + c32;
                float a0 = 0, a1 = 0, a2 = 0, a3 = 0, a4 = 0;
                const float* wp = p.in[I_WADA] + (size_t)(kg * 64) * 6144 + col;
#pragma unroll 8
                for (int kk = 0; kk < 64; ++kk) { const float w = wp[(size_t)kk * 6144]; const int k = kg * 64 + kk;
                    a0 += sc[k] * w; a1 += sc[1024 + k] * w; a2 += sc[2048 + k] * w; a3 += sc[3072 + k] * w; a4 += sc[4096 + k] * w; }
                LAS float* rp = red + (kg * 32 + c32) * 5; rp[0] = a0; rp[1] = a1; rp[2] = a2; rp[3] = a3; rp[4] = a4;
                __syncthreads();
                if (tid < 160) { const int cc = tid & 31, j = tid >> 5; float s = p.in[I_BADA][unit * 32 + cc];
                    for (int g = 0; g < 16; ++g) s += red[(g * 32 + cc) * 5 + j];
                    mod[j * 6144 + unit * 32 + cc] = s; }
                __syncthreads();
            }
        }
    }
    __syncthreads();
    {
        LAS float* scr = (LAS float*)(lds + wave * 8448);
        const int gw = blockIdx.x * NWAVES + wave, NGW = gridDim.x * NWAVES;
        bf16_t* WIN = (bf16_t*)(ws + WS_WIN); bf16_t* WLO = (bf16_t*)(ws + WS_WLORA); bf16_t* WUQ = (bf16_t*)(ws + WS_WUQ); bf16_t* WUKV = (bf16_t*)(ws + WS_WUKV); bf16_t* WOUT = (bf16_t*)(ws + WS_WOUT);
        constexpr int I_IN = 16 * 78, I_L = 16, I_G = 32, I_Q = 4 * 24, I_KV = 4 * 16, I_O = 16 * 32;
        constexpr int NITEMS = I_IN + 4 * I_L + I_G + I_Q + 2 * I_KV + I_O;
        for (int it = gw; it < NITEMS; it += NGW) {
            int r = it;
            if (r < I_IN) { const int kb = r / 78, nb = r % 78; transpose_item(p.in[I_WIN], IN_PROJ, kb * 64, nb * 32, WIN + (size_t)(nb * 32) * 1024 + kb * 64, 1024, nullptr, scr, lane); continue; } r -= I_IN;
            if (r < 2 * I_L) { const int d = r / 16, nb = r % 16; transpose_item(p.in[I_WUP] + (size_t)d * 64 * 512, 512, 0, nb * 32, WLO + (size_t)(d * 512 + nb * 32) * 128 + d * 64, 128, nullptr, scr, lane); continue; } r -= 2 * I_L;
            if (r < 2 * I_L) { const int d = r / 16, nb = r % 16; transpose_item(p.in[I_AUP] + (size_t)d * 64 * 512, 512, 0, nb * 32, WLO + (size_t)(1024 + d * 512 + nb * 32) * 128 + d * 64, 128, nullptr, scr, lane); continue; } r -= 2 * I_L;
            if (r < I_G) { const int kb = r / 16, nb = r % 16; transpose_item(p.in[I_GUP], 512, kb * 64, nb * 32, WLO + (size_t)(2048 + nb * 32) * 128 + kb * 64, 128, nullptr, scr, lane); continue; } r -= I_G;
            if (r < I_Q) { const int kb = r / 24, nb = r % 24; transpose_item(p.in[I_WUQ], 768, kb * 64, nb * 32, WUQ + (size_t)(nb * 32) * 256 + kb * 64, 256, p.in[I_QNORM], scr, lane); continue; } r -= I_Q;
            if (r < I_KV) { const int kb = r / 16, nb = r % 16; transpose_item(p.in[I_WUK], 512, kb * 64, nb * 32, WUKV + (size_t)(nb * 32) * 256 + kb * 64, 256, p.in[I_KVNORM], scr, lane); continue; } r -= I_KV;
            if (r < I_KV) { const int kb = r / 16, nb = r % 16; transpose_item(p.in[I_WUV], 512, kb * 64, nb * 32, WUKV + (size_t)(512 + nb * 32) * 256 + kb * 64, 256, p.in[I_KVNORM], scr, lane); continue; } r -= I_KV;
            { const int kb = r / 32, nb = r % 32; transpose_item(p.in[I_WOUT], 1024, kb * 64, nb * 32, WOUT + (size_t)(nb * 32) * 1024 + kb * 64, 1024, nullptr, scr, lane); }
        }
        const long gt = (long)blockIdx.x * NTHREADS + tid, gs = (long)gridDim.x * NTHREADS;
        const u32x4 z = {0u, 0u, 0u, 0u};
        for (long i = gt; i < 64 * 128; i += gs) *(u32x4*)(WIN + (size_t)IN_PROJ * 1024 + i * 8) = z;
        for (long i = gt; i < 2048 * 8; i += gs) { const int row = (int)(i >> 3), ch = (int)(i & 7), d = (row >> 9) & 1;
            *(u32x4*)(WLO + (size_t)row * 128 + (1 - d) * 64 + ch * 8) = z; }
    }
}

__device__ __forceinline__ void ph_modulate1(KP p) {
    const int tid = threadIdx.x, lane = tid & 63, wave = tid >> 6;
    const float* mod = (const float*)(p.ws + WS_MOD); bf16_t* XM = (bf16_t*)(p.ws + WS_XM);
    const int gw = blockIdx.x * NWAVES + wave, NGW = gridDim.x * NWAVES;
    ER(1) for (int row = gw; row < MA; row += NGW) {
        const float* xr; int j;
        if (row < ML) { xr = p.in[I_X] + (size_t)row * D; j = row >> 13; } else { xr = p.in[I_CTX] + (size_t)(row - ML) * D; j = 4; }
        const float* sh = mod + j * 6144, * sc = sh + 1024;
        f32x4 v[4]; float s = 0.f;
#pragma unroll
        for (int q = 0; q < 4; ++q) { v[q] = __builtin_nontemporal_load((const f32x4*)(xr + q * 256 + lane * 4)); s += (v[q].x + v[q].y) + (v[q].z + v[q].w); }
        const float mean = wave_sum(s) * (1.f / D); float s2 = 0.f;
#pragma unroll
        for (int q = 0; q < 4; ++q) { v[q] = v[q] - mean; s2 += (v[q].x * v[q].x + v[q].y * v[q].y) + (v[q].z * v[q].z + v[q].w * v[q].w); }
        const float rstd = 1.0f / sqrtf(wave_sum(s2) * (1.f / D) + LN_EPS);
#pragma unroll
        for (int q = 0; q < 4; ++q) { const int c = q * 256 + lane * 4; const f32x4 a = *(const f32x4*)(sc + c), bsh = *(const f32x4*)(sh + c);
            const f32x4 y = v[q] * rstd * (a + 1.0f) + bsh;
            u32x2 w; w.x = cvt_pk_bf16(y.x, y.y); w.y = cvt_pk_bf16(y.z, y.w); *(u32x2*)(XM + (size_t)row * D + c) = w; }
    }
}

__device__ __forceinline__ void ph_prepare(KP p) {
    const int tid = threadIdx.x, lane = tid & 63, wave = tid >> 6;
    unsigned char* ws = p.ws;
    const bf16_t* H = (const bf16_t*)(ws + WS_H); _Float16* RKV = (_Float16*)(ws + WS_RKV); bf16_t* ACT = (bf16_t*)(ws + WS_ACT);
    float* rq = (float*)(ws + WS_RSTDQ); float* rkv = (float*)(ws + WS_RSTDKV); bf16_t* Kb = (bf16_t*)(ws + WS_K);
    const float* cw = p.in[I_CONV]; float* rnp = (float*)(ws + WS_RN);
    const int gw = blockIdx.x * NWAVES + wave, NGW = gridDim.x * NWAVES;
    constexpr int STRIP = 17, NSTRIP = (MA + STRIP - 1) / STRIP;
    const u32x4 z4 = {0u, 0u, 0u, 0u};
    ER(3) for (int strip = gw; strip < NSTRIP; strip += NGW) {
        const int r0 = strip * STRIP, r1 = (r0 + STRIP < MA) ? r0 + STRIP : MA;
        u32x4 prv[3], cur[3], nxt[3]; u32x4 lx = z4; u32x2 qa, qc; unsigned short k1 = 0, k2 = 0;
#define PREP_LOADROW(dst, row_) do { const bf16_t* hp_ = H + (size_t)(row_) * NHP; _Pragma("unroll") for (int q = 0; q < 3; ++q) dst[q] = __builtin_nontemporal_load((const u32x4*)(hp_ + q * 512 + lane * 8)); } while (0)
#define PREP_LOADAUX(row_) do { const bf16_t* hp_ = H + (size_t)(row_) * NHP; if (lane < 48) lx = *(const u32x4*)(hp_ + 1536 + lane * 8); qa = *(const u32x2*)(hp_ + 1920 + lane * 4); qc = *(const u32x2*)(hp_ + 2176 + lane * 4); \
        if (lane < 32) { const int g_ = (lane >> 4) & 1, jj_ = lane & 15; k1 = hp_[2432 + g_ * 32 + jj_]; k2 = hp_[2432 + g_ * 32 + 16 + jj_]; } } while (0)
        PREP_LOADROW(cur, r0); PREP_LOADAUX(r0);
        if (r0 > 0) PREP_LOADROW(prv, r0 - 1); else { prv[0] = z4; prv[1] = z4; prv[2] = z4; }
        if (r0 + 1 < MA) PREP_LOADROW(nxt, r0 + 1); else { nxt[0] = z4; nxt[1] = z4; nxt[2] = z4; }
        for (int row = r0; row < r1; ++row) {
            int b, t, len, key;
            if (row < ML) { b = row >> 13; t = row & (T - 1); len = T; key = CTX + t; } else { const int rc = row - ML; b = rc >> 8; t = rc & (CTX - 1); len = CTX; key = t; }
            const u32x4 lxc = lx; const u32x2 qac = qa, qcc = qc; const unsigned short k1c = k1, k2c = k2;
            u32x4 nn[3]; nn[0] = z4; nn[1] = z4; nn[2] = z4;
            if (row + 2 < MA && row + 1 < r1) PREP_LOADROW(nn, row + 2);
            if (row + 1 < r1) PREP_LOADAUX(row + 1);
            const bool hasp = t > 0, hasn = t < len - 1;
#pragma unroll
            for (int q = 0; q < 3; ++q) { const int c = q * 512 + lane * 8;
                const u32x4 pv = hasp ? prv[q] : z4, nv = hasn ? nxt[q] : z4, cv = cur[q];
                h16x8 o;
#pragma unroll
                for (int i = 0; i < 4; ++i) { const int ch = c + 2 * i;
                    const float lo = cw[ch] * bflo(pv[i]) + cw[1536 + ch] * bflo(cv[i]) + cw[3072 + ch] * bflo(nv[i]);
                    const float hi = cw[ch + 1] * bfhi(pv[i]) + cw[1536 + ch + 1] * bfhi(cv[i]) + cw[3072 + ch + 1] * bfhi(nv[i]);
                    o[2 * i] = (_Float16)lo; o[2 * i + 1] = (_Float16)hi; }
                *(h16x8*)(RKV + (size_t)row * 1536 + c) = o;
                if (q == 1) {
                    float ss = 0.f;
#pragma unroll
                    for (int i = 0; i < 8; ++i) { const float kr = (float)o[i] * p.in[I_KK][lane * 8 + i]; ss += kr * kr; }
                    ss += __shfl_xor(ss, 1); ss += __shfl_xor(ss, 2); ss += __shfl_xor(ss, 4);
                    if ((lane & 7) == 0) rnp[(size_t)row * 8 + (lane >> 3)] = 1.0f / sqrtf(ss + 1e-12f); } }
            if (lane < 48) { u32x4 o;
#pragma unroll
                for (int i = 0; i < 4; ++i) { float lo = bflo(lxc[i]), hi = bfhi(lxc[i]);
                    if (lane < 16) { const float el = __builtin_amdgcn_exp2f(-2.885390081777927f * lo), eh = __builtin_amdgcn_exp2f(-2.885390081777927f * hi);
                        lo = 2.0f * __builtin_amdgcn_rcpf(1.0f + el) - 1.0f; hi = 2.0f * __builtin_amdgcn_rcpf(1.0f + eh) - 1.0f; }
                    else if (lane >= 32) { lo = sigmoidf_(lo); hi = sigmoidf_(hi); }
                    o[i] = cvt_pk_bf16(lo, hi); }
                *(u32x4*)(ACT + (size_t)row * 384 + lane * 8) = o; }
            { float sa = bflo(qac.x) * bflo(qac.x) + bfhi(qac.x) * bfhi(qac.x) + bflo(qac.y) * bflo(qac.y) + bfhi(qac.y) * bfhi(qac.y);
              float sb = bflo(qcc.x) * bflo(qcc.x) + bfhi(qcc.x) * bfhi(qcc.x) + bflo(qcc.y) * bflo(qcc.y) + bfhi(qcc.y) * bfhi(qcc.y);
              sa = wave_sum(sa); sb = wave_sum(sb);
              if (lane == 0) { rq[row] = 1.0f / sqrtf(sa * (1.f / 256.f) + RMS_EPS); rkv[row] = 1.0f / sqrtf(sb * (1.f / 256.f) + RMS_EPS); } }
            if (lane < 32) { float o1, o2; const int g = (lane >> 4) & 1, jj = lane & 15; const float x1 = bf2f(k1c), x2 = bf2f(k2c);
                if (row < ML) { const float pos = (float)(g == 0 ? (t >> 6) : (t & 63)); float rev = pos * rope_invfreq(jj); rev = rev - floorf(rev);
                    const float sn = __builtin_amdgcn_sinf(rev), cs = __builtin_amdgcn_cosf(rev); o1 = x1 * cs - x2 * sn; o2 = x2 * cs + x1 * sn; }
                else { o1 = x1; o2 = x2; }
                const bf16_t w1 = (bf16_t)(cvt_pk_bf16(o1, 0.f) & 0xffffu), w2 = (bf16_t)(cvt_pk_bf16(o2, 0.f) & 0xffffu);
#pragma unroll
                for (int hh = 0; hh < 4; ++hh) { bf16_t* kp = Kb + ((size_t)(b * 4 + hh) * SKV + key) * 192 + 128 + g * 32 + jj; kp[0] = w1; kp[16] = w2; } }
#pragma unroll
            for (int q = 0; q < 3; ++q) { prv[q] = cur[q]; cur[q] = nxt[q]; nxt[q] = nn[q]; }
        }
#undef PREP_LOADROW
#undef PREP_LOADAUX
    }
}

constexpr int SC_CH = 32, SC_TOKF = 344;
__device__ __forceinline__ int scan_row_of(int b, int dir, int n) {
    if (n < CTX) { const int tc = dir ? (CTX - 1 - n) : n; return ML + b * CTX + tc; }
    const int tl = dir ? (T - 1 - (n - CTX)) : (n - CTX); return b * T + tl;
}
__device__ __forceinline__ void ph_scan(KP p, LAS unsigned char* lds) {
    const int tid = threadIdx.x, lane = tid & 63, wave = tid >> 6;
    unsigned char* ws = p.ws;
    const _Float16* RKV = (const _Float16*)(ws + WS_RKV); const _Float16* E16 = (const _Float16*)(ws + WS_E16); const _Float16* A16 = (const _Float16*)(ws + WS_A16);
    _Float16* YS = (_Float16*)((unsigned char*)p.out + DO_YS);
    const float* kkp = p.in[I_KK]; const float* kap = p.in[I_KA];
    LAS float* buf = (LAS float*)lds;
    constexpr int NCHUNK = SKV / SC_CH;
    for (int unit = blockIdx.x; unit < 256; unit += gridDim.x) {
        const int chain = unit >> 2, rb = (unit & 3) * 16;
        const int dir = chain & 1, hh = (chain >> 1) & 3  ;
        const int b = chain >> 4, head = (chain >> 1) & 7;
        (void)hh;
#define SC_PREP(ck) do { const int pt = tid - 256; const int tt = pt >> 3, part = pt & 7;                                                        \
        const int row = scan_row_of(b, dir, (ck) * SC_CH + tt); const int ch0 = head * 64 + part * 8;                                            \
        const h16x8 r8 = *(const h16x8*)(RKV + (size_t)row * 1536 + ch0), k8 = *(const h16x8*)(RKV + (size_t)row * 1536 + 512 + ch0);          \
        const h16x8 a8 = *(const h16x8*)(A16 + ((size_t)dir * MA + row) * 512 + ch0), e8 = *(const h16x8*)(E16 + ((size_t)dir * MA + row) * 512 + ch0); \
        float kf[8], kkr[8]; float ss = 0.f;                                                                                                     \
        _Pragma("unroll") for (int i = 0; i < 8; ++i) { kf[i] = (float)k8[i]; kkr[i] = kf[i] * kkp[ch0 + i]; ss += kkr[i] * kkr[i]; }           \
        ss += __shfl_xor(ss, 1); ss += __shfl_xor(ss, 2); ss += __shfl_xor(ss, 4);                                                               \
        const float rn = 1.0f / sqrtf(ss + 1e-12f);                                                                                              \
        LAS float* rec = buf + ((ck) & 1) * (SC_CH * SC_TOKF) + tt * SC_TOKF; float c1 = 0.f, c2 = 0.f;                                         \
        _Pragma("unroll") for (int i = 0; i < 8; ++i) { const float a = (float)a8[i], r = (float)r8[i]; const float kk = kkr[i] * rn;           \
            const float w = __builtin_amdgcn_exp2f(-1.4426950408889634f * (float)e8[i]); const float ka = kk * a;                                \
            const float kd = kf[i] * (1.0f + (a - 1.0f) * kap[ch0 + i]);                                                                         \
            rec[part * 8 + i] = kk; rec[64 + part * 8 + i] = w * r; rec[128 + part * 8 + i] = w; rec[192 + part * 8 + i] = kd; rec[256 + part * 8 + i] = ka; \
            c1 += ka * r; c2 += kd * r; }                                                                                                        \
        c1 += __shfl_xor(c1, 1); c1 += __shfl_xor(c1, 2); c1 += __shfl_xor(c1, 4); c2 += __shfl_xor(c2, 1); c2 += __shfl_xor(c2, 2); c2 += __shfl_xor(c2, 4); \
        if (part == 0) { rec[336] = c1; rec[337] = c2; }                                                                                         \
        if (part < 2) { const h16x8 v8 = *(const h16x8*)(RKV + (size_t)row * 1536 + 1024 + head * 64 + rb + part * 8);                           \
            _Pragma("unroll") for (int i = 0; i < 8; ++i) rec[320 + part * 8 + i] = (float)v8[i]; } } while (0)
        if (wave >= 4) SC_PREP(0);
        __syncthreads();
        f32x2 S01 = {0.f, 0.f}, S23 = {0.f, 0.f};
        const int ri = (wave & 3) * 4 + (lane >> 4), q = lane & 15;
        for (int ck = 0; ck < NCHUNK; ++ck) {
            if (wave >= 4) { if (ck + 1 < NCHUNK) SC_PREP(ck + 1); }
            else {
                const LAS float* cb = buf + (ck & 1) * (SC_CH * SC_TOKF);
                float yk0 = 0.f, yk1 = 0.f;
#pragma unroll 4
                for (int tt = 0; tt < SC_CH; ++tt) {
                    const LAS float* rec = cb + tt * SC_TOKF;
                    const f32x4 kk4 = *(const LAS f32x4*)(rec + q * 4), wr4 = *(const LAS f32x4*)(rec + 64 + q * 4), w4 = *(const LAS f32x4*)(rec + 128 + q * 4);
                    const f32x4 kd4 = *(const LAS f32x4*)(rec + 192 + q * 4), ka4 = *(const LAS f32x4*)(rec + 256 + q * 4);
                    const float v = rec[320 + ri]; const f32x2 cc = *(const LAS f32x2*)(rec + 336);
                    f32x2 d1 = S01 * (f32x2){kk4.x, kk4.y}; d1 = S23 * (f32x2){kk4.z, kk4.w} + d1;
                    f32x2 d2 = S01 * (f32x2){wr4.x, wr4.y}; d2 = S23 * (f32x2){wr4.z, wr4.w} + d2;
                    const float sk = allred16(d1.x + d1.y), qv = allred16(d2.x + d2.y);
                    const float y = qv - sk * cc.x + v * cc.y;
                    const f32x2 vv = {v, v}, ns = {-sk, -sk};
                    S01 = S01 * (f32x2){w4.x, w4.y}; S01 = vv * (f32x2){kd4.x, kd4.y} + S01; S01 = ns * (f32x2){ka4.x, ka4.y} + S01;
                    S23 = S23 * (f32x2){w4.z, w4.w}; S23 = vv * (f32x2){kd4.z, kd4.w} + S23; S23 = ns * (f32x2){ka4.z, ka4.w} + S23;
                    if ((tt & 15) == q) { if (tt < 16) yk0 = y; else yk1 = y; }
                }
                if (ck >= CTX / SC_CH) {
                    const int r0 = scan_row_of(b, dir, ck * SC_CH + q), r1 = scan_row_of(b, dir, ck * SC_CH + 16 + q);
                    YS[((size_t)dir * ML + r0) * 512 + head * 64 + rb + ri] = (_Float16)yk0;
                    YS[((size_t)dir * ML + r1) * 512 + head * 64 + rb + ri] = (_Float16)yk1;
                }
            }
            __syncthreads();
        }
#undef SC_PREP
    }
}


#ifndef SC2_DUP
#define SC2_DUP 0
#endif
namespace sc2 {
constexpr int PITCH = 128, SLOT = 64 * PITCH;
constexpr int CPS = 33, CH = 64;
enum { SL_S = 0, SL_MT = 1, SL_AH = 2, SL_BH = 3, SL_KH = 4, SL_RH = 5, SL_AHT = 6, SL_BBT = 7, SL_VT = 8, SL_KBT = 9, SL_AAB = 10, SL_AAKT = 11, SL_ARB = 12, SL_ARK = 13, SL_P2T = 14,
       SL_TT = 2, SL_ET = 3, SL_T = 4, SL_Q1 = 2, SL_Q2 = 3, SL_ML = 4, SL_ZX = 6, SL_P1T = 10, SL_TB = 15, SL_TTB = 16 };
constexpr int GC_OFF = 17 * SLOT;
__device__ __forceinline__ int swz(int row, int byte) { return row * PITCH + ((((byte >> 4) ^ (row >> 1)) & 7) << 4) + (byte & 15); }
struct Fr { bf16x8 k0, k1; };
__device__ __forceinline__ Fr ldf(const LAS char* M, int tile, int lane) { const int row = 16 * tile + (lane & 15), cq = lane >> 4, sw = (row >> 1) & 7; Fr f;
    f.k0 = *(const LAS bf16x8*)(M + row * PITCH + ((cq ^ sw) << 4)); f.k1 = *(const LAS bf16x8*)(M + row * PITCH + (((cq + 4) ^ sw) << 4)); return f; }
__device__ __forceinline__ f32x4 mm(const Fr& A, const Fr& B, f32x4 acc) {
    acc = __builtin_amdgcn_mfma_f32_16x16x32_bf16(A.k0, B.k0, acc, 0, 0, 0); acc = __builtin_amdgcn_mfma_f32_16x16x32_bf16(A.k1, B.k1, acc, 0, 0, 0); return acc; }
__device__ __forceinline__ void st4(LAS char* M, int row, int col, f32x4 v) { u32x2 w; w.x = cvt_pk_bf16_n(v[0], v[1]); w.y = cvt_pk_bf16_n(v[2], v[3]); *(LAS u32x2*)(M + swz(row, col * 2)) = w; }
__device__ __forceinline__ f32x4 ld4(const LAS char* M, int row, int col) { const u32x2 w = *(const LAS u32x2*)(M + swz(row, col * 2)); return (f32x4){bflo(w.x), bfhi(w.x), bflo(w.y), bfhi(w.y)}; }
__device__ __forceinline__ void st1(LAS char* M, int row, int col, float v) { *(LAS unsigned short*)(M + swz(row, col * 2)) = (unsigned short)(cvt_pk_bf16_n(v, 0.f) & 0xffffu); }
#define SC2_SLOT(i) ((LAS char*)lds + (i) * SLOT)
#define SC2_BAR() do { asm volatile("s_waitcnt lgkmcnt(0)" ::: "memory"); __syncthreads(); } while (0)
#define SC2_Z ((f32x4){0.f, 0.f, 0.f, 0.f})
#define SC2_SB() __builtin_amdgcn_sched_barrier(0)

__device__ __forceinline__ void pass_a(KP p, LAS unsigned char* lds) {
    int tid_o = threadIdx.x; asm volatile("" : "+v"(tid_o));
    const int tid = tid_o, lane = tid & 63, wave = __builtin_amdgcn_readfirstlane(tid >> 6), q4 = (lane >> 4) * 4, l15 = lane & 15;
    unsigned char* ws = p.ws;
    const _Float16* RKV = (const _Float16*)(ws + WS_RKV); const _Float16* E16 = (const _Float16*)(ws + WS_E16); const _Float16* A16 = (const _Float16*)(ws + WS_A16);
    _Float16* YS = (_Float16*)((unsigned char*)p.out + DO_YS);
    LAS float* gC = (LAS float*)((LAS char*)lds + GC_OFF); const float* RN = (const float*)(ws + WS_RN);
    const int tx = wave >> 1, ty0 = (wave & 1) * 2;
    const int x = 16 * tx + l15;
    for (int unit = blockIdx.x; unit < 256; unit += gridDim.x) {
        const int chain = unit >> 2, seg = unit & 3, dir = chain & 1, head = (chain >> 1) & 7, b = chain >> 4;
        bf16_t* QC = (bf16_t*)(ws + (dir ? WS_QC1 : WS_QC0)) + (size_t)(chain >> 1) * SKV * 64;
        float* SEG = (float*)(ws + WS_SEG) + (size_t)unit * 8192;
        h16x8 e8n, a8n, r8n, k8n, v8n; float rnn;
#define SC2_LOADRAW(ck_) do { const int row_ = scan_row_of(b, dir, (ck_) * CH + lane); const size_t eo_ = ((size_t)dir * MA + row_) * 512 + head * 64 + wave * 8; \
        e8n = *(const h16x8*)(E16 + eo_); a8n = *(const h16x8*)(A16 + eo_); const _Float16* rp_ = RKV + (size_t)row_ * 1536 + head * 64 + wave * 8; \
        r8n = *(const h16x8*)rp_; k8n = *(const h16x8*)(rp_ + 512); v8n = *(const h16x8*)(rp_ + 1024); rnn = RN[(size_t)row_ * 8 + head]; } while (0)
        unsigned zo_ = 0u; asm volatile("" : "+v"(zo_)); const u32x4 zz4 = {zo_, zo_, zo_, zo_};
        for (int i = tid; i < 2 * SLOT / 16; i += NTHREADS) *(LAS u32x4*)((LAS char*)lds + i * 16) = zz4;
        SC2_BAR();
        if (tid < 64) st1(SC2_SLOT(SL_MT), tid, tid, 1.0f);
        const int cb = wave & 3;
        f32x4 mst[4];
#pragma unroll
        for (int tk = 0; tk < 4; ++tk) { mst[tk] = SC2_Z;
            if (wave >= 4) {
#pragma unroll
                for (int e = 0; e < 4; ++e) mst[tk][e] = (16 * tk + q4 + e == 16 * cb + l15) ? 1.0f : 0.0f; } }
        SC2_BAR();
        for (int ck = seg * CPS; ck < (seg + 1) * CPS; ++ck) {
            {
                SC2_LOADRAW(ck);
                const h16x8 e8 = e8n, a8 = a8n, r8 = r8n, k8 = k8n, v8 = v8n; const float rn = rnn;
                u32x4 wah, wrh, wbh, wkh; unsigned pa = 0, pr = 0, pb = 0, pk = 0;
                const f32x4 kk0 = *(const f32x4*)(p.in[I_KK] + head * 64 + wave * 8), kk1 = *(const f32x4*)(p.in[I_KK] + head * 64 + wave * 8 + 4), ka0 = *(const f32x4*)(p.in[I_KA] + head * 64 + wave * 8), ka1 = *(const f32x4*)(p.in[I_KA] + head * 64 + wave * 8 + 4);
#pragma unroll
                for (int j = 0; j < 8; ++j) {
                    const float ev = (float)e8[j];
                    float L = ev; L += dppf<0x111>(L); L += dppf<0x112>(L); L += dppf<0x114>(L); L += dppf<0x118>(L);
                    const float r0 = __int_as_float(__builtin_amdgcn_readlane(__float_as_int(L), 15)), r1 = __int_as_float(__builtin_amdgcn_readlane(__float_as_int(L), 31)), r2 = __int_as_float(__builtin_amdgcn_readlane(__float_as_int(L), 47));
                    L += (lane >= 16 ? r0 : 0.f) + (lane >= 32 ? r1 : 0.f) + (lane >= 48 ? r2 : 0.f);
                    const float tot = __int_as_float(__builtin_amdgcn_readlane(__float_as_int(L), 63));
                    const float gam = __builtin_amdgcn_exp2f(-1.4426950408889634f * L), gprev = __builtin_amdgcn_exp2f(-1.4426950408889634f * (L - ev));
                    const float ginv = __builtin_amdgcn_exp2f(1.4426950408889634f * L), gbar = __builtin_amdgcn_exp2f(1.4426950408889634f * (L - tot));
                    const float kf = (float)k8[j], af = (float)a8[j], kkn = kf * (j < 4 ? kk0[j & 3] : kk1[j & 3]) * rn;
                    const float ka = kkn * af, kd = kf * (1.0f + (af - 1.0f) * (j < 4 ? ka0[j & 3] : ka1[j & 3]));
                    const float Ah = -kkn * gprev, Rh = (float)r8[j] * gam, Bh = ka * ginv, Kh = kd * ginv, Bb = ka * gbar, Kb = kd * gbar;
                    const int c = wave * 8 + j;
                    st1(SC2_SLOT(SL_AHT), c, lane, Ah); st1(SC2_SLOT(SL_BBT), c, lane, Bb); st1(SC2_SLOT(SL_VT), c, lane, (float)v8[j]); st1(SC2_SLOT(SL_KBT), c, lane, Kb);
                    if (lane == 0) gC[c] = __builtin_amdgcn_exp2f(-1.4426950408889634f * tot);
                    if (j & 1) { wah[j >> 1] = cvt_pk_bf16_n(__uint_as_float(pa), Ah); wrh[j >> 1] = cvt_pk_bf16_n(__uint_as_float(pr), Rh); wbh[j >> 1] = cvt_pk_bf16_n(__uint_as_float(pb), Bh); wkh[j >> 1] = cvt_pk_bf16_n(__uint_as_float(pk), Kh); SC2_SB(); }
                    else { pa = __float_as_uint(Ah); pr = __float_as_uint(Rh); pb = __float_as_uint(Bh); pk = __float_as_uint(Kh); } }
                const int ro = swz(lane, wave * 16);
                *(LAS u32x4*)(SC2_SLOT(SL_AH) + ro) = wah; *(LAS u32x4*)(SC2_SLOT(SL_RH) + ro) = wrh; *(LAS u32x4*)(SC2_SLOT(SL_BH) + ro) = wbh; *(LAS u32x4*)(SC2_SLOT(SL_KH) + ro) = wkh;
            }
            SC2_BAR();
            { const Fr fAHx = ldf(SC2_SLOT(SL_AH), tx, lane), fKHx = ldf(SC2_SLOT(SL_KH), tx, lane), fRHx = ldf(SC2_SLOT(SL_RH), tx, lane);
#pragma unroll
              for (int j = 0; j < 2; ++j) { const int y0 = 16 * (ty0 + j) + q4;
                const Fr fBHy = ldf(SC2_SLOT(SL_BH), ty0 + j, lane), fAHy = ldf(SC2_SLOT(SL_AH), ty0 + j, lane), fKHy = ldf(SC2_SLOT(SL_KH), ty0 + j, lane);
                SC2_SB();
                f32x4 aab = mm(fBHy, fAHx, SC2_Z), aak = mm(fAHy, fKHx, SC2_Z), arb = mm(fBHy, fRHx, SC2_Z), ark = mm(fKHy, fRHx, SC2_Z);
                SC2_SB();
#pragma unroll
                for (int e = 0; e < 4; ++e) { const int y = y0 + e; if (!(y < x)) aab[e] = 0.f; if (!(x < y)) aak[e] = 0.f; if (!(y <= x)) { arb[e] = 0.f; ark[e] = 0.f; } }
                st4(SC2_SLOT(SL_AAB), x, y0, aab); st4(SC2_SLOT(SL_AAKT), x, y0, aak); st4(SC2_SLOT(SL_ARB), x, y0, arb); st4(SC2_SLOT(SL_ARK), x, y0, ark); } }
            SC2_BAR();
            if (wave == 0) {
                const int blk = lane >> 4, c = lane & 15; float X[16];
                const LAS char* am = SC2_SLOT(SL_AAB);
                { u32x4 ar0[9];
#pragma unroll
                  for (int r = 1; r < 9; ++r) ar0[r] = *(const LAS u32x4*)(am + swz(16 * blk + r, 32 * blk));
#pragma unroll
                  for (int r = 0; r < 9; ++r) { float xv = (r == c) ? 1.0f : 0.0f;
#pragma unroll
                      for (int s2 = 0; s2 < 8; ++s2) { if (s2 < r) { const unsigned wv = ar0[r][s2 >> 1]; xv += ((s2 & 1) ? bfhi(wv) : bflo(wv)) * X[s2]; } }
                      X[r] = xv; st1(SC2_SLOT(SL_T), 16 * blk + r, 16 * blk + c, xv); } }
                asm volatile("" ::: "memory");
                { u32x4 ar0[7], ar1[7];
#pragma unroll
                  for (int r = 9; r < 16; ++r) { ar0[r - 9] = *(const LAS u32x4*)(am + swz(16 * blk + r, 32 * blk)); ar1[r - 9] = *(const LAS u32x4*)(am + swz(16 * blk + r, 32 * blk + 16)); }
#pragma unroll
                  for (int r = 9; r < 16; ++r) { float xv = (r == c) ? 1.0f : 0.0f;
#pragma unroll
                      for (int s2 = 0; s2 < 16; ++s2) { if (s2 < r) { const unsigned wv = s2 < 8 ? ar0[r - 9][s2 >> 1] : ar1[r - 9][(s2 - 8) >> 1]; xv += ((s2 & 1) ? bfhi(wv) : bflo(wv)) * X[s2]; } }
                      X[r] = xv; st1(SC2_SLOT(SL_T), 16 * blk + r, 16 * blk + c, xv); } }
                u32x4 o0, o1;
#pragma unroll
                for (int i = 0; i < 4; ++i) { o0[i] = cvt_pk_bf16_n(X[2 * i], X[2 * i + 1]); o1[i] = cvt_pk_bf16_n(X[8 + 2 * i], X[9 + 2 * i]); }
                *(LAS u32x4*)(SC2_SLOT(SL_TT) + swz(16 * blk + c, 32 * blk)) = o0; *(LAS u32x4*)(SC2_SLOT(SL_TT) + swz(16 * blk + c, 32 * blk + 16)) = o1;
            } else {
                for (int i = tid - 64; i < 768; i += NTHREADS - 64) { const int m = i / 384, rem = i % 384, b12 = rem >> 5, rr = (rem & 31) >> 1, hf = rem & 1; const int bi = b12 / 3; int bj = b12 % 3; bj += (bj >= bi) ? 1 : 0;
                    *(LAS u32x4*)(SC2_SLOT(m ? SL_TT : SL_T) + swz(16 * bi + rr, 32 * bj + 16 * hf)) = zz4; }
            }
            SC2_BAR();
#pragma unroll
            for (int lv = 0; lv < 2; ++lv) { const int sh = 4 + lv;
                const LAS char* Ts = SC2_SLOT(lv ? SL_TB : SL_T); const LAS char* TTs = SC2_SLOT(lv ? SL_TTB : SL_TT); LAS char* Td = SC2_SLOT(lv ? SL_T : SL_TB); LAS char* TTd = SC2_SLOT(lv ? SL_TT : SL_TTB);
                { const Fr fTTx = ldf(TTs, tx, lane); Fr fABy[2];
#pragma unroll
                  for (int j = 0; j < 2; ++j) fABy[j] = ldf(SC2_SLOT(SL_AAB), ty0 + j, lane);
                  SC2_SB();
                  f32x4 ev[2];
#pragma unroll
                  for (int j = 0; j < 2; ++j) ev[j] = mm(fABy[j], fTTx, SC2_Z);
                  SC2_SB();
#pragma unroll
                  for (int j = 0; j < 2; ++j) { const int r0 = 16 * (ty0 + j) + q4;
#pragma unroll
                    for (int e = 0; e < 4; ++e) { const int r = r0 + e; const bool ok = ((r >> (sh + 1)) == (x >> (sh + 1))) && ((r >> sh) & 1) && !((x >> sh) & 1); if (!ok) ev[j][e] = 0.f; }
                    st4(SC2_SLOT(SL_ET), x, r0, ev[j]); } }
                SC2_BAR();
                { const Fr fTx = ldf(Ts, tx, lane), fETx = ldf(SC2_SLOT(SL_ET), tx, lane); Fr fETy[2], fTy[2]; f32x4 tn[2], ttn[2];
#pragma unroll
                  for (int j = 0; j < 2; ++j) { const int y0 = 16 * (ty0 + j) + q4; fETy[j] = ldf(SC2_SLOT(SL_ET), ty0 + j, lane); tn[j] = ld4(Ts, x, y0);
                      if (lv == 0) { fTy[j] = ldf(Ts, ty0 + j, lane); ttn[j] = ld4(TTs, x, y0); } }
                  SC2_SB();
#pragma unroll
                  for (int j = 0; j < 2; ++j) { tn[j] = mm(fETy[j], fTx, tn[j]);
                      if (lv == 0) ttn[j] = mm(fTy[j], fETx, ttn[j]); }
                  SC2_SB();
#pragma unroll
                  for (int j = 0; j < 2; ++j) { const int y0 = 16 * (ty0 + j) + q4; st4(Td, x, y0, tn[j]); if (lv == 0) st4(TTd, x, y0, ttn[j]); } }
                SC2_BAR();
            }
            { const Fr fAHTx = ldf(SC2_SLOT(SL_AHT), tx, lane), fAAKTx = ldf(SC2_SLOT(SL_AAKT), tx, lane); Fr fTy[2];
#pragma unroll
              for (int j = 0; j < 2; ++j) fTy[j] = ldf(SC2_SLOT(SL_T), ty0 + j, lane);
              SC2_SB();
              f32x4 p1[2], p2[2];
#pragma unroll
              for (int j = 0; j < 2; ++j) { p1[j] = mm(fTy[j], fAHTx, SC2_Z); p2[j] = mm(fTy[j], fAAKTx, SC2_Z); }
              SC2_SB();
#pragma unroll
              for (int j = 0; j < 2; ++j) { const int y0 = 16 * (ty0 + j) + q4; st4(SC2_SLOT(SL_P1T), x, y0, p1[j]); st4(SC2_SLOT(SL_P2T), x, y0, p2[j]); } }
            SC2_BAR();
            { const Fr fARBx = ldf(SC2_SLOT(SL_ARB), tx, lane), fBBTx = ldf(SC2_SLOT(SL_BBT), tx, lane); Fr fP1y[2], fP2y[2]; f32x4 q1[2], q2[2], ml[2], zx[2];
#pragma unroll
              for (int j = 0; j < 2; ++j) { const int y0 = 16 * (ty0 + j) + q4; fP1y[j] = ldf(SC2_SLOT(SL_P1T), ty0 + j, lane); fP2y[j] = ldf(SC2_SLOT(SL_P2T), ty0 + j, lane);
                  q1[j] = ld4(SC2_SLOT(SL_RH), x, y0); q2[j] = ld4(SC2_SLOT(SL_ARK), x, y0); zx[j] = ld4(SC2_SLOT(SL_KBT), x, y0); }
              SC2_SB();
#pragma unroll
              for (int j = 0; j < 2; ++j) { q1[j] = mm(fP1y[j], fARBx, q1[j]); q2[j] = mm(fP2y[j], fARBx, q2[j]); ml[j] = mm(fP1y[j], fBBTx, SC2_Z); zx[j] = mm(fP2y[j], fBBTx, zx[j]); }
              SC2_SB();
#pragma unroll
              for (int j = 0; j < 2; ++j) { const int y0 = 16 * (ty0 + j) + q4; st4(SC2_SLOT(SL_Q1), x, y0, q1[j]); st4(SC2_SLOT(SL_Q2), x, y0, q2[j]); st4(SC2_SLOT(SL_ML), x, y0, ml[j]); st4(SC2_SLOT(SL_ZX), x, y0, zx[j]); } }
            SC2_BAR();
            {
                const Fr fSt = ldf(SC2_SLOT(wave < 4 ? SL_S : SL_MT), cb, lane); Fr fVT = fSt; if (wave < 4) fVT = ldf(SC2_SLOT(SL_VT), cb, lane);
#pragma unroll
                for (int hf = 0; hf < 2; ++hf) { Fr fQ1[2], fQ2[2];
#pragma unroll
                  for (int t2 = 0; t2 < 2; ++t2) { const int tt = 2 * hf + t2; fQ1[t2] = ldf(SC2_SLOT(SL_Q1), tt, lane); fQ2[t2] = fQ1[t2]; if (wave < 4) fQ2[t2] = ldf(SC2_SLOT(SL_Q2), tt, lane); }
                  SC2_SB();
                  f32x4 yv[2];
#pragma unroll
                  for (int t2 = 0; t2 < 2; ++t2) { yv[t2] = mm(fSt, fQ1[t2], SC2_Z); if (wave < 4) yv[t2] = mm(fVT, fQ2[t2], yv[t2]); }
                  SC2_SB();
#pragma unroll
                  for (int t2 = 0; t2 < 2; ++t2) { const int tt = 2 * hf + t2; const int n = ck * CH + 16 * tt + l15;
                    if (wave < 4) {
                        if (ck >= CTX / CH) { const int row = scan_row_of(b, dir, n); h16x4 o; o[0] = (_Float16)yv[t2][0]; o[1] = (_Float16)yv[t2][1]; o[2] = (_Float16)yv[t2][2]; o[3] = (_Float16)yv[t2][3];
                            *(h16x4*)(YS + ((size_t)dir * ML + row) * 512 + head * 64 + 16 * cb + q4) = o; } }
                    else { u32x2 w; w.x = cvt_pk_bf16_n(yv[t2][0], yv[t2][1]); w.y = cvt_pk_bf16_n(yv[t2][2], yv[t2][3]); *(u32x2*)(QC + (size_t)n * 64 + 16 * cb + q4) = w; } } }
#pragma unroll
                for (int hf = 0; hf < 2; ++hf) { Fr fML[2], fZX[2]; f32x4 g[2];
#pragma unroll
                  for (int t2 = 0; t2 < 2; ++t2) { const int tk = 2 * hf + t2; fML[t2] = ldf(SC2_SLOT(SL_ML), tk, lane); fZX[t2] = fML[t2]; if (wave < 4) fZX[t2] = ldf(SC2_SLOT(SL_ZX), tk, lane); g[t2] = *(const LAS f32x4*)(gC + 16 * tk + q4); }
                  SC2_SB();
#pragma unroll
                  for (int t2 = 0; t2 < 2; ++t2) { const int tk = 2 * hf + t2; f32x4 xn = mm(fML[t2], fSt, mst[tk] * g[t2]); if (wave < 4) xn = mm(fZX[t2], fVT, xn); mst[tk] = xn; }
                  SC2_SB(); }
                SC2_BAR();
                LAS char* Sw = SC2_SLOT(wave < 4 ? SL_S : SL_MT);
#pragma unroll
                for (int tk = 0; tk < 4; ++tk) st4(Sw, 16 * cb + l15, 16 * tk + q4, mst[tk]);
            }
        }
        { float* dst = SEG + (wave < 4 ? 0 : 4096);
#pragma unroll
          for (int tk = 0; tk < 4; ++tk)
#pragma unroll
              for (int e = 0; e < 4; ++e) dst[(16 * tk + q4 + e) * 64 + 16 * cb + l15] = mst[tk][e]; }
        SC2_BAR();
    }
#undef SC2_LOADRAW
}

__device__ __forceinline__ void pass_b(KP p, LAS unsigned char* lds) {
    const int tid = threadIdx.x, lane = tid & 63, wave = __builtin_amdgcn_readfirstlane(tid >> 6), q4 = (lane >> 4) * 4, l15 = lane & 15;
    unsigned char* ws = p.ws;
    _Float16* YS = (_Float16*)((unsigned char*)p.out + DO_YS);
    LAS float* Xa = (LAS float*)lds; LAS float* Xb = Xa + 4096; LAS float* Mm = Xb + 4096;
    LAS char* Sst = (LAS char*)lds + 3 * 16384;
    for (int unit = blockIdx.x; unit < 256; unit += gridDim.x) {
        const int chain = unit >> 2, seg = unit & 3, dir = chain & 1, head = (chain >> 1) & 7, b = chain >> 4;
        if (seg == 0) continue;
        const bf16_t* QC = (const bf16_t*)(ws + (dir ? WS_QC1 : WS_QC0)) + (size_t)(chain >> 1) * SKV * 64;
        const float* SEG0 = (const float*)(ws + WS_SEG) + (size_t)(chain * 4) * 8192;
        for (int i = tid; i < 4096; i += NTHREADS) Xa[i] = SEG0[i];
        __syncthreads();
        LAS float* xc = Xa; LAS float* xn = Xb;
        for (int m = 1; m < seg; ++m) {
            const float* sg = SEG0 + (size_t)m * 8192;
            for (int i = tid; i < 4096; i += NTHREADS) Mm[i] = sg[4096 + i];
            __syncthreads();
            const int v = lane, k0 = wave * 8; float acc[8];
#pragma unroll
            for (int i = 0; i < 8; ++i) acc[i] = sg[(k0 + i) * 64 + v];
            for (int k2 = 0; k2 < 64; ++k2) { const float xv = xc[k2 * 64 + v];
#pragma unroll
                for (int i = 0; i < 8; ++i) acc[i] += Mm[(k0 + i) * 64 + k2] * xv; }
#pragma unroll
            for (int i = 0; i < 8; ++i) xn[(k0 + i) * 64 + v] = acc[i];
            __syncthreads();
            LAS float* tmp = xc; xc = xn; xn = tmp;
        }
        { const int v = lane, k0 = wave * 8; u32x4 o;
#pragma unroll
          for (int i = 0; i < 4; ++i) o[i] = cvt_pk_bf16_n(xc[(k0 + 2 * i) * 64 + v], xc[(k0 + 2 * i + 1) * 64 + v]);
          *(LAS u32x4*)(Sst + swz(v, k0 * 2)) = o; }
        SC2_BAR();
        const int cb = wave & 3, tt0 = (wave >> 2) * 2; const Fr fS = ldf(Sst, cb, lane);
        bf16x8 nb0[2], nb1[2]; h16x4 ny[2]; _Float16* nyp[2];
#define SC2_PBLOAD(ck_) do { _Pragma("unroll") for (int j = 0; j < 2; ++j) { const int n_ = (ck_) * CH + 16 * (tt0 + j) + l15; const bf16_t* qp_ = QC + (size_t)n_ * 64 + (lane >> 4) * 8; \
            nb0[j] = *(const bf16x8*)qp_; nb1[j] = *(const bf16x8*)(qp_ + 32); const int row_ = scan_row_of(b, dir, n_); \
            nyp[j] = YS + ((size_t)dir * ML + row_) * 512 + head * 64 + 16 * cb + q4; ny[j] = *(const h16x4*)nyp[j]; } } while (0)
        SC2_PBLOAD(seg * CPS);
        for (int ck = seg * CPS; ck < (seg + 1) * CPS; ++ck) {
            bf16x8 b0[2], b1[2]; h16x4 yv[2]; _Float16* yp[2];
#pragma unroll
            for (int j = 0; j < 2; ++j) { b0[j] = nb0[j]; b1[j] = nb1[j]; yv[j] = ny[j]; yp[j] = nyp[j]; }
            if (ck + 1 < (seg + 1) * CPS) SC2_PBLOAD(ck + 1);
#pragma unroll
            for (int j = 0; j < 2; ++j) {
                f32x4 acc = {0.f, 0.f, 0.f, 0.f};
                acc = __builtin_amdgcn_mfma_f32_16x16x32_bf16(fS.k0, b0[j], acc, 0, 0, 0);
                acc = __builtin_amdgcn_mfma_f32_16x16x32_bf16(fS.k1, b1[j], acc, 0, 0, 0);
                h16x4 o = yv[j]; o[0] = (_Float16)((float)o[0] + acc[0]); o[1] = (_Float16)((float)o[1] + acc[1]); o[2] = (_Float16)((float)o[2] + acc[2]); o[3] = (_Float16)((float)o[3] + acc[3]);
                *(h16x4*)yp[j] = o; }
        }
#undef SC2_PBLOAD
        __syncthreads();
    }
}
#undef SC2_SLOT
#undef SC2_BAR
}

__device__ __forceinline__ void ph_readout(KP p) {
    const int tid = threadIdx.x, lane = tid & 63, wave = tid >> 6;
    unsigned char* ws = p.ws;
    const _Float16* RKV = (const _Float16*)(ws + WS_RKV); const _Float16* A16 = (const _Float16*)(ws + WS_A16); const _Float16* G16 = (const _Float16*)(ws + WS_G16);
    const _Float16* YS = (const _Float16*)((const unsigned char*)p.out + DO_YS); bf16_t* MIX = (bf16_t*)((unsigned char*)p.out + DO_MIX);
    const int gw = blockIdx.x * NWAVES + wave, NGW = gridDim.x * NWAVES; const int c0 = lane * 8;
    float gng[8], gnb[8], ka_[8], rk_[8];
#pragma unroll
    for (int i = 0; i < 8; ++i) { gng[i] = p.in[I_GNG][c0 + i]; gnb[i] = p.in[I_GNB][c0 + i]; ka_[i] = p.in[I_KA][c0 + i]; rk_[i] = p.in[I_RK][c0 + i]; }
    ER(8) for (int row = gw; row < ML; row += NGW) {
        const h16x8 y0 = __builtin_nontemporal_load((const h16x8*)(YS + (size_t)row * 512 + c0)), y1 = __builtin_nontemporal_load((const h16x8*)(YS + ((size_t)ML + row) * 512 + c0));
        const h16x8 r8 = __builtin_nontemporal_load((const h16x8*)(RKV + (size_t)row * 1536 + c0)), k8 = __builtin_nontemporal_load((const h16x8*)(RKV + (size_t)row * 1536 + 512 + c0)), v8 = __builtin_nontemporal_load((const h16x8*)(RKV + (size_t)row * 1536 + 1024 + c0));
        const h16x8 a0 = __builtin_nontemporal_load((const h16x8*)(A16 + (size_t)row * 512 + c0)), a1 = __builtin_nontemporal_load((const h16x8*)(A16 + ((size_t)MA + row) * 512 + c0)), g8 = __builtin_nontemporal_load((const h16x8*)(G16 + (size_t)row * 512 + c0));
        float y[8]; float s = 0.f, bo = 0.f;
#pragma unroll
        for (int i = 0; i < 8; ++i) { y[i] = (float)y0[i] + (float)y1[i]; s += y[i];
            const float ksum = (float)k8[i] * (2.0f + ((float)a0[i] + (float)a1[i] - 2.0f) * ka_[i]); bo += (float)r8[i] * ksum * rk_[i]; }
        s += __shfl_xor(s, 1); s += __shfl_xor(s, 2); s += __shfl_xor(s, 4);
        bo += __shfl_xor(bo, 1); bo += __shfl_xor(bo, 2); bo += __shfl_xor(bo, 4);
        const float mu = s * (1.f / 64.f); float q = 0.f;
#pragma unroll
        for (int i = 0; i < 8; ++i) { y[i] -= mu; q += y[i] * y[i]; }
        q += __shfl_xor(q, 1); q += __shfl_xor(q, 2); q += __shfl_xor(q, 4);
        const float rstd = 1.0f / sqrtf(q * (1.f / 64.f) + GN_EPS);
        float o[8];
#pragma unroll
        for (int i = 0; i < 8; ++i) o[i] = (y[i] * rstd * gng[i] + gnb[i] + bo * (float)v8[i]) * (float)g8[i];
        u32x4 w; w.x = cvt_pk_bf16(o[0], o[1]); w.y = cvt_pk_bf16(o[2], o[3]); w.z = cvt_pk_bf16(o[4], o[5]); w.w = cvt_pk_bf16(o[6], o[7]);
        *(u32x4*)(MIX + (size_t)row * 1024 + c0) = w;
    }
}

__device__ __forceinline__ void ph_ln1_router(KP p, LAS unsigned char* lds) {
    const int tid = threadIdx.x, lane = tid & 63, wave = tid >> 6;
    unsigned char* ws = p.ws;
    _Float16* X1 = (_Float16*)(ws + WS_X1); bf16_t* XM2 = (bf16_t*)(ws + WS_XM2);
    float* AFF = (float*)(ws + WS_AFF); int* SLOT = (int*)(ws + WS_SLOT); const float* mod = (const float*)(ws + WS_MOD);
    LAS float* rt = (LAS float*)lds;
    LAS float* vec = (LAS float*)(lds + 65536);
    for (int i = tid; i < 1024 * 16; i += NTHREADS) rt[(i & 15) * 1024 + (i >> 4)] = p.in[I_ROUTER][i];
    for (int i = tid; i < 2048; i += NTHREADS) vec[3072 + i] = i < 1024 ? p.in[I_LN1G][i] : p.in[I_LN1B][i - 1024];
    const int G = gridDim.x, RPB = (((ML + G - 1) / G) + 15) & ~15;
    const int r0 = blockIdx.x * RPB, r1 = (r0 + RPB < ML) ? r0 + RPB : ML;
    const bf16_t* MO = (const bf16_t*)(ws + WS_Y1); const float* Xin = p.in[I_X];
    int curb = -1;
    f32x4 xa[4], xb[4]; u32x2 ma[4], mb[4];
#define LN1_LOAD(X, M, row_) do { const int rr_ = (row_) < r1 ? (row_) : (r1 - 8 + wave); const size_t o_ = (size_t)rr_ * D + lane * 4; \
    _Pragma("unroll") for (int q = 0; q < 4; ++q) { X[q] = __builtin_nontemporal_load((const f32x4*)(Xin + o_ + q * 256)); M[q] = __builtin_nontemporal_load((const u32x2*)(MO + o_ + q * 256)); } } while (0)
    if (r0 < ML) { LN1_LOAD(xa, ma, r0 + wave); LN1_LOAD(xb, mb, r0 + 8 + wave); }
#define LN1_HEAD(X, M, U, row_, nxt_) do { const int row = (row_); \
        f32x4 v[4]; float s = 0.f; \
        _Pragma("unroll") for (int q = 0; q < 4; ++q) { const f32x4 gv = *(const LAS f32x4*)(lds + lb1 + q * 1024), mv = {bflo(M[q].x), bfhi(M[q].x), bflo(M[q].y), bfhi(M[q].y)}; \
            v[q] = X[q] * ALPHA + gv * mv; s += (v[q].x + v[q].y) + (v[q].z + v[q].w); } \
        LN1_LOAD(X, M, nxt_); \
        float mean = wave_sum(s) * (1.f / D); float s2 = 0.f; \
        _Pragma("unroll") for (int q = 0; q < 4; ++q) { v[q] = v[q] - mean; s2 += (v[q].x * v[q].x + v[q].y * v[q].y) + (v[q].z * v[q].z + v[q].w * v[q].w); } \
        float rstd = __builtin_amdgcn_rsqf(wave_sum(s2) * (1.f / D) + LN_EPS); \
        s = 0.f; \
        _Pragma("unroll") for (int q = 0; q < 4; ++q) { const int c = q * 256 + lane * 4; const f32x4 g = *(const LAS f32x4*)(lds + lb1 + 12288 + q * 1024), bb = *(const LAS f32x4*)(lds + lb1 + 16384 + q * 1024); \
            v[q] = v[q] * rstd * g + bb; { h16x4 hv_ = {(_Float16)v[q].x, (_Float16)v[q].y, (_Float16)v[q].z, (_Float16)v[q].w}; *(h16x4*)(X1 + (size_t)row * D + c) = hv_; } s += (v[q].x + v[q].y) + (v[q].z + v[q].w); } \
        mean = wave_sum(s) * (1.f / D); s2 = 0.f; \
        _Pragma("unroll") for (int q = 0; q < 4; ++q) { v[q] = v[q] - mean; s2 += (v[q].x * v[q].x + v[q].y * v[q].y) + (v[q].z * v[q].z + v[q].w * v[q].w); } \
        rstd = __builtin_amdgcn_rsqf(wave_sum(s2) * (1.f / D) + LN_EPS); \
        _Pragma("unroll") for (int q = 0; q < 4; ++q) { const int c = q * 256 + lane * 4; const f32x4 a1 = *(const LAS f32x4*)(lds + lb1 + 8192 + q * 1024), bsh = *(const LAS f32x4*)(lds + lb1 + 4096 + q * 1024); \
            U[q] = v[q] * rstd * a1 + bsh; \
            u32x2 w; w.x = cvt_pk_bf16(U[q].x, U[q].y); w.y = cvt_pk_bf16(U[q].z, U[q].w); *(u32x2*)(XM2 + (size_t)row * D + c) = w; } } while (0)
#define LN1_TAIL(CMP, row_) do { const int row = (row_); const int b = row >> 13, t = row & (T - 1); \
        float lg[16]; \
        _Pragma("unroll") for (int e = 0; e < 16; ++e) lg[e] = acc[e].CMP; \
        float t8[8], t4[4]; \
        _Pragma("unroll") for (int e = 0; e < 8; ++e) { const auto r = __builtin_amdgcn_permlane32_swap(__float_as_uint(lg[e]), __float_as_uint(lg[e + 8]), false, false); t8[e] = __uint_as_float(r[0]) + __uint_as_float(r[1]); } \
        _Pragma("unroll") for (int e = 0; e < 4; ++e) { const auto r = __builtin_amdgcn_permlane16_swap(__float_as_uint(t8[e]), __float_as_uint(t8[e + 4]), false, false); t4[e] = __uint_as_float(r[0]) + __uint_as_float(r[1]); } \
        const bool o0 = lane & 1, o1 = lane & 2; \
        const float w0 = (o0 ? t4[1] : t4[0]) + dppf<0xB1>(o0 ? t4[0] : t4[1]), w1 = (o0 ? t4[3] : t4[2]) + dppf<0xB1>(o0 ? t4[2] : t4[3]); \
        float z = (o1 ? w1 : w0) + dppf<0x4E>(o1 ? w0 : w1); \
        z += dppf<0x124>(z); z += dppf<0x128>(z); \
        float mx = fmaxf(z, dppf<0xB1>(z)); mx = fmaxf(mx, dppf<0x4E>(mx)); mx = fmaxf(mx, dppf<0x141>(mx)); mx = fmaxf(mx, dppf<0x140>(mx)); \
        { const auto r = __builtin_amdgcn_permlane16_swap(__float_as_uint(mx), __float_as_uint(mx), false, false); mx = fmaxf(__uint_as_float(r[0]), __uint_as_float(r[1])); } \
        { const auto r = __builtin_amdgcn_permlane32_swap(__float_as_uint(mx), __float_as_uint(mx), false, false); mx = fmaxf(__uint_as_float(r[0]), __uint_as_float(r[1])); } \
        const float ez = __expf(z - mx); const float den = wave_sum(ez) * 0.25f;          \
        if (((lane >> 2) & 3) == 0) { const int e = (lane & 3) + 4 * (lane >> 4); AFF[((size_t)b * 16 + e) * T + t] = ez * __builtin_amdgcn_rcpf(den); SLOT[(size_t)row * 16 + e] = -1; } } while (0)
    for (int rb = r0; rb < r1; rb += 16) {
        const int b = rb >> 13;
        if (b != curb) { __syncthreads();
            for (int i = tid; i < 3072; i += NTHREADS) { const float x = mod[b * 6144 + 2048 + i]; vec[i] = (i >= 2048) ? x + 1.0f : x; }
            __syncthreads(); curb = b; }
        int lb0 = lane * 16, lb1 = 65536 + lane * 16; asm volatile("" : "+v"(lb0), "+v"(lb1));
        f32x4 ua[4], ub[4];
        LN1_HEAD(xa, ma, ua, rb + wave, rb + 16 + wave);
        __builtin_amdgcn_sched_barrier(0);
        LN1_HEAD(xb, mb, ub, rb + 8 + wave, rb + 24 + wave);
        __builtin_amdgcn_sched_barrier(0);
        f32x2 acc[16];
#pragma unroll
        for (int e = 0; e < 16; ++e) acc[e] = (f32x2){0.f, 0.f};
#pragma unroll
        for (int q = 0; q < 4; ++q) {
            const f32x2 u0 = {ua[q].x, ub[q].x}, u1 = {ua[q].y, ub[q].y}, u2 = {ua[q].z, ub[q].z}, u3 = {ua[q].w, ub[q].w};
#pragma unroll
            for (int eh = 0; eh < 16; eh += 8) { f32x4 r[8];
#pragma unroll
                for (int e = 0; e < 8; ++e) r[e] = *(const LAS f32x4*)(lds + lb0 + (eh + e) * 4096 + q * 1024);
#pragma unroll
                for (int e = 0; e < 8; ++e) { f32x2 t = acc[eh + e];
                    t = __builtin_elementwise_fma(u0, (f32x2){r[e].x, r[e].x}, t); t = __builtin_elementwise_fma(u1, (f32x2){r[e].y, r[e].y}, t);
                    t = __builtin_elementwise_fma(u2, (f32x2){r[e].z, r[e].z}, t); t = __builtin_elementwise_fma(u3, (f32x2){r[e].w, r[e].w}, t); acc[eh + e] = t; }
                __builtin_amdgcn_sched_barrier(0); } }
        LN1_TAIL(x, rb + wave);
        __builtin_amdgcn_sched_barrier(0);
        LN1_TAIL(y, rb + 8 + wave);
        __builtin_amdgcn_sched_barrier(0);
    }
#undef LN1_HEAD
#undef LN1_TAIL
#undef LN1_LOAD
#undef LN1_ROW
}

__device__ __forceinline__ void ph_expert_weights(KP p, LAS unsigned char* lds) {
    const int tid = threadIdx.x, lane = tid & 63, wave = tid >> 6;
    unsigned char* ws = p.ws;
    const int gw = blockIdx.x * NWAVES + wave, NGW = gridDim.x * NWAVES;
    {
        LAS float* scr = (LAS float*)(lds + wave * 8448);
        bf16_t* WGU = (bf16_t*)(ws + WS_WGU); bf16_t* WD = (bf16_t*)(ws + WS_WD);
        constexpr int PER = 16 * 32;
#ifndef TOPK_ITEMS
#define TOPK_ITEMS 9
#endif
        constexpr int NIT = 3 * 16 * PER; const int G = gridDim.x, bx = blockIdx.x;
        int ibase, icnt;
        if (G == 256 && (NIT - 64 * 8 * TOPK_ITEMS) % (192 * 8) == 0) { constexpr int CN = (NIT - 64 * 8 * TOPK_ITEMS) / (192 * 8);
            if (bx < 64) { icnt = TOPK_ITEMS; ibase = 192 * 8 * CN + bx * 8 * TOPK_ITEMS; } else { icnt = CN; ibase = (bx - 64) * 8 * CN; } }
        else { icnt = (NIT + NGW - 1) / NGW; ibase = bx * 8 * icnt; }
        ER(11) for (int ii = 0; ii < icnt; ++ii) { const int it = ibase + ii * 8 + wave; if (it >= NIT) break;
            const int which = it / (16 * PER), r = it % (16 * PER), e = r / PER, kb = (r % PER) / 32, nb = r % 32;
            if (which < 2) { const float* W = p.in[which == 0 ? I_EG : I_EU] + (size_t)e * 1024 * 1024; const int f0 = nb * 32;
                const int drow = 256 * (f0 >> 7) + (which == 1 ? 128 : 0) + (f0 & 127);
                transpose_item(W, 1024, kb * 64, f0, WGU + ((size_t)e * 2048 + drow) * 1024 + kb * 64, 1024, nullptr, scr, lane); }
            else { const float* W = p.in[I_ED] + (size_t)e * 1024 * 1024;
                transpose_item(W, 1024, kb * 64, nb * 32, WD + ((size_t)e * 1024 + nb * 32) * 1024 + kb * 64, 1024, nullptr, scr, lane); }
        }
    }
}

__device__ __forceinline__ void ph_topk(KP p, LAS unsigned char* lds) {
    const int tid = threadIdx.x, lane = tid & 63, wave = tid >> 6;
    unsigned char* ws = p.ws;
    const float* AFF = (const float*)(ws + WS_AFF); int* SLOT = (int*)(ws + WS_SLOT); int* IDX = (int*)(ws + WS_IDX); float* GATE = (float*)(ws + WS_GATE);
    LAS unsigned* hist = (LAS unsigned*)lds;
    LAS unsigned* sh = (LAS unsigned*)(lds + 1024);
    for (int prob = blockIdx.x; prob < 64; prob += gridDim.x) {
        const int b = prob >> 4, e = prob & 15;
        const float* av = AFF + (size_t)prob * T;
        unsigned key[16];
#pragma unroll
        for (int i = 0; i < 4; ++i) { const u32x4 x = __builtin_nontemporal_load((const u32x4*)(av + tid * 16 + i * 4)); key[4 * i] = x.x; key[4 * i + 1] = x.y; key[4 * i + 2] = x.z; key[4 * i + 3] = x.w; }
        unsigned prefix = 0, kth = CAP;
        for (int pass = 0; pass < 4; ++pass) {
            const int shift = 24 - 8 * pass; const unsigned himask = pass == 0 ? 0u : (0xffffffffu << (shift + 8));
            if (tid < 256) hist[tid] = 0u;
            __syncthreads();
#pragma unroll
            for (int i = 0; i < 16; ++i) if ((key[i] & himask) == prefix) atomicAdd((unsigned*)&hist[(key[i] >> shift) & 255u], 1u);
            __syncthreads();
            if (wave == 0) {
                const u32x4 h4 = *(const LAS u32x4*)(hist + lane * 4); const unsigned sl = h4.x + h4.y + h4.z + h4.w; unsigned suf = sl;
#pragma unroll
                for (int o = 1; o < 64; o <<= 1) { const unsigned tt = __shfl_down(suf, o); if (lane + o < 64) suf += tt; }
                const unsigned above = suf - sl;
                if (above < kth && kth <= suf) { unsigned cum = above; int d;
                    if (cum + h4.w >= kth) d = 3; else { cum += h4.w; if (cum + h4.z >= kth) d = 2; else { cum += h4.z; if (cum + h4.y >= kth) d = 1; else { cum += h4.y; d = 0; } } }
                    sh[0] = prefix | ((unsigned)(4 * lane + d) << shift); sh[1] = kth - cum; } }
            __syncthreads();
            prefix = sh[0]; kth = sh[1];
            __syncthreads();
        }
        unsigned ngt = 0, neq = 0;
#pragma unroll
        for (int i = 0; i < 16; ++i) { ngt += key[i] > prefix; neq += key[i] == prefix; }
        unsigned ig = ngt, iq = neq;
#pragma unroll
        for (int o = 1; o < 64; o <<= 1) { const unsigned a = __shfl_up(ig, o), c = __shfl_up(iq, o); if (lane >= o) { ig += a; iq += c; } }
        if (lane == 63) { sh[8 + wave] = ig; sh[16 + wave] = iq; }
        __syncthreads();
        unsigned og = 0, oq = 0;
        for (int w = 0; w < wave; ++w) { og += sh[8 + w]; oq += sh[16 + w]; }
        unsigned eg = og + ig - ngt, eq = oq + iq - neq;
        const int sbase = (e * 4 + b) * CAP;
#pragma unroll
        for (int i = 0; i < 16; ++i) {
            const int t = tid * 16 + i; bool take = false;
            if (key[i] > prefix) take = true; else if (key[i] == prefix) { take = eq < kth; }
            if (take) { const unsigned eqsel = eq < kth ? eq : kth; const int c = (int)(eg + eqsel);
                IDX[sbase + c] = t; GATE[sbase + c] = __uint_as_float(key[i]); SLOT[((size_t)b * T + t) * 16 + e] = c; }
            if (key[i] > prefix) ++eg; else if (key[i] == prefix) ++eq;
        }
        __syncthreads();
    }
}

__device__ __forceinline__ void ph_final(KP p) {
    const int tid = threadIdx.x, lane = tid & 63, wave = tid >> 6;
    unsigned char* ws = p.ws;
    const _Float16* X1 = (const _Float16*)(ws + WS_X1); const bf16_t* YE = (const bf16_t*)(ws + WS_YE); const int* SLOT = (const int*)(ws + WS_SLOT); const float* mod = (const float*)(ws + WS_MOD);
    const int gw = blockIdx.x * NWAVES + wave, NGW = gridDim.x * NWAVES;
    if (gw >= ML) return;
#define FIN_ROWC(r_) ((r_) < ML ? (r_) : gw)
#define FIN_SLOTS(r_) (lane < 16 ? SLOT[(size_t)FIN_ROWC(r_) * 16 + lane] : -1)
#define FIN_GATHER(W, NE, REST, sl_, r_) do { unsigned long long act_ = __ballot((sl_) >= 0); const int b_ = FIN_ROWC(r_) >> 13; NE = 0; \
        _Pragma("unroll") for (int i = 0; i < 4; ++i) { const bool on_ = act_ != 0; const int e_ = on_ ? __builtin_ctzll(act_) : 0; if (on_) { act_ &= act_ - 1; NE = i + 1; } \
            const int c_ = __shfl((sl_), e_); const bf16_t* yr_ = YE + ((size_t)(e_ * 4 + b_) * CAP + (c_ < 0 ? 0 : c_)) * 1024; \
            if (on_) { _Pragma("unroll") for (int q = 0; q < 4; ++q) W[i][q] = __builtin_nontemporal_load((const u32x2*)(yr_ + q * 256 + lane * 4)); } } \
        REST = act_; } while (0)
    int s1 = FIN_SLOTS(gw), s2 = FIN_SLOTS(gw + NGW);
    f32x4 nx[4]; u32x2 nw[4][4]; int nne; unsigned long long nrest;
#pragma unroll
    for (int q = 0; q < 4; ++q) { const h16x4 hv_ = __builtin_nontemporal_load((const h16x4*)(X1 + (size_t)gw * D + q * 256 + lane * 4)); nx[q] = (f32x4){(float)hv_[0], (float)hv_[1], (float)hv_[2], (float)hv_[3]}; }
    FIN_GATHER(nw, nne, nrest, s1, gw);
    ER(14) for (int row = gw; row < ML; row += NGW) {
        const int b = row >> 13;
        const int myslot = s1; const int ne = nne; unsigned long long rest = nrest;
        f32x4 v[4]; u32x2 w[4][4];
#pragma unroll
        for (int q = 0; q < 4; ++q) v[q] = nx[q];
#pragma unroll
        for (int i = 0; i < 4; ++i)
#pragma unroll
            for (int q = 0; q < 4; ++q) w[i][q] = nw[i][q];
        s1 = s2; s2 = FIN_SLOTS(row + 2 * NGW);
        { const int nr = FIN_ROWC(row + NGW);
#pragma unroll
          for (int q = 0; q < 4; ++q) { const h16x4 hv_ = __builtin_nontemporal_load((const h16x4*)(X1 + (size_t)nr * D + q * 256 + lane * 4)); nx[q] = (f32x4){(float)hv_[0], (float)hv_[1], (float)hv_[2], (float)hv_[3]}; }
          FIN_GATHER(nw, nne, nrest, s1, row + NGW); }
        f32x4 m[4];
#pragma unroll
        for (int q = 0; q < 4; ++q) m[q] = (f32x4){0.f, 0.f, 0.f, 0.f};
#pragma unroll
        for (int i = 0; i < 4; ++i) if (i < ne) {
#pragma unroll
            for (int q = 0; q < 4; ++q) { m[q].x += bflo(w[i][q].x); m[q].y += bfhi(w[i][q].x); m[q].z += bflo(w[i][q].y); m[q].w += bfhi(w[i][q].y); } }
        while (rest) {
            const int e = __builtin_ctzll(rest); rest &= rest - 1;
            const int c = __shfl(myslot, e); const bf16_t* yr = YE + ((size_t)(e * 4 + b) * CAP + (c < 0 ? 0 : c)) * 1024;
#pragma unroll
            for (int q = 0; q < 4; ++q) { const u32x2 ww = *(const u32x2*)(yr + q * 256 + lane * 4); m[q].x += bflo(ww.x); m[q].y += bfhi(ww.x); m[q].z += bflo(ww.y); m[q].w += bfhi(ww.y); } }
        float s = 0.f;
#pragma unroll
        for (int q = 0; q < 4; ++q) { const int c = q * 256 + lane * 4; const f32x4 g2 = *(const f32x4*)(mod + b * 6144 + 5120 + c);
            v[q] = v[q] * ALPHA + g2 * m[q]; s += (v[q].x + v[q].y) + (v[q].z + v[q].w); }
        const float mean = wave_sum(s) * (1.f / D); float s2v = 0.f;
#pragma unroll
        for (int q = 0; q < 4; ++q) { v[q] = v[q] - mean; s2v += (v[q].x * v[q].x + v[q].y * v[q].y) + (v[q].z * v[q].z + v[q].w * v[q].w); }
        const float rstd = __builtin_amdgcn_rsqf(wave_sum(s2v) * (1.f / D) + LN_EPS);
#pragma unroll
        for (int q = 0; q < 4; ++q) { const int c = q * 256 + lane * 4; const f32x4 g = *(const f32x4*)(p.in[I_LN2G] + c), bb = *(const f32x4*)(p.in[I_LN2B] + c);
            __builtin_nontemporal_store(v[q] * rstd * g + bb, (f32x4*)(p.out + (size_t)row * D + c)); }
    }
#undef FIN_ROWC
#undef FIN_SLOTS
#undef FIN_GATHER
}

__global__ void __launch_bounds__(NTHREADS, 2) mega(Params p_unused) {
    const Params __attribute__((address_space(4)))* pq = (const Params __attribute__((address_space(4)))*)__builtin_amdgcn_kernarg_segment_ptr();
    KP p = *pq;
    extern __shared__ __attribute__((aligned(16))) unsigned char lds_raw[];
    LAS unsigned char* lds = (LAS unsigned char*)lds_raw;
    cg::grid_group grid = cg::this_grid();
    unsigned char* ws = p.ws;
    const int lo = p.ph_lo, hi = p.ph_hi;
    const int G = gridDim.x, bx = blockIdx.x;
    volatile LAS unsigned* xst = (volatile LAS unsigned*)(lds + LDS_BYTES - 64);
    if (threadIdx.x < 4) xst[threadIdx.x] = 0u;
    __syncthreads();
    const XcdBarrier xbar = xcd_barrier_post((unsigned*)(ws + WS_CTL), xst);
    if (lo < 0) grid.sync();
#ifndef PHMASK
#define PHMASK 0x7fff
#endif
#define IN(k) ((((PHMASK) >> (k)) & 1) && lo <= (k) && (k) < hi)
#define SEAM(k) do { if (IN(k) && IN((k) + 1)) xcd_barrier(xbar); } while (0)
#ifndef DUPMASK
#define DUPMASK 0
#endif
#ifndef GDUP
#define GDUP 0
#endif
#define GD(k) ((((GDUP) >> (k)) & 1) + 1)
#define REPL(k) for (int repl_ = 0; repl_ <= (((DUPMASK) >> (k)) & 1); ++repl_, __syncthreads())
#define REP(k) for (int rep_ = 0; rep_ <= (((DUPMASK) >> (k)) & 1); ++rep_, ((((DUPMASK) >> (k)) & 1) && rep_ == 1 ? grid.sync() : (void)0))
    if (IN(0)) REP(0) { ph_mod_and_weights(p, lds); } SEAM(0);
    if (IN(1)) REP(1) { ph_modulate1(p); } SEAM(1);
    if (IN(2)) REP(2) {
        pg8::Gemm g{(const bf16_t*)(ws + WS_XM), (const bf16_t*)(ws + WS_WIN), 1024, 1024}; pg8::DenseOrder S; S.init(MA, NHP, G, bx, GD(2));
        EpiH E{(bf16_t*)(ws + WS_H)}; pg8::gemm_phase(lds, g, S, E); } SEAM(2);
    if (IN(3)) REP(3) { ph_prepare(p); } SEAM(3);
    if (IN(4)) REP(4) {
        { pg8::Gemm g{(const bf16_t*)(ws + WS_H) + 1920, (const bf16_t*)(ws + WS_WUQ), 256, NHP}; pg8::DenseOrder S; S.init(ML, 768, G, bx, GD(4));
          EpiQ E{(bf16_t*)(ws + WS_Q), (const float*)(ws + WS_RSTDQ)}; pg8::gemm_phase(lds, g, S, E); }
        { pg8::Gemm g{(const bf16_t*)(ws + WS_H) + 2176, (const bf16_t*)(ws + WS_WUKV), 256, NHP}; pg8::DenseOrder S; S.init(MA, 1024, G, bx, GD(4));
          EpiKV E{(bf16_t*)(ws + WS_K), (bf16_t*)(ws + WS_V), (const float*)(ws + WS_RSTDKV)}; pg8::gemm_phase(lds, g, S, E); } } SEAM(4);
    if (IN(5)) REP(5) {
        pg8::Gemm g{(const bf16_t*)(ws + WS_ACT), (const bf16_t*)(ws + WS_WLORA), 128, 384}; pg8::LoraOrder S; S.init(MA, 2560, G, bx, GD(5));
        EpiLora E{(_Float16*)(ws + WS_E16), (_Float16*)(ws + WS_A16), (_Float16*)(ws + WS_G16), p.in[I_W0], p.in[I_A0]}; pg8::gemm_phase(lds, g, S, E); } SEAM(5);
    if (IN(6)) REP(6) {
        const int vcu = (G % 8 == 0) ? (bx % 8) * (G / 8) + bx / 8 : bx;
#ifndef MIXGRP
#define MIXGRP 2
#endif
        const int grp = (MIXGRP == 1) ? 0 : ((G % 8 == 0) ? (bx / 8) % MIXGRP : bx % MIXGRP);
        const int scan_slot = (MIXGRP == 1) ? 2 : (MIXGRP == 2 ? (grp == 0 ? 2 : 0) : 2 - grp);
        int au = vcu; const int natt = vcu < 512 ? (512 - vcu + G - 1) / G : 0; const int sslot = scan_slot < natt ? scan_slot : natt;
        for (int slot = 0; slot <= natt; ++slot) {
            if (slot == sslot) { sc2::pass_a(p, lds); __syncthreads(); }
            else { const int unit = au; au += G; const int bh = unit >> 5, qb = unit & 31; const int b = bh >> 2, hh = bh & 3;
                att2::attn_unit((const bf16_t*)(ws + WS_Q) + ((size_t)bh * T + qb * 256) * 192, (const bf16_t*)(ws + WS_K) + (size_t)bh * SKV * 192, (const bf16_t*)(ws + WS_V) + (size_t)bh * SKV * 128,
                               (bf16_t*)((unsigned char*)p.out + DO_MIX) + ((size_t)b * T + qb * 256) * 1024 + 512 + hh * 128, lds);
                __syncthreads(); }
        }
        } SEAM(6);
    if (IN(7)) REP(7) { sc2::pass_b(p, lds); } SEAM(7);
    if (IN(8)) REP(8) { ph_readout(p); } SEAM(8);
    if (IN(9)) REP(9) {
        pg8::Gemm g{(const bf16_t*)((unsigned char*)p.out + DO_MIX), (const bf16_t*)(ws + WS_WOUT), 1024, 1024}; pg8::DenseOrder S; S.init(ML, 1024, G, bx, GD(9));
        EpiMix E{(bf16_t*)(ws + WS_Y1)}; pg8::gemm_phase(lds, g, S, E); } SEAM(9);
    if (IN(10)) REP(10) { ph_ln1_router(p, lds); } SEAM(10);
    if (IN(11)) REP(11) { ph_topk(p, lds); __syncthreads(); ph_expert_weights(p, lds); } SEAM(11);
    if (IN(12)) REP(12) {
        pg8::Gemm g{(const bf16_t*)(ws + WS_XM2), (const bf16_t*)(ws + WS_WGU), 1024, 1024}; GuOrder S{G, bx, (const int*)(ws + WS_IDX), GD(12)};
        EpiHid E{(bf16_t*)(ws + WS_HID)}; pg8::gemm_phase(lds, g, S, E); } SEAM(12);
    if (IN(13)) REP(13) {
        pg8::Gemm g{(const bf16_t*)(ws + WS_HID), (const bf16_t*)(ws + WS_WD), 1024, 1024}; DnOrder S{G, bx, GD(13)};
        EpiYe E{(bf16_t*)(ws + WS_YE), (const float*)(ws + WS_GATE)}; pg8::gemm_phase(lds, g, S, E); } SEAM(13);
    if (IN(14)) REP(14) { ph_final(p); }
#undef IN
#undef SEAM
}

extern "C" void kernel_launch(void* const* d_in, const int* in_sizes, int n_in, void* d_out, int out_size, void* d_ws, size_t ws_size, hipStream_t stream) {
    static int grid_blocks = 0;
    if (grid_blocks == 0) {
        if (n_in != 32 || out_size != ML * D || ws_size < WS_END) { fprintf(stderr, "kernel_launch: unexpected shapes: n_in %d out %d ws %zu (need %zu)\n", n_in, out_size, ws_size, (size_t)WS_END); grid_blocks = -1; return; }
        int dev = 0, cus = 0, per_cu = 0;
        (void)hipGetDevice(&dev);
        (void)hipDeviceGetAttribute(&cus, hipDeviceAttributeMultiprocessorCount, dev);
        (void)hipFuncSetAttribute((const void*)mega, hipFuncAttributeMaxDynamicSharedMemorySize, LDS_BYTES);
        (void)hipOccupancyMaxActiveBlocksPerMultiprocessor(&per_cu, (const void*)mega, NTHREADS, LDS_BYTES);
        if (per_cu < 1) { fprintf(stderr, "kernel_launch: occupancy query says %d blocks per CU\n", per_cu); grid_blocks = -1; return; }
        grid_blocks = cus;
    }
    if (grid_blocks < 0) return;
    if (hipMemsetAsync((char*)d_ws + WS_CTL, 0, CTL_BYTES, stream) != hipSuccess) { fprintf(stderr, "kernel_launch: memset failed\n"); return; }
    Params p{};
    for (int i = 0; i < 32; ++i) p.in[i] = (const float*)d_in[i];
    p.out = (float*)d_out; p.ws = (unsigned char*)d_ws; p.ph_lo = 0; p.ph_hi = NPHASE;
    void* args[] = {&p};
    hipError_t e = hipLaunchCooperativeKernel((const void*)mega, dim3(grid_blocks), dim3(NTHREADS), args, LDS_BYTES, stream);
    if (e != hipSuccess) fprintf(stderr, "kernel_launch: cooperative launch failed: %s (grid %d)\n", hipGetErrorString(e), grid_blocks);
}
```

```cpp
#include <hip/hip_runtime.h>
#include <hip/hip_cooperative_groups.h>
#include <cstdio>
#include <cstdint>
namespace cg = cooperative_groups;
#ifndef EDUP
#define EDUP 0
#endif
#define ER(k) for (int er_ = 0; er_ <= (((EDUP) >> (k)) & 1); ++er_)

#define LAS __attribute__((address_space(3)))
typedef unsigned short bf16_t;
typedef short bf16x8 __attribute__((ext_vector_type(8)));
typedef short s16x4 __attribute__((ext_vector_type(4)));
typedef float f32x2 __attribute__((ext_vector_type(2)));
typedef float f32x4 __attribute__((ext_vector_type(4)));
typedef float f32x16 __attribute__((ext_vector_type(16)));
typedef unsigned u32x2 __attribute__((ext_vector_type(2)));
typedef unsigned u32x4 __attribute__((ext_vector_type(4)));
typedef _Float16 h16x8 __attribute__((ext_vector_type(8)));
typedef _Float16 h16x4 __attribute__((ext_vector_type(4)));

constexpr int NB = 4, T = 8192, D = 1024, CTX = 256, SKV = T + CTX;
constexpr int ML = NB * T, MC = NB * CTX, MA = ML + MC;
constexpr int NHP = 2560, IN_PROJ = 2496;
constexpr int NE = 16, CAP = 1024, NSLOT = NE * NB * CAP;
constexpr int NTHREADS = 512, NWAVES = 8;
constexpr int LDS_BYTES = 163840;
constexpr int NPHASE = 15;
#ifndef USE_DIRECT_SCAN
#define USE_DIRECT_SCAN 0
#endif
constexpr float LN_EPS = 1e-5f, RMS_EPS = 1e-6f, GN_EPS = 64e-5f;
constexpr float ALPHA = 1.189207115002721f;

constexpr size_t MiB = 1u << 20;
constexpr size_t WS_CTL = 0, CTL_BYTES = 16384;
constexpr size_t WS_MOD = 1 * MiB, WS_RSTDQ = 1 * MiB + 256 * 1024, WS_RSTDKV = 1 * MiB + 512 * 1024;
constexpr size_t WS_WIN = 2 * MiB, WS_WLORA = 7 * MiB, WS_WUQ = 9 * MiB, WS_WUKV = 9 * MiB + 512 * 1024, WS_WOUT = 10 * MiB;
constexpr size_t WS_RN = 12 * MiB;
constexpr size_t WS_H = 16 * MiB;
constexpr size_t SZ_L16 = (size_t)MA * 512 * 2;
constexpr size_t WS_E16 = WS_H, WS_A16 = WS_H + 2 * SZ_L16, WS_G16 = WS_H + 4 * SZ_L16;
constexpr size_t WS_Y1 = 16 * MiB, WS_HID = 16 * MiB;
constexpr size_t WS_WD = 144 * MiB, WS_WGU = 176 * MiB, WS_XM2 = 240 * MiB, WS_YE = 176 * MiB;
constexpr size_t WS_RKV = 181 * MiB;
constexpr size_t WS_XM = 280 * MiB, WS_ACT = 280 * MiB;
constexpr size_t WS_Q = 346 * MiB, WS_K = 394 * MiB, WS_V = 444 * MiB, WS_X1 = 346 * MiB;
constexpr size_t WS_AFF = 478 * MiB, WS_SLOT = 480 * MiB, WS_IDX = 482 * MiB, WS_GATE = 482 * MiB + 512 * 1024;
constexpr size_t WS_QC0 = 280 * MiB, WS_SEG = 314 * MiB, WS_QC1 = 477 * MiB;
constexpr size_t WS_END = 510 * MiB;
constexpr size_t DO_YS = 0, DO_MIX = 64 * MiB;

struct Params { const float* in[32]; float* out; unsigned char* ws; int ph_lo, ph_hi; };
typedef const Params __attribute__((address_space(4)))& KP;
enum { I_X = 0, I_C, I_CTX, I_CCTX, I_WADA, I_BADA, I_WIN, I_CONV, I_W0, I_WUP, I_A0, I_AUP, I_GUP, I_KK, I_KA, I_RK, I_GNG, I_GNB,
       I_QNORM, I_WUQ, I_KVNORM, I_WUK, I_WUV, I_WOUT, I_LN1G, I_LN1B, I_ROUTER, I_EG, I_EU, I_ED, I_LN2G, I_LN2B };

__device__ __forceinline__ unsigned cvt_pk_bf16(float lo, float hi) { unsigned r; asm volatile("v_cvt_pk_bf16_f32 %0, %1, %2" : "=v"(r) : "v"(lo), "v"(hi)); return r; }
typedef __bf16 bf16x2_t __attribute__((ext_vector_type(2)));
__device__ __forceinline__ unsigned cvt_pk_bf16_n(float lo, float hi) { const f32x2 v = {lo, hi}; const bf16x2_t b = __builtin_convertvector(v, bf16x2_t); return __builtin_bit_cast(unsigned, b); }
__device__ __forceinline__ float bf2f(unsigned short b) { return __uint_as_float(((unsigned)b) << 16); }
__device__ __forceinline__ float bflo(unsigned w) { return __uint_as_float(w << 16); }
__device__ __forceinline__ float bfhi(unsigned w) { return __uint_as_float(w & 0xffff0000u); }
template <int CTRL> __device__ __forceinline__ float dppf(float x) { return __int_as_float(__builtin_amdgcn_update_dpp(0, __float_as_int(x), CTRL, 0xF, 0xF, true)); }
template <int CTRL, int ROWMASK> __device__ __forceinline__ float dppm(float x) { return __int_as_float(__builtin_amdgcn_update_dpp(0, __float_as_int(x), CTRL, ROWMASK, 0xF, false)); }
__device__ __forceinline__ float allred16(float x) { x += dppf<0xB1>(x); x += dppf<0x4E>(x); x += dppf<0x141>(x); x += dppf<0x140>(x); return x; }
__device__ __forceinline__ float wave_sum(float v) {
    v = allred16(v);
    { const auto r16 = __builtin_amdgcn_permlane16_swap(__float_as_uint(v), __float_as_uint(v), false, false); v = __uint_as_float(r16[0]) + __uint_as_float(r16[1]); }
    const auto rr = __builtin_amdgcn_permlane32_swap(__float_as_uint(v), __float_as_uint(v), false, false);
    return __uint_as_float(rr[0]) + __uint_as_float(rr[1]);
}
__device__ __forceinline__ float sigmoidf_(float x) { return __builtin_amdgcn_rcpf(1.0f + __builtin_amdgcn_exp2f(-1.4426950408889634f * x)); }
#define LDS_WAIT() asm volatile("s_waitcnt lgkmcnt(0)" ::: "memory")


#define XB_TMO      128
#define XB_XCNT(j)  (256  + 64 * (j))
#define XB_XSUB(j)  (1280 + 64 * (j))
#define XB_XGEN(j)  (2304 + 64 * (j))
#define XB_TOP      3328
#define XB_TOPGEN   3392
#define XCD_BAR_WORDS 3456
#define XB_SPIN_CAP (1u << 18)
__device__ __forceinline__ unsigned xb_ld(unsigned* p)              { return __hip_atomic_load(p, __ATOMIC_RELAXED, __HIP_MEMORY_SCOPE_AGENT); }
__device__ __forceinline__ unsigned xb_add(unsigned* p, unsigned v) { return __hip_atomic_fetch_add(p, v, __ATOMIC_RELAXED, __HIP_MEMORY_SCOPE_AGENT); }
__device__ __forceinline__ unsigned xb_xcc_id() { return (unsigned)__builtin_amdgcn_s_getreg((3 << 11) | 20) & 0xFu; }
#define XB_SPIN(cond, bar) do { unsigned _sp = 0; while (cond) { __builtin_amdgcn_s_sleep(1); \
    if ((++_sp & 255u) == 0u) { if (xb_ld(&(bar)[XB_TMO])) break; if (_sp > XB_SPIN_CAP) { atomicAdd(&(bar)[XB_TMO], 1u); break; } } } } while (0)
struct XcdBarrier { unsigned* bar; unsigned x; volatile LAS unsigned* st; };
__device__ __forceinline__ XcdBarrier xcd_barrier_post(unsigned* bar, volatile LAS unsigned* st) {
    XcdBarrier b; b.bar = bar; b.x = xb_xcc_id(); b.st = st;
    if (threadIdx.x == 0) (void)xb_add(&bar[XB_XCNT(b.x)], 1u);
    return b;
}
__device__ __forceinline__ void xcd_barrier_complete(unsigned* bar, unsigned x, unsigned& nloc, unsigned& nx) {
    const unsigned G = gridDim.x * gridDim.y * gridDim.z;
    unsigned sum, cnt, mine, sp = 0u;
    for (;;) {
        sum = 0u; cnt = 0u; mine = 0u;
#pragma unroll
        for (unsigned j = 0; j < 16; ++j) { const unsigned c = xb_ld(&bar[XB_XCNT(j)]); sum += c; cnt += (c > 0u) ? 1u : 0u; mine = (j == x) ? c : mine; }
        if (sum == G) break;
        __builtin_amdgcn_s_sleep(1);
        if ((++sp & 255u) == 0u) { if (xb_ld(&bar[XB_TMO])) break; if (sp > XB_SPIN_CAP) { atomicAdd(&bar[XB_TMO], 1u); break; } }
    }
    nloc = mine > 0u ? mine : 1u; nx = cnt > 0u ? cnt : 1u;
}
__device__ __forceinline__ void xcd_barrier(const XcdBarrier& b) {
    asm volatile("s_waitcnt vmcnt(0)" ::: "memory");
    __syncthreads();
    if (threadIdx.x == 0) {
        unsigned* bar = b.bar;
        __builtin_amdgcn_s_waitcnt(0);
        unsigned nloc = b.st[0], nx = b.st[1];
        if (nloc == 0u) { xcd_barrier_complete(bar, b.x, nloc, nx); b.st[0] = nloc; b.st[1] = nx; }
        const unsigned old = xb_add(&bar[XB_XSUB(b.x)], 1u);
        const unsigned gen = old / nloc;
        if (old + 1u == (gen + 1u) * nloc) {
            __builtin_amdgcn_fence(__ATOMIC_RELEASE, "agent");
            asm volatile("s_waitcnt vmcnt(0)" ::: "memory");
            const unsigned og = xb_add(&bar[XB_TOP], 1u);
            const unsigned tg = og / nx;
            if (og + 1u == (tg + 1u) * nx) xb_add(&bar[XB_TOPGEN], 1u);
            else XB_SPIN(xb_ld(&bar[XB_TOPGEN]) == tg, bar);
            __builtin_amdgcn_fence(__ATOMIC_ACQUIRE, "agent");
            xb_add(&bar[XB_XGEN(b.x)], 1u);
            asm volatile("s_waitcnt vmcnt(0)" ::: "memory");
        } else {
            XB_SPIN(xb_ld(&bar[XB_XGEN(b.x)]) == gen, bar);
            __builtin_amdgcn_fence(__ATOMIC_ACQUIRE, "agent");
            asm volatile("s_waitcnt vmcnt(0)" ::: "memory");
        }
    }
    __syncthreads();
}

namespace pg8 {
constexpr int BM = 256, BK = 64, HALF = 128, HTB = HALF * BK * 2, STAGE_BYTES = 8 * HTB;
__device__ __forceinline__ int lds_byte(int r, int c) { const int st = (r >> 4) * 2 + (c >> 5), rr = r & 15, cc = c & 31, ob = rr * 64 + cc * 2; return st * 1024 + (ob ^ (((ob >> 9) & 1) << 5)); }
__device__ __forceinline__ void stage_rc(int b, int& R, int& C) { const int st = b / 1024, sb = b % 1024, swz = sb ^ (((sb >> 9) & 1) << 5); R = (st >> 1) * 16 + swz / 64; C = (st & 1) * 32 + (swz % 64) / 2; }
__device__ __forceinline__ int perm32(int rho) { const int n = rho >> 4, i = rho & 15; return 8 * (i >> 2) + 4 * n + (i & 3); }
struct Unit { int pm, pn; };
struct Gemm { const bf16_t* A; const bf16_t* Bt; int K, lda; };

struct DenseOrder {
    int nM, nN, nwg, G, c, dupf;
    __device__ void init(int M, int N, int G_, int c_, int dupf_ = 1) { nM = M / BM; nN = N / BM; nwg = nM * nN; G = G_; c = c_; dupf = dupf_; }
    __device__ bool next(int i, Unit& u) const {
        const long L = (long)i * G + c; if (L >= (long)nwg * dupf) return false;
        int wgid = (int)(L % nwg); { const int q = nwg / 8, r = nwg % 8, xcd = wgid % 8, off = wgid / 8; wgid = (xcd < r ? xcd * (q + 1) : r * (q + 1) + (xcd - r) * q) + off; }
        const int nig = 8 * nN, gid = wgid / nig, fm = gid * 8, gsz = (nM - fm) < 8 ? (nM - fm) : 8;
        u.pm = fm + ((wgid % nig) % gsz); u.pn = (wgid % nig) / gsz; return true;
    }
    __device__ __forceinline__ int arow(const Unit& u, int r) const { return u.pm * BM + r; }
    __device__ __forceinline__ int acol(const Unit&) const { return 0; }
};
struct LoraOrder : DenseOrder { __device__ __forceinline__ int acol(const Unit& u) const { return u.pn < 4 ? 0 : (u.pn < 8 ? 128 : 256); } };

template <class Epi, class Sched>
__device__ __forceinline__ void gemm_phase(LAS unsigned char* lds, const Gemm g, const Sched& S, const Epi& E) {
    const int tid = threadIdx.x, wid = __builtin_amdgcn_readfirstlane(tid >> 6), lane = tid & 63, wr = wid >> 2, wc = wid & 3, fr = lane & 15, fq = lane >> 4;
    int K = g.K; asm volatile("" : "+s"(K));
    const int nt = K / BK;
    int Rr[2], Cc[2]; unsigned voffB[2];
#pragma unroll
    for (int i = 0; i < 2; ++i) { int R, C; stage_rc(tid * 16 + i * 8192, R, C); Rr[i] = R; Cc[i] = C; const int Rb = Epi::PERM ? ((R & ~31) + perm32(R & 31)) : R; voffB[i] = (unsigned)(Rb * K + C) * 2u; }
    const size_t kstep = (size_t)(BK * 2);
    const size_t hstepB = (size_t)HALF * K * 2, tstepB = 2 * hstepB;
    const unsigned ldsw = (unsigned)wid * 1024u;
    const int aoff = lds_byte(wr * 64 + fr, fq * 8), boff = lds_byte(wc * 32 + fr, fq * 8);
#define PG8_SA(b, h) (((b) * 2 + (h)) * HTB)
#define PG8_SB(b, h) ((4 + (b) * 2 + (h)) * HTB)
#define PG8_STAGE(bufoff, gbase, voff) do { _Pragma("unroll") for (int _i = 0; _i < 2; ++_i) \
        __builtin_amdgcn_global_load_lds((const unsigned*)((const char*)(gbase) + (voff)[_i]), (LAS unsigned*)(lds + (bufoff) + ldsw + _i * 8192), 16, 0, 0); } while (0)
#define PG8_LDA(dst, b, h) do { _Pragma("unroll") for (int m = 0; m < 4; ++m) _Pragma("unroll") for (int k = 0; k < 2; ++k) dst[m][k] = *(const LAS bf16x8*)(lds + PG8_SA(b, h) + aoff + m * 2048 + k * 1024); } while (0)
#define PG8_LDB(dst, b, h) do { _Pragma("unroll") for (int n = 0; n < 2; ++n) _Pragma("unroll") for (int k = 0; k < 2; ++k) dst[n][k] = *(const LAS bf16x8*)(lds + PG8_SB(b, h) + boff + n * 2048 + k * 1024); } while (0)
#define PG8_MMA(ai, bj, At, Bt) do { __builtin_amdgcn_s_setprio(1); _Pragma("unroll") for (int m = 0; m < 4; ++m) _Pragma("unroll") for (int n = 0; n < 2; ++n) _Pragma("unroll") for (int k = 0; k < 2; ++k) \
        acc[ai][bj][m][n] = __builtin_amdgcn_mfma_f32_16x16x32_bf16(Bt[n][k], At[m][k], acc[ai][bj][m][n], 0, 0, 0); __builtin_amdgcn_s_setprio(0); } while (0)
#define PG8_WAIT_V(n) asm volatile("s_waitcnt vmcnt(" #n ")" ::: "memory")
#define PG8_WAIT_L(n) asm volatile("s_waitcnt lgkmcnt(" #n ")" ::: "memory")
#define PG8_BAR __builtin_amdgcn_s_barrier()
#define PG8_SCHED __builtin_amdgcn_sched_barrier(0)
#define PG8_LOADVO(dst, u) do { _Pragma("unroll") for (int _h = 0; _h < 2; ++_h) _Pragma("unroll") for (int _i = 0; _i < 2; ++_i) \
        dst[_h][_i] = ((unsigned)S.arow(u, _h * HALF + Rr[_i]) * (unsigned)g.lda + (unsigned)Cc[_i] + (unsigned)S.acol(u)) * 2u; } while (0)
    Unit cur, nxt; int ui = 0;
    if (!S.next(0, cur)) return;
    f32x4 acc[2][2][4][2];
#pragma unroll
    for (int a = 0; a < 2; ++a)
#pragma unroll
        for (int b = 0; b < 2; ++b)
#pragma unroll
            for (int m = 0; m < 4; ++m)
#pragma unroll
                for (int n = 0; n < 2; ++n) acc[a][b][m][n] = (f32x4){0.f, 0.f, 0.f, 0.f};
    bf16x8 At[4][2], B0[2][2], B1[2][2];
    unsigned voA[2][2], voN[2][2];
    PG8_LOADVO(voA, cur);
    const char* Ab = (const char*)g.A;
    const char* cB = (const char*)g.Bt + (size_t)cur.pn * tstepB;
    PG8_STAGE(PG8_SB(0, 0), cB, voffB); PG8_STAGE(PG8_SA(0, 0), Ab, voA[0]); PG8_STAGE(PG8_SB(0, 1), cB + hstepB, voffB); PG8_STAGE(PG8_SA(0, 1), Ab, voA[1]);
    if (wr == 1) PG8_BAR;
    PG8_WAIT_V(4); PG8_BAR;
    PG8_STAGE(PG8_SB(1, 0), cB + kstep, voffB); PG8_STAGE(PG8_SA(1, 0), Ab + kstep, voA[0]); PG8_STAGE(PG8_SB(1, 1), cB + hstepB + kstep, voffB);
    PG8_WAIT_V(6); PG8_BAR;
    for (;;) {
        const bool has_next = S.next(ui + 1, nxt);
        if (has_next) { PG8_LOADVO(voN, nxt); }
        else {
#pragma unroll
            for (int h = 0; h < 2; ++h)
#pragma unroll
                for (int i = 0; i < 2; ++i) voN[h][i] = voA[h][i]; }
        const char* nB = has_next ? (const char*)g.Bt + (size_t)nxt.pn * tstepB : cB;
#pragma unroll 1
        for (int t = 0; t < nt; t += 2) {
            const bool last = (t == nt - 2);
            const char* a1 = Ab + (size_t)(t + 1) * kstep;
            const char* a2 = last ? Ab : Ab + (size_t)(t + 2) * kstep; const char* b2 = last ? nB : cB + (size_t)(t + 2) * kstep;
            const char* a3 = a2 + kstep; const char* b3 = b2 + kstep;
            unsigned o2[2][2];
#pragma unroll
            for (int h = 0; h < 2; ++h)
#pragma unroll
                for (int i = 0; i < 2; ++i) o2[h][i] = last ? voN[h][i] : voA[h][i];
            PG8_LDB(B0, 0, 0); PG8_SCHED; PG8_LDA(At, 0, 0); PG8_STAGE(PG8_SA(1, 1), a1, voA[1]);
            PG8_WAIT_L(8); PG8_BAR; PG8_WAIT_L(0); PG8_MMA(0, 0, At, B0); PG8_BAR; PG8_SCHED;
            PG8_LDB(B1, 0, 1); PG8_STAGE(PG8_SB(0, 0), b2, voffB);
            PG8_BAR; PG8_WAIT_L(0); PG8_MMA(0, 1, At, B1); PG8_BAR;
            PG8_LDA(At, 0, 1); PG8_STAGE(PG8_SA(0, 0), a2, o2[0]);
            PG8_BAR; PG8_WAIT_L(0); PG8_MMA(1, 0, At, B0); PG8_BAR; PG8_SCHED;
            PG8_STAGE(PG8_SB(0, 1), b2 + hstepB, voffB);
            PG8_WAIT_V(6); PG8_BAR; PG8_MMA(1, 1, At, B1); PG8_BAR;
            PG8_LDB(B0, 1, 0); PG8_SCHED; PG8_LDA(At, 1, 0); PG8_STAGE(PG8_SA(0, 1), a2, o2[1]);
            PG8_WAIT_L(8); PG8_BAR; PG8_WAIT_L(0); PG8_MMA(0, 0, At, B0); PG8_BAR; PG8_SCHED;
            PG8_LDB(B1, 1, 1); PG8_STAGE(PG8_SB(1, 0), b3, voffB);
            PG8_BAR; PG8_WAIT_L(0); PG8_MMA(0, 1, At, B1); PG8_BAR;
            PG8_LDA(At, 1, 1); PG8_STAGE(PG8_SA(1, 0), a3, o2[0]);
            PG8_BAR; PG8_WAIT_L(0); PG8_MMA(1, 0, At, B0); PG8_BAR; PG8_SCHED;
            PG8_STAGE(PG8_SB(1, 1), b3 + hstepB, voffB);
            PG8_WAIT_V(6); PG8_BAR; PG8_MMA(1, 1, At, B1); PG8_BAR;
        }
        { int fr_ = fr, fq_ = fq; asm volatile("" : "+v"(fr_), "+v"(fq_)); E(acc, cur, wr, wc, fr_, fq_); }
        if (!has_next) break;
#pragma unroll
        for (int a = 0; a < 2; ++a)
#pragma unroll
            for (int b = 0; b < 2; ++b)
#pragma unroll
                for (int m = 0; m < 4; ++m)
#pragma unroll
                    for (int n = 0; n < 2; ++n) acc[a][b][m][n] = (f32x4){0.f, 0.f, 0.f, 0.f};
        cur = nxt; cB = nB; ++ui;
#pragma unroll
        for (int h = 0; h < 2; ++h)
#pragma unroll
            for (int i = 0; i < 2; ++i) voA[h][i] = voN[h][i];
    }
    PG8_WAIT_V(0);
    if (wr == 0) PG8_BAR;
    PG8_BAR;
#undef PG8_SA
#undef PG8_SB
#undef PG8_STAGE
#undef PG8_LDA
#undef PG8_LDB
#undef PG8_MMA
#undef PG8_WAIT_V
#undef PG8_WAIT_L
#undef PG8_BAR
#undef PG8_SCHED
#undef PG8_LOADVO
}
}
using pg8::Unit;

typedef const f32x4 (&AccRef)[2][2][4][2];

struct EpiH {
    static constexpr bool PERM = true; bf16_t* O;
    __device__ __forceinline__ void operator()(AccRef acc, const Unit& u, int wr, int wc, int fr, int fq) const {
        const int row0 = u.pm * 256 + wr * 64 + fr, col0 = u.pn * 256 + wc * 32 + 8 * fq;
#pragma unroll
        for (int ai = 0; ai < 2; ++ai)
#pragma unroll
            for (int m = 0; m < 4; ++m) { bf16_t* rowp = O + (size_t)(row0 + ai * 128 + m * 16) * NHP + col0;
#pragma unroll
                for (int bj = 0; bj < 2; ++bj) { const f32x4 v0 = acc[ai][bj][m][0], v1 = acc[ai][bj][m][1];
                    u32x4 w; w.x = cvt_pk_bf16(v0[0], v0[1]); w.y = cvt_pk_bf16(v0[2], v0[3]); w.z = cvt_pk_bf16(v1[0], v1[1]); w.w = cvt_pk_bf16(v1[2], v1[3]);
                    *(u32x4*)(rowp + bj * 128) = w; } }
    }
};

__device__ __forceinline__ float rope_invfreq(int j) { return __builtin_amdgcn_exp2f(-(float)(2 * j) * (13.287712379549449f / 32.0f)) * 0.15915494309189535f; }

struct EpiQ {
    static constexpr bool PERM = false; bf16_t* Q; const float* rstd;
    __device__ __forceinline__ void operator()(AccRef acc, const Unit& u, int wr, int wc, int fr, int fq) const {
        const int row0 = u.pm * 256 + wr * 64 + fr;
        float fr4[4];
#pragma unroll
        for (int i = 0; i < 4; ++i) fr4[i] = rope_invfreq(4 * fq + i);
#pragma unroll
        for (int ai = 0; ai < 2; ++ai)
#pragma unroll
            for (int m = 0; m < 4; ++m) {
                const int row = row0 + ai * 128 + m * 16; const int b = row >> 13, t = row & (T - 1);
                const float rs = rstd[row];
#pragma unroll
                for (int bj = 0; bj < 2; ++bj) {
                    const int cgp = u.pn * 8 + bj * 4 + wc;
                    const int head = cgp / 6, wg = cgp - head * 6;
                    bf16_t* qp = Q + ((size_t)(b * 4 + head) * T + t) * 192 + wg * 32 + 4 * fq;
                    f32x4 x1 = acc[ai][bj][m][0] * rs, x2 = acc[ai][bj][m][1] * rs;
                    if (wg >= 4) {
                        const float pos = (float)(wg == 4 ? (t >> 6) : (t & 63));
#pragma unroll
                        for (int i = 0; i < 4; ++i) { float rev = pos * fr4[i]; rev = rev - floorf(rev);
                            const float sn = __builtin_amdgcn_sinf(rev), cs = __builtin_amdgcn_cosf(rev);
                            const float a = x1[i], bb = x2[i]; x1[i] = a * cs - bb * sn; x2[i] = bb * cs + a * sn; }
                    }
                    u32x2 w0, w1; w0.x = cvt_pk_bf16(x1[0], x1[1]); w0.y = cvt_pk_bf16(x1[2], x1[3]); w1.x = cvt_pk_bf16(x2[0], x2[1]); w1.y = cvt_pk_bf16(x2[2], x2[3]);
                    *(u32x2*)qp = w0; *(u32x2*)(qp + 16) = w1;
                }
                asm volatile("" ::: "memory");
            }
    }
};

struct EpiKV {
    static constexpr bool PERM = true; bf16_t* Kb; bf16_t* Vb; const float* rstd;
    __device__ __forceinline__ void operator()(AccRef acc, const Unit& u, int wr, int wc, int fr, int fq) const {
        const int row0 = u.pm * 256 + wr * 64 + fr; const bool isv = u.pn >= 2; const int c0 = wc * 32 + 8 * fq;
#pragma unroll
        for (int ai = 0; ai < 2; ++ai)
#pragma unroll
            for (int m = 0; m < 4; ++m) {
                const int row = row0 + ai * 128 + m * 16; int b, key;
                if (row < ML) { b = row >> 13; key = CTX + (row & (T - 1)); } else { const int rc = row - ML; b = rc >> 8; key = rc & (CTX - 1); }
                const float rs = rstd[row];
#pragma unroll
                for (int bj = 0; bj < 2; ++bj) { const int head = ((u.pn & 1) << 1) + bj;
                    const f32x4 v0 = acc[ai][bj][m][0] * rs, v1 = acc[ai][bj][m][1] * rs;
                    u32x4 w; w.x = cvt_pk_bf16(v0[0], v0[1]); w.y = cvt_pk_bf16(v0[2], v0[3]); w.z = cvt_pk_bf16(v1[0], v1[1]); w.w = cvt_pk_bf16(v1[2], v1[3]);
                    const size_t kr = (size_t)(b * 4 + head) * SKV + key;
                    if (isv) *(u32x4*)(Vb + kr * 128 + c0) = w; else *(u32x4*)(Kb + kr * 192 + c0) = w; }
                asm volatile("" ::: "memory");
            }
    }
};

struct EpiLora {
    static constexpr bool PERM = true; _Float16* E16; _Float16* A16; _Float16* G16; const float* w0; const float* a0;
    __device__ __forceinline__ void operator()(AccRef acc, const Unit& u, int wr, int wc, int fr, int fq) const {
        const int row0 = u.pm * 256 + wr * 64 + fr; const int type = u.pn >> 1, dir = type & 1;
        _Float16* dst = type < 2 ? E16 + (size_t)dir * MA * 512 : (type < 4 ? A16 + (size_t)dir * MA * 512 : G16);
        const float* bias = type < 2 ? w0 + dir * 512 : a0 + dir * 512;
#pragma unroll
        for (int bj = 0; bj < 2; ++bj) { const int ch = (u.pn & 1) * 256 + bj * 128 + wc * 32 + 8 * fq;
            f32x4 b0 = {0.f, 0.f, 0.f, 0.f}, b1 = {0.f, 0.f, 0.f, 0.f};
            if (type < 4) { b0 = *(const f32x4*)(bias + ch); b1 = *(const f32x4*)(bias + ch + 4); }
#pragma unroll
            for (int ai = 0; ai < 2; ++ai)
#pragma unroll
                for (int m = 0; m < 4; ++m) { const int row = row0 + ai * 128 + m * 16;
                    f32x4 v0 = acc[ai][bj][m][0] + b0, v1 = acc[ai][bj][m][1] + b1;
                    if (type < 4) {
                        const float sc = type < 2 ? 0.8750387749145276f : 1.0f;
#pragma unroll
                        for (int i = 0; i < 4; ++i) { v0[i] = sc * sigmoidf_(v0[i]); v1[i] = sc * sigmoidf_(v1[i]); } }
                    h16x8 o; o[0] = (_Float16)v0[0]; o[1] = (_Float16)v0[1]; o[2] = (_Float16)v0[2]; o[3] = (_Float16)v0[3]; o[4] = (_Float16)v1[0]; o[5] = (_Float16)v1[1]; o[6] = (_Float16)v1[2]; o[7] = (_Float16)v1[3];
                    *(h16x8*)(dst + (size_t)row * 512 + ch) = o; asm volatile("" ::: "memory"); } }
    }
};

struct EpiMix {
    static constexpr bool PERM = true; bf16_t* O;
    __device__ __forceinline__ void operator()(AccRef acc, const Unit& u, int wr, int wc, int fr, int fq) const {
        const int row0 = u.pm * 256 + wr * 64 + fr, col0 = u.pn * 256 + wc * 32 + 8 * fq;
#pragma unroll
        for (int ai = 0; ai < 2; ++ai)
#pragma unroll
            for (int m = 0; m < 4; ++m) { bf16_t* rowp = O + (size_t)(row0 + ai * 128 + m * 16) * D + col0;
#pragma unroll
                for (int bj = 0; bj < 2; ++bj) { const f32x4 v0 = acc[ai][bj][m][0], v1 = acc[ai][bj][m][1];
                    u32x4 w; w.x = cvt_pk_bf16(v0[0], v0[1]); w.y = cvt_pk_bf16(v0[2], v0[3]); w.z = cvt_pk_bf16(v1[0], v1[1]); w.w = cvt_pk_bf16(v1[2], v1[3]);
                    *(u32x4*)(rowp + bj * 128) = w; } }
    }
};

struct EpiHid {
    static constexpr bool PERM = true; bf16_t* Hd;
    __device__ __forceinline__ void operator()(AccRef acc, const Unit& u, int wr, int wc, int fr, int fq) const {
        const int row0 = u.pm * 256 + wr * 64 + fr, col0 = (u.pn & 7) * 128 + wc * 32 + 8 * fq;
#pragma unroll
        for (int ai = 0; ai < 2; ++ai)
#pragma unroll
            for (int m = 0; m < 4; ++m) {
                f32x4 v0, v1;
#pragma unroll
                for (int i = 0; i < 4; ++i) { const float g0 = acc[ai][0][m][0][i], g1 = acc[ai][0][m][1][i];
                    v0[i] = g0 * sigmoidf_(g0) * acc[ai][1][m][0][i]; v1[i] = g1 * sigmoidf_(g1) * acc[ai][1][m][1][i]; }
                u32x4 w; w.x = cvt_pk_bf16(v0[0], v0[1]); w.y = cvt_pk_bf16(v0[2], v0[3]); w.z = cvt_pk_bf16(v1[0], v1[1]); w.w = cvt_pk_bf16(v1[2], v1[3]);
                *(u32x4*)(Hd + (size_t)(row0 + ai * 128 + m * 16) * 1024 + col0) = w; }
    }
};

struct EpiYe {
    static constexpr bool PERM = true; bf16_t* Ye; const float* gate;
    __device__ __forceinline__ void operator()(AccRef acc, const Unit& u, int wr, int wc, int fr, int fq) const {
        const int row0 = u.pm * 256 + wr * 64 + fr, col0 = (u.pn & 3) * 256 + wc * 32 + 8 * fq;
#pragma unroll
        for (int ai = 0; ai < 2; ++ai)
#pragma unroll
            for (int m = 0; m < 4; ++m) { const int row = row0 + ai * 128 + m * 16; const float gt = gate[row];
#pragma unroll
                for (int bj = 0; bj < 2; ++bj) { const f32x4 v0 = acc[ai][bj][m][0] * gt, v1 = acc[ai][bj][m][1] * gt;
                    u32x4 w; w.x = cvt_pk_bf16(v0[0], v0[1]); w.y = cvt_pk_bf16(v0[2], v0[3]); w.z = cvt_pk_bf16(v1[0], v1[1]); w.w = cvt_pk_bf16(v1[2], v1[3]);
                    *(u32x4*)(Ye + (size_t)row * 1024 + col0 + bj * 128) = w; } }
    }
};

struct GuOrder {
    int G, c; const int* idx; int dupf;
    __device__ bool next(int i, Unit& u) const { long L = (long)i * G + c; if (L >= 2048L * dupf) return false; L &= 2047;
        const int e = (int)L >> 7, w = (int)L & 127;
        const int xc = w & 7, k = w >> 3; u.pn = e * 8 + (xc & 3) * 2 + (k & 1); u.pm = e * 16 + (xc >> 2) * 8 + (k >> 1); return true; }
    __device__ __forceinline__ int arow(const Unit& u, int r) const { return ((u.pm >> 2) & 3) * T + idx[u.pm * 256 + r]; }
    __device__ __forceinline__ int acol(const Unit&) const { return 0; }
};
struct DnOrder {
    int G, c, dupf;
    __device__ bool next(int i, Unit& u) const { long L = (long)i * G + c; if (L >= 1024L * dupf) return false; L &= 1023;
        const int e = (int)L >> 6, w = (int)L & 63; u.pm = e * 16 + (w >> 2); u.pn = e * 4 + (w & 3); return true; }
    __device__ __forceinline__ int arow(const Unit& u, int r) const { return u.pm * 256 + r; }
    __device__ __forceinline__ int acol(const Unit&) const { return 0; }
};

namespace att {
constexpr int DQK = 192, DV = 128, KVBLK = 64, QBLK = 32;
constexpr float SCALE = 0.07216878364870322f;
constexpr float THR = 8.f;
constexpr int KPITCH = 400;
constexpr int SHM_V = KVBLK * DV * 2, SHM_K = KVBLK * KPITCH;
constexpr int SHM_ATTN = 2 * SHM_V + 2 * SHM_K + NWAVES * 64 * 4;
#define SBAR() __builtin_amdgcn_sched_barrier(0)
__device__ __forceinline__ int crow(int r, int hi) { return (r & 3) + 8 * (r >> 2) + 4 * hi; }
__device__ __forceinline__ void partialSM(f32x16& p0, f32x16& p1, float& m_reg, float& mn, float& alpha) {
    constexpr float C = SCALE * 1.4426950408889634f;
    float pmax = p0[0];
#pragma unroll
    for (int r = 1; r < 16; ++r) pmax = fmaxf(pmax, p0[r]);
#pragma unroll
    for (int r = 0; r < 16; ++r) pmax = fmaxf(pmax, p1[r]);
    { auto rr = __builtin_amdgcn_permlane32_swap(__float_as_uint(pmax), __float_as_uint(pmax), false, false);
      pmax = fmaxf(__uint_as_float(rr[0]), __uint_as_float(rr[1])); }
    if (__builtin_expect(__all(pmax - m_reg <= THR / SCALE), 1)) { mn = m_reg; alpha = 1.f; }
    else { mn = fmaxf(m_reg, pmax); alpha = __builtin_amdgcn_exp2f((m_reg - mn) * C); m_reg = mn; }
    const float mnC = -mn * C;
#pragma unroll
    for (int r = 0; r < 16; ++r) p0[r] = fmaf(p0[r], C, mnC);
#pragma unroll
    for (int r = 0; r < 16; ++r) p1[r] = fmaf(p1[r], C, mnC);
#pragma unroll
    for (int r = 0; r < 16; ++r) p0[r] = __builtin_amdgcn_exp2f(p0[r]);
}
__device__ __forceinline__ void finishSM(f32x16& p0, f32x16& p1, float alpha, float& l_reg, bf16x8& pa0, bf16x8& pa1, bf16x8& pa2, bf16x8& pa3) {
#pragma unroll
    for (int r = 0; r < 16; ++r) p1[r] = __builtin_amdgcn_exp2f(p1[r]);
    float ps = 0;
#pragma unroll
    for (int r = 0; r < 16; ++r) ps += p0[r];
#pragma unroll
    for (int r = 0; r < 16; ++r) ps += p1[r];
    { auto rr = __builtin_amdgcn_permlane32_swap(__float_as_uint(ps), __float_as_uint(ps), false, false);
      ps = __uint_as_float(rr[0]) + __uint_as_float(rr[1]); }
    l_reg = l_reg * alpha + ps;
#define PK4(P, BASE, OUT) do { unsigned a0 = cvt_pk_bf16(P[BASE + 0], P[BASE + 1]), a1 = cvt_pk_bf16(P[BASE + 2], P[BASE + 3]);   \
    unsigned b0 = cvt_pk_bf16(P[BASE + 4], P[BASE + 5]), b1 = cvt_pk_bf16(P[BASE + 6], P[BASE + 7]);                              \
    auto r0 = __builtin_amdgcn_permlane32_swap(a0, b0, false, false); auto r1 = __builtin_amdgcn_permlane32_swap(a1, b1, false, false); \
    u32x4 w = {r0[0], r1[0], r0[1], r1[1]}; OUT = *reinterpret_cast<bf16x8*>(&w); } while (0)
    PK4(p0, 0, pa0); PK4(p0, 8, pa1); PK4(p1, 0, pa2); PK4(p1, 8, pa3);
#undef PK4
}
__device__ __forceinline__ void qkt(f32x16& p0, f32x16& p1, const char* Ks, const bf16x8* qr, int r32, int hi) {
    p0 = f32x16{}; p1 = f32x16{};
#pragma unroll
    for (int d0 = 0; d0 < 12; ++d0) { const int cb = d0 * 32 + hi * 16;
        const bf16x8 b0 = *reinterpret_cast<const bf16x8*>(Ks + r32 * KPITCH + cb);
        const bf16x8 b1 = *reinterpret_cast<const bf16x8*>(Ks + (32 + r32) * KPITCH + cb);
        p0 = __builtin_amdgcn_mfma_f32_32x32x16_bf16(b0, qr[d0], p0, 0, 0, 0);
        p1 = __builtin_amdgcn_mfma_f32_32x32x16_bf16(b1, qr[d0], p1, 0, 0, 0); }
}
__device__ __forceinline__ int v_st(int k, int c) { const int kk = (k & ~0xC) | ((k & 4) << 1) | ((k & 8) >> 1); return ((kk >> 3) * 4 + (c >> 5)) * 512 + ((kk & 7) * 32 + (c & 31)) * 2; }
__device__ __forceinline__ int v_rd_base(int lane) { return ((lane & 3) << 3) | (((lane >> 2) & 3) << 6) | (((lane >> 4) & 1) << 5) | (((lane >> 5) & 1) << 8); }
constexpr int v_rd_off(int d0, int ks, int half) { return d0 * 512 + ks * 4096 + half * 2048; }
template <int OFF> __device__ __forceinline__ s16x4 tr_read(int vb) {
    s16x4 r; asm volatile("ds_read_b64_tr_b16 %0, %1 offset:%2" : "=&v"(r) : "v"(vb), "i"(OFF) : "memory"); return r;
}
template <int D0> __device__ __forceinline__ void pv_one(f32x16& od, int vb, bf16x8 pa0, bf16x8 pa1, bf16x8 pa2, bf16x8 pa3) {
    const s16x4 l0 = tr_read<v_rd_off(D0, 0, 0)>(vb), h0 = tr_read<v_rd_off(D0, 0, 1)>(vb), l1 = tr_read<v_rd_off(D0, 1, 0)>(vb), h1 = tr_read<v_rd_off(D0, 1, 1)>(vb);
    const s16x4 l2 = tr_read<v_rd_off(D0, 2, 0)>(vb), h2 = tr_read<v_rd_off(D0, 2, 1)>(vb), l3 = tr_read<v_rd_off(D0, 3, 0)>(vb), h3 = tr_read<v_rd_off(D0, 3, 1)>(vb);
    asm volatile("s_waitcnt lgkmcnt(0)" ::: "memory"); SBAR();
#define PK(L, H) (bf16x8){L[0], L[1], L[2], L[3], H[0], H[1], H[2], H[3]}
    od = __builtin_amdgcn_mfma_f32_32x32x16_bf16(pa0, PK(l0, h0), od, 0, 0, 0);
    od = __builtin_amdgcn_mfma_f32_32x32x16_bf16(pa1, PK(l1, h1), od, 0, 0, 0);
    od = __builtin_amdgcn_mfma_f32_32x32x16_bf16(pa2, PK(l2, h2), od, 0, 0, 0);
    od = __builtin_amdgcn_mfma_f32_32x32x16_bf16(pa3, PK(l3, h3), od, 0, 0, 0);
#undef PK
}
__device__ __forceinline__ void pv_d0(f32x16* o, int vb, bf16x8 pa0, bf16x8 pa1, bf16x8 pa2, bf16x8 pa3) {
    pv_one<0>(o[0], vb, pa0, pa1, pa2, pa3); pv_one<1>(o[1], vb, pa0, pa1, pa2, pa3); pv_one<2>(o[2], vb, pa0, pa1, pa2, pa3); pv_one<3>(o[3], vb, pa0, pa1, pa2, pa3);
}
__device__ __forceinline__ void attn_unit(const bf16_t* __restrict__ Qb, const bf16_t* __restrict__ Kh, const bf16_t* __restrict__ Vh, bf16_t* __restrict__ Ob, char* lds) {
    const int tid = threadIdx.x, wid = __builtin_amdgcn_readfirstlane(tid >> 6), lane = tid & 63, r32 = lane & 31, hi = lane >> 5;
    char* V_lds = lds; char* K_lds = lds + 2 * SHM_V;
    float* ws = (float*)(lds + 2 * SHM_V + 2 * SHM_K) + wid * 64; float* li_l = ws; float* al_l = ws + 32;
    float m_reg = -1e30f, l_reg = 0; f32x16 o[4] = {}; bf16x8 qr[12];
    const bf16_t* Qw = Qb + (size_t)(wid * QBLK + r32) * DQK + hi * 8;
#pragma unroll
    for (int d0 = 0; d0 < 12; ++d0) qr[d0] = *reinterpret_cast<const bf16x8*>(Qw + d0 * 16);
    const int sr = tid >> 4, sc = (tid & 15) * 8, vst0 = v_st(sr, sc);
    const int kd0 = tid * 16 + 16 * (tid / 24), kd1 = (tid + 512) * 16 + 16 * ((tid + 512) / 24), kd2 = (tid + 1024) * 16 + 16 * ((tid + 1024) / 24);
    const char* Kg = (const char*)Kh + tid * 16; const char* Vg = (const char*)Vh + tid * 16;
    const int vb0 = (int)(uintptr_t)V_lds + v_rd_base(lane);
    bf16x8 vs0, vs1, ks0, ks1, ks2;
#define SLOAD(k0) do { const char* vp = Vg + (size_t)(k0) * (DV * 2); const char* kp = Kg + (size_t)(k0) * (DQK * 2); \
    vs0 = *reinterpret_cast<const bf16x8*>(vp); vs1 = *reinterpret_cast<const bf16x8*>(vp + 8192); \
    ks0 = *reinterpret_cast<const bf16x8*>(kp); ks1 = *reinterpret_cast<const bf16x8*>(kp + 8192); ks2 = *reinterpret_cast<const bf16x8*>(kp + 16384); } while (0)
#define SWRITE(b) do { *(bf16x8*)(V_lds + (b) * SHM_V + vst0) = vs0; *(bf16x8*)(V_lds + (b) * SHM_V + vst0 + 8192) = vs1; \
    *(bf16x8*)(K_lds + (b) * SHM_K + kd0) = ks0; *(bf16x8*)(K_lds + (b) * SHM_K + kd1) = ks1; *(bf16x8*)(K_lds + (b) * SHM_K + kd2) = ks2; } while (0)
#define SWAIT() asm volatile("s_waitcnt vmcnt(0)" ::: "memory")
#define RESC(a) do { if (__any((a) < 1.f)) { if (hi == 0) al_l[r32] = (a); asm volatile("s_waitcnt lgkmcnt(0)" ::: "memory"); \
    _Pragma("unroll") for (int d = 0; d < 4; ++d) _Pragma("unroll") for (int r = 0; r < 16; ++r) o[d][r] *= al_l[crow(r, hi)]; } } while (0)
    f32x16 pA0, pA1, pB0, pB1; float mnA, mnB, alA, alB; bf16x8 pa0, pa1, pa2, pa3; constexpr int NT = SKV / KVBLK;
    SLOAD(0); SWAIT(); SWRITE(0); __syncthreads();
    qkt(pA0, pA1, K_lds, qr, r32, hi); partialSM(pA0, pA1, m_reg, mnA, alA);
    SLOAD(KVBLK);
    SWAIT(); SWRITE(1); __syncthreads();
    for (int j = 1; j + 1 < NT; j += 2) {
        SBAR(); qkt(pB0, pB1, K_lds + SHM_K, qr, r32, hi);
        finishSM(pA0, pA1, alA, l_reg, pa0, pa1, pa2, pa3); SBAR();
        SLOAD((j + 1) * KVBLK); SBAR();
        pv_d0(o, vb0, pa0, pa1, pa2, pa3); partialSM(pB0, pB1, m_reg, mnB, alB);
        __syncthreads(); SWAIT(); SWRITE(0);
        RESC(alB); __syncthreads();
        SBAR(); qkt(pA0, pA1, K_lds, qr, r32, hi);
        finishSM(pB0, pB1, alB, l_reg, pa0, pa1, pa2, pa3); SBAR();
        SLOAD((j + 2) * KVBLK); SBAR();
        pv_d0(o, vb0 + SHM_V, pa0, pa1, pa2, pa3); partialSM(pA0, pA1, m_reg, mnA, alA);
        __syncthreads(); SWAIT(); SWRITE(1);
        RESC(alA); __syncthreads();
    }
    SBAR(); qkt(pB0, pB1, K_lds + SHM_K, qr, r32, hi);
    finishSM(pA0, pA1, alA, l_reg, pa0, pa1, pa2, pa3); SBAR();
    pv_d0(o, vb0, pa0, pa1, pa2, pa3); partialSM(pB0, pB1, m_reg, mnB, alB);
    __syncthreads(); RESC(alB);
    finishSM(pB0, pB1, alB, l_reg, pa0, pa1, pa2, pa3); SBAR();
    pv_d0(o, vb0 + SHM_V, pa0, pa1, pa2, pa3);
    if (hi == 0) li_l[r32] = l_reg;
    asm volatile("s_waitcnt lgkmcnt(0)" ::: "memory");
    float rli[16];
#pragma unroll
    for (int r = 0; r < 16; ++r) rli[r] = __builtin_amdgcn_rcpf(li_l[crow(r, hi)]);
    bf16_t* Ow = Ob + (size_t)(wid * QBLK) * 1024;
#pragma unroll
    for (int r = 0; r < 16; ++r) { const int orow = crow(r, hi);
#pragma unroll
        for (int d0 = 0; d0 < 4; ++d0) Ow[(size_t)orow * 1024 + d0 * 32 + r32] = (bf16_t)(cvt_pk_bf16(o[d0][r] * rli[r], 0.f) & 0xffffu); }
#undef SLOAD
#undef SWRITE
#undef SWAIT
#undef RESC
}
}

namespace att2 {
using att::crow; using att::v_rd_base; using att::v_rd_off;
constexpr int DQK = 192, DV = 128, KVBLK = 64, QBLK = 32, NT = SKV / KVBLK;
constexpr float SCALE = 0.07216878364870322f, THR = 8.f, CL = SCALE * 1.4426950408889634f;
constexpr int KTB = KVBLK * DQK * 2, VTB = KVBLK * DV * 2, VRING = 4 * KTB, OFF_SCR = VRING + 3 * VTB;
#define SB2() __builtin_amdgcn_sched_barrier(0)
template <int I> __device__ __forceinline__ float pget(const f32x16& p0, const f32x16& p1) { if constexpr (I < 16) return p0[I]; else return p1[I - 16]; }
template <int I> __device__ __forceinline__ void pset(f32x16& p0, f32x16& p1, float v) { if constexpr (I < 16) p0[I] = v; else p1[I - 16] = v; }
template <int I> __device__ __forceinline__ void fexp(f32x16& p0, f32x16& p1) { pset<I>(p0, p1, __builtin_amdgcn_exp2f(pget<I>(p0, p1))); }
template <int I> __device__ __forceinline__ void fadd(const f32x16& p0, const f32x16& p1, float& psA, float& psB) { if constexpr (I < 16) psA += pget<I>(p0, p1); else psB += pget<I>(p0, p1); }
template <int B> __device__ __forceinline__ void fcvt(const f32x16& p0, const f32x16& p1, unsigned (&tw)[4]) {
    tw[0] = cvt_pk_bf16_n(pget<B>(p0, p1), pget<B + 1>(p0, p1)); tw[1] = cvt_pk_bf16_n(pget<B + 2>(p0, p1), pget<B + 3>(p0, p1));
    tw[2] = cvt_pk_bf16_n(pget<B + 4>(p0, p1), pget<B + 5>(p0, p1)); tw[3] = cvt_pk_bf16_n(pget<B + 6>(p0, p1), pget<B + 7>(p0, p1)); }
__device__ __forceinline__ bf16x8 fperm(const unsigned (&tw)[4]) {
    const auto r0 = __builtin_amdgcn_permlane32_swap(tw[0], tw[2], false, false); const auto r1 = __builtin_amdgcn_permlane32_swap(tw[1], tw[3], false, false);
    const u32x4 w = {r0[0], r1[0], r0[1], r1[1]}; return __builtin_bit_cast(bf16x8, w); }
template <int G> __device__ __forceinline__ void fin_gap(f32x16& p0, f32x16& p1, float& psA, float& psB, unsigned (&tw)[4], bf16x8 (&pa)[4], float& l_reg, float alO) {
    if constexpr (G == 0) { fexp<8>(p0, p1); fexp<9>(p0, p1); psA = pget<0>(p0, p1) + pget<1>(p0, p1); }
    if constexpr (G == 1) { fexp<10>(p0, p1); fexp<11>(p0, p1); fadd<2>(p0, p1, psA, psB); fadd<3>(p0, p1, psA, psB); }
    if constexpr (G == 2) { fexp<12>(p0, p1); fexp<13>(p0, p1); fadd<4>(p0, p1, psA, psB); fadd<5>(p0, p1, psA, psB); }
    if constexpr (G == 3) { fexp<14>(p0, p1); fexp<15>(p0, p1); fadd<6>(p0, p1, psA, psB); fadd<7>(p0, p1, psA, psB); }
    if constexpr (G == 4) { fcvt<0>(p0, p1, tw); fadd<8>(p0, p1, psA, psB); }
    if constexpr (G == 5) { pa[0] = fperm(tw); fexp<16>(p0, p1); }
    if constexpr (G == 6) { fexp<17>(p0, p1); fexp<18>(p0, p1); fadd<11>(p0, p1, psA, psB); fadd<12>(p0, p1, psA, psB); }
    if constexpr (G == 7) { fexp<19>(p0, p1); fexp<20>(p0, p1); fadd<13>(p0, p1, psA, psB); fadd<14>(p0, p1, psA, psB); }
    if constexpr (G == 8) { fcvt<8>(p0, p1, tw); fadd<15>(p0, p1, psA, psB); }
    if constexpr (G == 9) { pa[1] = fperm(tw); fexp<21>(p0, p1); psB = pget<16>(p0, p1) + pget<17>(p0, p1); }
    if constexpr (G == 10) { fexp<22>(p0, p1); fexp<23>(p0, p1); fadd<18>(p0, p1, psA, psB); fadd<19>(p0, p1, psA, psB); }
    if constexpr (G == 11) { fexp<24>(p0, p1); fexp<25>(p0, p1); fadd<20>(p0, p1, psA, psB); fadd<21>(p0, p1, psA, psB); }
    if constexpr (G == 12) { fcvt<16>(p0, p1, tw); fadd<22>(p0, p1, psA, psB); }
    if constexpr (G == 13) { pa[2] = fperm(tw); fexp<26>(p0, p1); }
    if constexpr (G == 14) { fexp<27>(p0, p1); fexp<28>(p0, p1); fadd<25>(p0, p1, psA, psB); fadd<26>(p0, p1, psA, psB); }
    if constexpr (G == 15) { fexp<29>(p0, p1); fexp<30>(p0, p1); fadd<27>(p0, p1, psA, psB); fadd<28>(p0, p1, psA, psB); }
    if constexpr (G == 16) { fexp<31>(p0, p1); fadd<29>(p0, p1, psA, psB); fadd<30>(p0, p1, psA, psB); fadd<9>(p0, p1, psA, psB); fadd<10>(p0, p1, psA, psB); }
    if constexpr (G == 17) { fadd<31>(p0, p1, psA, psB); fcvt<24>(p0, p1, tw); fadd<23>(p0, p1, psA, psB); }
    if constexpr (G == 18) { pa[3] = fperm(tw); fadd<24>(p0, p1, psA, psB); psA += psB; }
    if constexpr (G == 19) { const auto rr = __builtin_amdgcn_permlane32_swap(__float_as_uint(psA), __float_as_uint(psA), false, false);
                             l_reg = l_reg * alO + (__uint_as_float(rr[0]) + __uint_as_float(rr[1])); }
}
template <int G> __device__ __forceinline__ void par_gap(f32x16& n0, f32x16& n1, float& mA, float& mB, float& m_reg, float& alN, float& mnC) {
#define MX3(a, b, c) fmaxf(fmaxf(a, b), c)
#define NV(I) pget<I>(n0, n1)
    if constexpr (G == 0) { mA = MX3(NV(0), NV(1), NV(2)); mB = MX3(NV(16), NV(17), NV(18)); mA = MX3(mA, NV(3), NV(4)); mB = MX3(mB, NV(19), NV(20)); }
    if constexpr (G == 1) { mA = MX3(mA, NV(5), NV(6)); mB = MX3(mB, NV(21), NV(22)); mA = MX3(mA, NV(7), NV(8)); mB = MX3(mB, NV(23), NV(24)); }
    if constexpr (G == 2) { mA = MX3(mA, NV(9), NV(10)); mB = MX3(mB, NV(25), NV(26)); mA = MX3(mA, NV(11), NV(12)); mB = MX3(mB, NV(27), NV(28)); }
    if constexpr (G == 3) { mA = MX3(mA, NV(13), NV(14)); mB = MX3(mB, NV(29), NV(30)); mA = MX3(mA, NV(15), NV(31)); mA = fmaxf(mA, mB); }
    if constexpr (G == 4) { const auto rr = __builtin_amdgcn_permlane32_swap(__float_as_uint(mA), __float_as_uint(mA), false, false);
                            const float pmax = fmaxf(__uint_as_float(rr[0]), __uint_as_float(rr[1]));
                            const bool keep = __all(pmax - m_reg <= THR / SCALE); mB = keep ? m_reg : fmaxf(m_reg, pmax); }
    if constexpr (G == 5) { alN = __builtin_amdgcn_exp2f((m_reg - mB) * CL); m_reg = mB; mnC = -mB * CL; }
    if constexpr (G >= 6 && G <= 13) { constexpr int k = G - 6;
        pset<4 * k>(n0, n1, fmaf(NV(4 * k), CL, mnC)); pset<4 * k + 1>(n0, n1, fmaf(NV(4 * k + 1), CL, mnC));
        pset<4 * k + 2>(n0, n1, fmaf(NV(4 * k + 2), CL, mnC)); pset<4 * k + 3>(n0, n1, fmaf(NV(4 * k + 3), CL, mnC));
        fexp<k>(n0, n1); }
#undef MX3
#undef NV
}
template <int G> __device__ __forceinline__ bf16x8 kfrag(const LAS unsigned char* lds, const int (&kb)[4]) {
    constexpr int d0 = G >> 1, h = G & 1;
    return *(const LAS bf16x8*)(lds + kb[d0 & 3] + (d0 >> 2) * 128 + h * 12288);
}
template <int I> __device__ __forceinline__ bf16x8 vfrag(const LAS unsigned char* lds, int vb) {
    constexpr int d0 = I >> 2, ks = I & 3;
    const s16x4 l = __builtin_amdgcn_ds_read_tr16_b64_v4i16((LAS s16x4*)(lds + vb + v_rd_off(d0, ks, 0)));
    const s16x4 h = __builtin_amdgcn_ds_read_tr16_b64_v4i16((LAS s16x4*)(lds + vb + v_rd_off(d0, ks, 1)));
    return (bf16x8){l[0], l[1], l[2], l[3], h[0], h[1], h[2], h[3]};
}
struct VF { s16x4 l, h; };
template <int I> __device__ __forceinline__ void vfrag_asm(VF& f, int vaddr) {
    constexpr int d0 = I >> 2, ks = I & 3;
    asm volatile("ds_read_b64_tr_b16 %0, %1 offset:%2" : "=v"(f.l) : "v"(vaddr), "i"(v_rd_off(d0, ks, 0)) : "memory");
    asm volatile("ds_read_b64_tr_b16 %0, %1 offset:%2" : "=v"(f.h) : "v"(vaddr), "i"(v_rd_off(d0, ks, 1)) : "memory");
}
template <int N> __device__ __forceinline__ bf16x8 vwait(VF& f) { asm volatile("s_waitcnt lgkmcnt(%2)" : "+v"(f.l), "+v"(f.h) : "i"(N)); return (bf16x8){f.l[0], f.l[1], f.l[2], f.l[3], f.h[0], f.h[1], f.h[2], f.h[3]}; }
constexpr int seg2_maxissued(int i) { return i == 0 ? 1 : ((((i - 1) & ~1) == 0) ? 5 : ((((i - 1) & ~1) <= 10) ? ((i - 1) & ~1) + 5 : 15)); }
struct Dma { const char* Kg; const char* Vg; unsigned ko0, ko1, ko2, vo; int wid; };
__device__ __forceinline__ void dma_k(LAS unsigned char* lds, const Dma& d, int t, int so) {
    const unsigned kt = (unsigned)t * KTB;
    LAS unsigned char* kd = lds + so + d.wid * 3072;
    __builtin_amdgcn_global_load_lds((const unsigned*)(d.Kg + (d.ko0 + kt)), (LAS unsigned*)(kd), 16, 0, 0);
    __builtin_amdgcn_global_load_lds((const unsigned*)(d.Kg + (d.ko1 + kt)), (LAS unsigned*)(kd + 1024), 16, 0, 0);
    __builtin_amdgcn_global_load_lds((const unsigned*)(d.Kg + (d.ko2 + kt)), (LAS unsigned*)(kd + 2048), 16, 0, 0);
}
__device__ __forceinline__ void dma_v(LAS unsigned char* lds, const Dma& d, int t, int so) {
    const unsigned vt = (unsigned)t * VTB;
    LAS unsigned char* vd = lds + so + d.wid * 2048;
    __builtin_amdgcn_global_load_lds((const unsigned*)(d.Vg + (d.vo + vt)), (LAS unsigned*)(vd), 16, 0, 0);
    __builtin_amdgcn_global_load_lds((const unsigned*)(d.Vg + (d.vo + vt + 128u)), (LAS unsigned*)(vd + 1024), 16, 0, 0);
}
struct DmaIt { unsigned kt, vt; int soK, soV; };
template <int PIECE> __device__ __forceinline__ void dma_piece(LAS unsigned char* lds, const Dma& d, const DmaIt& it) {
    if constexpr (PIECE < 3) { LAS unsigned char* kd = lds + it.soK + d.wid * 3072 + PIECE * 1024; const unsigned ko = PIECE == 0 ? d.ko0 : PIECE == 1 ? d.ko1 : d.ko2;
        __builtin_amdgcn_global_load_lds((const unsigned*)(d.Kg + (ko + it.kt)), (LAS unsigned*)(kd), 16, 0, 0); }
    else { LAS unsigned char* vd = lds + it.soV + d.wid * 2048 + (PIECE - 3) * 1024;
        __builtin_amdgcn_global_load_lds((const unsigned*)(d.Vg + (d.vo + it.vt + (PIECE - 3) * 128u)), (LAS unsigned*)(vd), 16, 0, 0); }
}
#define PIN2(a, b) asm volatile("" : "+v"(a), "+v"(b))
constexpr int pvp(int i) { return (i & 3) * 4 + (i >> 2); }
template <int G, int DM> __device__ __forceinline__ void seg1_gaps(LAS unsigned char* lds, const Dma& dm, const DmaIt& dit, const int (&kb)[4], int vb, const bf16x8 (&qr)[12], f32x16& pN0, f32x16& pN1, f32x16& pO0, f32x16& pO1,
                                                           bf16x8& f0, bf16x8& f1, bf16x8& f2, bf16x8& f3, VF& v0, VF& v1, float& psA, float& psB, unsigned (&tw)[4], bf16x8 (&pa)[4], float& l_reg, float alO) {
    if constexpr (G < 24) {
        bf16x8& fc = (G & 3) == 0 ? f0 : (G & 3) == 1 ? f1 : (G & 3) == 2 ? f2 : f3;
        if constexpr ((G & 1) == 0) { if constexpr (G < 2) pN0 = __builtin_amdgcn_mfma_f32_32x32x16_bf16(fc, qr[G >> 1], f32x16{}, 0, 0, 0); else pN0 = __builtin_amdgcn_mfma_f32_32x32x16_bf16(fc, qr[G >> 1], pN0, 0, 0, 0); }
        else { if constexpr (G < 2) pN1 = __builtin_amdgcn_mfma_f32_32x32x16_bf16(fc, qr[G >> 1], f32x16{}, 0, 0, 0); else pN1 = __builtin_amdgcn_mfma_f32_32x32x16_bf16(fc, qr[G >> 1], pN1, 0, 0, 0); }
        if constexpr ((G & 1) == 0) {
            bf16x8& fa = ((G + 2) & 3) == 0 ? f0 : f2; bf16x8& fb = ((G + 2) & 3) == 0 ? f1 : f3;
            if constexpr (G + 3 < 24) { fa = kfrag<G + 2>(lds, kb); fb = kfrag<G + 3>(lds, kb); }
            else { vfrag_asm<pvp(0)>(v0, vb); vfrag_asm<pvp(1)>(v1, vb); }
        }
        SB2();
        if constexpr (G == 19 && (DM & 1)) dma_piece<0>(lds, dm, dit);
        if constexpr (G == 20 && (DM & 1)) dma_piece<1>(lds, dm, dit);
        if constexpr (G == 21 && (DM & 1)) dma_piece<2>(lds, dm, dit);
        if constexpr (G == 22 && (DM & 2)) dma_piece<3>(lds, dm, dit);
        if constexpr (G == 23 && (DM & 2)) dma_piece<4>(lds, dm, dit);
        fin_gap<G>(pO0, pO1, psA, psB, tw, pa, l_reg, alO);
        SB2();
        seg1_gaps<G + 1, DM>(lds, dm, dit, kb, vb, qr, pN0, pN1, pO0, pO1, f0, f1, f2, f3, v0, v1, psA, psB, tw, pa, l_reg, alO);
    }
}
template <int I> __device__ __forceinline__ void seg2_gaps(int vb, f32x16 (&o)[4], const bf16x8 (&pa)[4], f32x16& pN0, f32x16& pN1,
                                                           VF& f0, VF& f1, VF& f2, VF& f3, VF& f4, VF& f5, float& mA, float& mB, float& m_reg, float& alN, float& mnC) {
    if constexpr (I < 16) {
        VF& fc = (I % 6) == 0 ? f0 : (I % 6) == 1 ? f1 : (I % 6) == 2 ? f2 : (I % 6) == 3 ? f3 : (I % 6) == 4 ? f4 : f5;
        const bf16x8 bv = vwait<2 * (seg2_maxissued(I) - I)>(fc);
        o[I & 3] = __builtin_amdgcn_mfma_f32_32x32x16_bf16(pa[I >> 2], bv, o[I & 3], 0, 0, 0);
        if constexpr (I == 0) { vfrag_asm<pvp(2)>(f2, vb); vfrag_asm<pvp(3)>(f3, vb); vfrag_asm<pvp(4)>(f4, vb); vfrag_asm<pvp(5)>(f5, vb); }
        else if constexpr ((I & 1) == 0 && I + 5 < 16) {
            VF& fa = ((I + 4) % 6) == 0 ? f0 : ((I + 4) % 6) == 2 ? f2 : f4; VF& fb = ((I + 4) % 6) == 0 ? f1 : ((I + 4) % 6) == 2 ? f3 : f5;
            vfrag_asm<pvp(I + 4)>(fa, vb); vfrag_asm<pvp(I + 5)>(fb, vb);
        }
        par_gap<I>(pN0, pN1, mA, mB, m_reg, alN, mnC);
        if constexpr (I >= 6 && I <= 13) { constexpr int k = I - 6;
            float t0 = pget<4 * k>(pN0, pN1), t1 = pget<4 * k + 1>(pN0, pN1), t2 = pget<4 * k + 2>(pN0, pN1), t3 = pget<4 * k + 3>(pN0, pN1);
            asm volatile("" : "+v"(t0), "+v"(t1), "+v"(t2), "+v"(t3));
            pset<4 * k>(pN0, pN1, t0); pset<4 * k + 1>(pN0, pN1, t1); pset<4 * k + 2>(pN0, pN1, t2); pset<4 * k + 3>(pN0, pN1, t3);
            float te = pget<k>(pN0, pN1); asm volatile("" : "+v"(te)); pset<k>(pN0, pN1, te); }
        SB2();
        seg2_gaps<I + 1>(vb, o, pa, pN0, pN1, f0, f1, f2, f3, f4, f5, mA, mB, m_reg, alN, mnC);
    }
}
__device__ __forceinline__ void attn_unit(const bf16_t* __restrict__ Qb, const bf16_t* __restrict__ Kh, const bf16_t* __restrict__ Vh, bf16_t* __restrict__ Ob, LAS unsigned char* lds) {
    int tid_o = threadIdx.x; asm volatile("" : "+v"(tid_o));
    const int tid = tid_o, wid = __builtin_amdgcn_readfirstlane(tid >> 6), lane = tid & 63, r32 = lane & 31, hi = lane >> 5;
    LAS float* scr = (LAS float*)(lds + OFF_SCR) + wid * 64; LAS float* li_l = scr; LAS float* al_l = scr + 32;
    const int kbase = r32 * 384 + ((hi ^ ((r32 >> 1) & 7)) << 4);
    const int vbase = v_rd_base(lane);
    Dma dm; dm.Kg = (const char*)Kh; dm.Vg = (const char*)Vh; dm.wid = wid;
    { unsigned ko[3];
#pragma unroll
      for (int i = 0; i < 3; ++i) { const int L = (3 * wid + i) * 1024 + lane * 16, r = L / 384, cp = (L - r * 384) >> 4, c = (cp & ~7) | ((cp ^ (r >> 1)) & 7); ko[i] = (unsigned)(r * 384 + c * 16); }
      dm.ko0 = ko[0]; dm.ko1 = ko[1]; dm.ko2 = ko[2];
      const int L = (2 * wid) * 1024 + lane * 16, blk = L >> 9, wv = L & 511, kk = (blk >> 2) * 8 + (wv >> 6), c = (blk & 3) * 32 + ((wv & 63) >> 1);
      const int k = (kk & ~0xC) | ((kk & 4) << 1) | ((kk & 8) >> 1); dm.vo = (unsigned)(k * 256 + c * 2); }
    dma_k(lds, dm, 0, 0); dma_k(lds, dm, 1, KTB); dma_k(lds, dm, 2, 2 * KTB); dma_k(lds, dm, 3, 3 * KTB); dma_v(lds, dm, 0, VRING); dma_v(lds, dm, 1, VRING + VTB);
    float m_reg = -1e30f, l_reg = 0.f; f32x16 o[4] = {}; bf16x8 qr[12];
    { const bf16_t* Qw = Qb + (size_t)(wid * QBLK + r32) * DQK + hi * 8;
#pragma unroll
      for (int d0 = 0; d0 < 12; ++d0) qr[d0] = *reinterpret_cast<const bf16x8*>(Qw + d0 * 16); }
    asm volatile("s_waitcnt vmcnt(0)" ::: "memory"); __builtin_amdgcn_s_barrier(); SB2();
    f32x16 pA0, pA1, pB0, pB1; float alA = 1.f, alB = 1.f, mA, mB, mnC, psA, psB; unsigned tw[4]; bf16x8 pa[4], f0, f1, f2, f3; VF vf0, vf1, vf2, vf3, vf4, vf5;
    int kb[4];
#define KB_SET(so) do { kb[0] = kbase + (so); asm volatile("" : "+v"(kb[0])); kb[1] = kb[0] ^ 32; kb[2] = kb[0] ^ 64; kb[3] = kb[0] ^ 96; } while (0)
    KB_SET(0);
    pA0 = f32x16{}; pA1 = f32x16{};
#pragma unroll
    for (int d0 = 0; d0 < 12; ++d0) { const bf16x8 b0 = *(const LAS bf16x8*)(lds + kb[d0 & 3] + (d0 >> 2) * 128), b1 = *(const LAS bf16x8*)(lds + kb[d0 & 3] + (d0 >> 2) * 128 + 12288);
        pA0 = __builtin_amdgcn_mfma_f32_32x32x16_bf16(b0, qr[d0], pA0, 0, 0, 0); pA1 = __builtin_amdgcn_mfma_f32_32x32x16_bf16(b1, qr[d0], pA1, 0, 0, 0); }
    par_gap<0>(pA0, pA1, mA, mB, m_reg, alA, mnC); par_gap<1>(pA0, pA1, mA, mB, m_reg, alA, mnC); par_gap<2>(pA0, pA1, mA, mB, m_reg, alA, mnC); par_gap<3>(pA0, pA1, mA, mB, m_reg, alA, mnC);
    par_gap<4>(pA0, pA1, mA, mB, m_reg, alA, mnC); par_gap<5>(pA0, pA1, mA, mB, m_reg, alA, mnC); par_gap<6>(pA0, pA1, mA, mB, m_reg, alA, mnC); par_gap<7>(pA0, pA1, mA, mB, m_reg, alA, mnC);
    par_gap<8>(pA0, pA1, mA, mB, m_reg, alA, mnC); par_gap<9>(pA0, pA1, mA, mB, m_reg, alA, mnC); par_gap<10>(pA0, pA1, mA, mB, m_reg, alA, mnC); par_gap<11>(pA0, pA1, mA, mB, m_reg, alA, mnC);
    par_gap<12>(pA0, pA1, mA, mB, m_reg, alA, mnC); par_gap<13>(pA0, pA1, mA, mB, m_reg, alA, mnC);
    alA = 1.f;
    __builtin_amdgcn_s_barrier(); SB2();
    int sV = VRING, sD = VRING + 2 * VTB, sVn = VRING + VTB;
    KB_SET(KTB); f0 = kfrag<0>(lds, kb); f1 = kfrag<1>(lds, kb);
#define RESC2(a) do { if (__any((a) < 1.f)) { if (hi == 0) al_l[r32] = (a); asm volatile("s_waitcnt lgkmcnt(0)" ::: "memory"); \
    _Pragma("unroll") for (int d = 0; d < 4; ++d) _Pragma("unroll") for (int r = 0; r < 16; ++r) o[d][r] *= al_l[crow(r, hi)]; } } while (0)
#define ITER2(pO0, pO1, alO, pN0, pN1, alN, t_, DO_DMA, VMW, PRE) do { \
        int vb_ = vbase + sV + (int)(unsigned long)lds; asm volatile("" : "+v"(vb_)); \
        const DmaIt dit_ = {(unsigned)((t_) + 4) * KTB, (unsigned)((t_) + 2) * VTB, ((t_) & 3) * KTB, sD}; \
        SB2(); \
        seg1_gaps<0, DO_DMA>(lds, dm, dit_, kb, vb_, qr, pN0, pN1, pO0, pO1, f0, f1, f2, f3, vf0, vf1, psA, psB, tw, pa, l_reg, alO); \
        seg2_gaps<0>(vb_, o, pa, pN0, pN1, vf0, vf1, vf2, vf3, vf4, vf5, mA, mB, m_reg, alN, mnC); \
        if (PRE) { KB_SET((((t_) + 2) & 3) * KTB); f0 = kfrag<0>(lds, kb); f1 = kfrag<1>(lds, kb); }        \
        RESC2(alN); \
        asm volatile("s_waitcnt vmcnt(" #VMW ")" ::: "memory"); __builtin_amdgcn_s_barrier(); SB2(); \
        { const int t3_ = sV; sV = sVn; sVn = sD; sD = t3_; } } while (0)
    for (int t = 0; t < NT - 4; t += 2) {
        ITER2(pA0, pA1, alA, pB0, pB1, alB, t, 3, 5, true);
        ITER2(pB0, pB1, alB, pA0, pA1, alA, t + 1, 3, 5, true);
    }
    ITER2(pA0, pA1, alA, pB0, pB1, alB, NT - 4, 2, 2, true);
    ITER2(pB0, pB1, alB, pA0, pA1, alA, NT - 3, 2, 2, true);
    ITER2(pA0, pA1, alA, pB0, pB1, alB, NT - 2, 0, 0, false);
    { int vb_ = vbase + sV; asm volatile("" : "+v"(vb_));
      fin_gap<0>(pB0, pB1, psA, psB, tw, pa, l_reg, alB); fin_gap<1>(pB0, pB1, psA, psB, tw, pa, l_reg, alB); fin_gap<2>(pB0, pB1, psA, psB, tw, pa, l_reg, alB); fin_gap<3>(pB0, pB1, psA, psB, tw, pa, l_reg, alB);
      fin_gap<4>(pB0, pB1, psA, psB, tw, pa, l_reg, alB); fin_gap<5>(pB0, pB1, psA, psB, tw, pa, l_reg, alB); fin_gap<6>(pB0, pB1, psA, psB, tw, pa, l_reg, alB); fin_gap<7>(pB0, pB1, psA, psB, tw, pa, l_reg, alB);
      fin_gap<8>(pB0, pB1, psA, psB, tw, pa, l_reg, alB); fin_gap<9>(pB0, pB1, psA, psB, tw, pa, l_reg, alB); fin_gap<10>(pB0, pB1, psA, psB, tw, pa, l_reg, alB); fin_gap<11>(pB0, pB1, psA, psB, tw, pa, l_reg, alB);
      fin_gap<12>(pB0, pB1, psA, psB, tw, pa, l_reg, alB); fin_gap<13>(pB0, pB1, psA, psB, tw, pa, l_reg, alB); fin_gap<14>(pB0, pB1, psA, psB, tw, pa, l_reg, alB); fin_gap<15>(pB0, pB1, psA, psB, tw, pa, l_reg, alB);
      fin_gap<16>(pB0, pB1, psA, psB, tw, pa, l_reg, alB); fin_gap<17>(pB0, pB1, psA, psB, tw, pa, l_reg, alB); fin_gap<18>(pB0, pB1, psA, psB, tw, pa, l_reg, alB); fin_gap<19>(pB0, pB1, psA, psB, tw, pa, l_reg, alB);
#pragma unroll
      for (int d0 = 0; d0 < 4; ++d0) {
          const bf16x8 v0 = d0 == 0 ? vfrag<0>(lds, vb_) : d0 == 1 ? vfrag<4>(lds, vb_) : d0 == 2 ? vfrag<8>(lds, vb_) : vfrag<12>(lds, vb_);
          const bf16x8 v1 = d0 == 0 ? vfrag<1>(lds, vb_) : d0 == 1 ? vfrag<5>(lds, vb_) : d0 == 2 ? vfrag<9>(lds, vb_) : vfrag<13>(lds, vb_);
          const bf16x8 v2 = d0 == 0 ? vfrag<2>(lds, vb_) : d0 == 1 ? vfrag<6>(lds, vb_) : d0 == 2 ? vfrag<10>(lds, vb_) : vfrag<14>(lds, vb_);
          const bf16x8 v3 = d0 == 0 ? vfrag<3>(lds, vb_) : d0 == 1 ? vfrag<7>(lds, vb_) : d0 == 2 ? vfrag<11>(lds, vb_) : vfrag<15>(lds, vb_);
          o[d0] = __builtin_amdgcn_mfma_f32_32x32x16_bf16(pa[0], v0, o[d0], 0, 0, 0); o[d0] = __builtin_amdgcn_mfma_f32_32x32x16_bf16(pa[1], v1, o[d0], 0, 0, 0);
          o[d0] = __builtin_amdgcn_mfma_f32_32x32x16_bf16(pa[2], v2, o[d0], 0, 0, 0); o[d0] = __builtin_amdgcn_mfma_f32_32x32x16_bf16(pa[3], v3, o[d0], 0, 0, 0); } }
    if (hi == 0) li_l[r32] = l_reg;
    asm volatile("s_waitcnt lgkmcnt(0)" ::: "memory");
    float rli[16];
#pragma unroll
    for (int r = 0; r < 16; ++r) rli[r] = __builtin_amdgcn_rcpf(li_l[crow(r, hi)]);
    { LAS unsigned char* ost = lds + wid * 8192;
#pragma unroll
      for (int r = 0; r < 16; ++r) { const int orow = crow(r, hi);
#pragma unroll
          for (int d0 = 0; d0 < 4; ++d0) *(LAS unsigned short*)(ost + orow * 256 + (d0 * 32 + r32) * 2) = (unsigned short)(cvt_pk_bf16_n(o[d0][r] * rli[r], 0.f) & 0xffffu); }
      asm volatile("s_waitcnt lgkmcnt(0)" ::: "memory");
      bf16_t* Ow = Ob + (size_t)(wid * QBLK) * 1024;
#pragma unroll
      for (int j = 0; j < 8; ++j) { const int row = j * 4 + (lane >> 4); const u32x4 vv = *(const LAS u32x4*)(ost + row * 256 + (lane & 15) * 16);
          *(u32x4*)(Ow + (size_t)row * 1024 + (lane & 15) * 8) = vv; } }
#undef KB_SET
#undef RESC2
#undef ITER2
}
#undef SB2
}

__device__ __forceinline__ void transpose_item(const float* W, int ldw, int k0, int n0, bf16_t* dst, int ldd, const float* kscale, LAS float* scr, int lane) {
    float tv[32];
#pragma unroll
    for (int i = 0; i < 32; ++i) { const int kk = 2 * i + (lane >> 5); tv[i] = __builtin_nontemporal_load(W + (size_t)(k0 + kk) * ldw + n0 + (lane & 31)); }
#pragma unroll
    for (int i = 0; i < 32; ++i) { const int kk = 2 * i + (lane >> 5); float v = tv[i]; if (kscale) v *= kscale[k0 + kk]; scr[kk * 33 + (lane & 31)] = v; }
    LDS_WAIT(); asm volatile("" ::: "memory");
    const int c = lane & 7;
#pragma unroll
    for (int j = 0; j < 4; ++j) { const int n = (lane >> 3) + 8 * j; const LAS float* s = scr + (8 * c) * 33 + n;
        u32x4 o; o.x = cvt_pk_bf16(s[0 * 33], s[1 * 33]); o.y = cvt_pk_bf16(s[2 * 33], s[3 * 33]); o.z = cvt_pk_bf16(s[4 * 33], s[5 * 33]); o.w = cvt_pk_bf16(s[6 * 33], s[7 * 33]);
        *(u32x4*)(dst + (size_t)n * ldd + 8 * c) = o; }
    LDS_WAIT(); asm volatile("" ::: "memory");
}

__device__ __forceinline__ void ph_mod_and_weights(KP p, LAS unsigned char* lds) {
    const int tid = threadIdx.x, lane = tid & 63, wave = tid >> 6;
    unsigned char* ws = p.ws;
    float* mod = (float*)(ws + WS_MOD);
    {
        LAS float* sc = (LAS float*)lds;
        LAS float* red = (LAS float*)(lds + 20480);
        if ((int)blockIdx.x < 192) {
            for (int i = tid; i < 5 * 1024; i += NTHREADS) { const int j = i >> 10, k = i & 1023; const float v = j < 4 ? p.in[I_C][j * 1024 + k] : p.in[I_CCTX][k]; sc[i] = v * sigmoidf_(v); }
            __syncthreads();
            for (int unit = blockIdx.x; unit < 192; unit += gridDim.x) {
                const int c32 = tid & 31, kg = tid >> 5, col = unit * 32 + c32;
                float a0 = 0, a1 = 0, a2 = 0, a3 = 0, a4 = 0;
                const float* wp = p.in[I_WADA] + (size_t)(kg * 64) * 6144 + col;
#pragma unroll 8
                for (int kk = 0; kk < 64; ++kk) { const float w = wp[(size_t)kk * 6144]; const int k = kg * 64 + kk;
                    a0 += sc[k] * w; a1 += sc[1024 + k] * w; a2 += sc[2048 + k] * w; a3 += sc[3072 + k] * w; a4 += sc[4096 + k] * w; }
                LAS float* rp = red + (kg * 32 + c32) * 5; rp[0] = a0; rp[1] = a1; rp[2] = a2; rp[3] = a3; rp[4] = a4;
                __syncthreads();
                if (tid < 160) { const int cc = tid & 31, j = tid >> 5; float s = p.in[I_BADA][unit * 32 + cc];
                    for (int g = 0; g < 16; ++g) s += red[(g * 32 + cc) * 5 + j];
                    mod[j * 6144 + unit * 32 + cc] = s; }
                __syncthreads();
            }
        }
    }
    __syncthreads();
    {
        LAS float* scr = (LAS float*)(lds + wave * 8448);
        const int gw = blockIdx.x * NWAVES + wave, NGW = gridDim.x * NWAVES;
        bf16_t* WIN = (bf16_t*)(ws + WS_WIN); bf16_t* WLO = (bf16_t*)(ws + WS_WLORA); bf16_t* WUQ = (bf16_t*)(ws + WS_WUQ); bf16_t* WUKV = (bf16_t*)(ws + WS_WUKV); bf16_t* WOUT = (bf16_t*)(ws + WS_WOUT);
        constexpr int I_IN = 16 * 78, I_L = 16, I_G = 32, I_Q = 4 * 24, I_KV = 4 * 16, I_O = 16 * 32;
        constexpr int NITEMS = I_IN + 4 * I_L + I_G + I_Q + 2 * I_KV + I_O;
        for (int it = gw; it < NITEMS; it += NGW) {
            int r = it;
            if (r < I_IN) { const int kb = r / 78, nb = r % 78; transpose_item(p.in[I_WIN], IN_PROJ, kb * 64, nb * 32, WIN + (size_t)(nb * 32) * 1024 + kb * 64, 1024, nullptr, scr, lane); continue; } r -= I_IN;
            if (r < 2 * I_L) { const int d = r / 16, nb = r % 16; transpose_item(p.in[I_WUP] + (size_t)d * 64 * 512, 512, 0, nb * 32, WLO + (size_t)(d * 512 + nb * 32) * 128 + d * 64, 128, nullptr, scr, lane); continue; } r -= 2 * I_L;
            if (r < 2 * I_L) { const int d = r / 16, nb = r % 16; transpose_item(p.in[I_AUP] + (size_t)d * 64 * 512, 512, 0, nb * 32, WLO + (size_t)(1024 + d * 512 + nb * 32) * 128 + d * 64, 128, nullptr, scr, lane); continue; } r -= 2 * I_L;
            if (r < I_G) { const int kb = r / 16, nb = r % 16; transpose_item(p.in[I_GUP], 512, kb * 64, nb * 32, WLO + (size_t)(2048 + nb * 32) * 128 + kb * 64, 128, nullptr, scr, lane); continue; } r -= I_G;
            if (r < I_Q) { const int kb = r / 24, nb = r % 24; transpose_item(p.in[I_WUQ], 768, kb * 64, nb * 32, WUQ + (size_t)(nb * 32) * 256 + kb * 64, 256, p.in[I_QNORM], scr, lane); continue; } r -= I_Q;
            if (r < I_KV) { const int kb = r / 16, nb = r % 16; transpose_item(p.in[I_WUK], 512, kb * 64, nb * 32, WUKV + (size_t)(nb * 32) * 256 + kb * 64, 256, p.in[I_KVNORM], scr, lane); continue; } r -= I_KV;
            if (r < I_KV) { const int kb = r / 16, nb = r % 16; transpose_item(p.in[I_WUV], 512, kb * 64, nb * 32, WUKV + (size_t)(512 + nb * 32) * 256 + kb * 64, 256, p.in[I_KVNORM], scr, lane); continue; } r -= I_KV;
            { const int kb = r / 32, nb = r % 32; transpose_item(p.in[I_WOUT], 1024, kb * 64, nb * 32, WOUT + (size_t)(nb * 32) * 1024 + kb * 64, 1024, nullptr, scr, lane); }
        }
        const long gt = (long)blockIdx.x * NTHREADS + tid, gs = (long)gridDim.x * NTHREADS;
        const u32x4 z = {0u, 0u, 0u, 0u};
        for (long i = gt; i < 64 * 128; i += gs) *(u32x4*)(WIN + (size_t)IN_PROJ * 1024 + i * 8) = z;
        for (long i = gt; i < 2048 * 8; i += gs) { const int row = (int)(i >> 3), ch = (int)(i & 7), d = (row >> 9) & 1;
            *(u32x4*)(WLO + (size_t)row * 128 + (1 - d) * 64 + ch * 8) = z; }
    }
}

__device__ __forceinline__ void ph_modulate1(KP p) {
    const int tid = threadIdx.x, lane = tid & 63, wave = tid >> 6;
    const float* mod = (const float*)(p.ws + WS_MOD); bf16_t* XM = (bf16_t*)(p.ws + WS_XM);
    const int gw = blockIdx.x * NWAVES + wave, NGW = gridDim.x * NWAVES;
    ER(1) for (int row = gw; row < MA; row += NGW) {
        const float* xr; int j;
        if (row < ML) { xr = p.in[I_X] + (size_t)row * D; j = row >> 13; } else { xr = p.in[I_CTX] + (size_t)(row - ML) * D; j = 4; }
        const float* sh = mod + j * 6144, * sc = sh + 1024;
        f32x4 v[4]; float s = 0.f;
#pragma unroll
        for (int q = 0; q < 4; ++q) { v[q] = __builtin_nontemporal_load((const f32x4*)(xr + q * 256 + lane * 4)); s += (v[q].x + v[q].y) + (v[q].z + v[q].w); }
        const float mean = wave_sum(s) * (1.f / D); float s2 = 0.f;
#pragma unroll
        for (int q = 0; q < 4; ++q) { v[q] = v[q] - mean; s2 += (v[q].x * v[q].x + v[q].y * v[q].y) + (v[q].z * v[q].z + v[q].w * v[q].w); }
        const float rstd = 1.0f / sqrtf(wave_sum(s2) * (1.f / D) + LN_EPS);
#pragma unroll
        for (int q = 0; q < 4; ++q) { const int c = q * 256 + lane * 4; const f32x4 a = *(const f32x4*)(sc + c), bsh = *(const f32x4*)(sh + c);
            const f32x4 y = v[q] * rstd * (a + 1.0f) + bsh;
            u32x2 w; w.x = cvt_pk_bf16(y.x, y.y); w.y = cvt_pk_bf16(y.z, y.w); *(u32x2*)(XM + (size_t)row * D + c) = w; }
    }
}

__device__ __forceinline__ void ph_prepare(KP p) {
    const int tid = threadIdx.x, lane = tid & 63, wave = tid >> 6;
    unsigned char* ws = p.ws;
    const bf16_t* H = (const bf16_t*)(ws + WS_H); _Float16* RKV = (_Float16*)(ws + WS_RKV); bf16_t* ACT = (bf16_t*)(ws + WS_ACT);
    float* rq = (float*)(ws + WS_RSTDQ); float* rkv = (float*)(ws + WS_RSTDKV); bf16_t* Kb = (bf16_t*)(ws + WS_K);
    const float* cw = p.in[I_CONV]; float* rnp = (float*)(ws + WS_RN);
    const int gw = blockIdx.x * NWAVES + wave, NGW = gridDim.x * NWAVES;
    constexpr int STRIP = 17, NSTRIP = (MA + STRIP - 1) / STRIP;
    const u32x4 z4 = {0u, 0u, 0u, 0u};
    ER(3) for (int strip = gw; strip < NSTRIP; strip += NGW) {
        const int r0 = strip * STRIP, r1 = (r0 + STRIP < MA) ? r0 + STRIP : MA;
        u32x4 prv[3], cur[3], nxt[3]; u32x4 lx = z4; u32x2 qa, qc; unsigned short k1 = 0, k2 = 0;
#define PREP_LOADROW(dst, row_) do { const bf16_t* hp_ = H + (size_t)(row_) * NHP; _Pragma("unroll") for (int q = 0; q < 3; ++q) dst[q] = __builtin_nontemporal_load((const u32x4*)(hp_ + q * 512 + lane * 8)); } while (0)
#define PREP_LOADAUX(row_) do { const bf16_t* hp_ = H + (size_t)(row_) * NHP; if (lane < 48) lx = *(const u32x4*)(hp_ + 1536 + lane * 8); qa = *(const u32x2*)(hp_ + 1920 + lane * 4); qc = *(const u32x2*)(hp_ + 2176 + lane * 4); \
        if (lane < 32) { const int g_ = (lane >> 4) & 1, jj_ = lane & 15; k1 = hp_[2432 + g_ * 32 + jj_]; k2 = hp_[2432 + g_ * 32 + 16 + jj_]; } } while (0)
        PREP_LOADROW(cur, r0); PREP_LOADAUX(r0);
        if (r0 > 0) PREP_LOADROW(prv, r0 - 1); else { prv[0] = z4; prv[1] = z4; prv[2] = z4; }
        if (r0 + 1 < MA) PREP_LOADROW(nxt, r0 + 1); else { nxt[0] = z4; nxt[1] = z4; nxt[2] = z4; }
        for (int row = r0; row < r1; ++row) {
            int b, t, len, key;
            if (row < ML) { b = row >> 13; t = row & (T - 1); len = T; key = CTX + t; } else { const int rc = row - ML; b = rc >> 8; t = rc & (CTX - 1); len = CTX; key = t; }
            const u32x4 lxc = lx; const u32x2 qac = qa, qcc = qc; const unsigned short k1c = k1, k2c = k2;
            u32x4 nn[3]; nn[0] = z4; nn[1] = z4; nn[2] = z4;
            if (row + 2 < MA && row + 1 < r1) PREP_LOADROW(nn, row + 2);
            if (row + 1 < r1) PREP_LOADAUX(row + 1);
            const bool hasp = t > 0, hasn = t < len - 1;
#pragma unroll
            for (int q = 0; q < 3; ++q) { const int c = q * 512 + lane * 8;
                const u32x4 pv = hasp ? prv[q] : z4, nv = hasn ? nxt[q] : z4, cv = cur[q];
                h16x8 o;
#pragma unroll
                for (int i = 0; i < 4; ++i) { const int ch = c + 2 * i;
                    const float lo = cw[ch] * bflo(pv[i]) + cw[1536 + ch] * bflo(cv[i]) + cw[3072 + ch] * bflo(nv[i]);
                    const float hi = cw[ch + 1] * bfhi(pv[i]) + cw[1536 + ch + 1] * bfhi(cv[i]) + cw[3072 + ch + 1] * bfhi(nv[i]);
                    o[2 * i] = (_Float16)lo; o[2 * i + 1] = (_Float16)hi; }
                *(h16x8*)(RKV + (size_t)row * 1536 + c) = o;
                if (q == 1) {
                    float ss = 0.f;
#pragma unroll
                    for (int i = 0; i < 8; ++i) { const float kr = (float)o[i] * p.in[I_KK][lane * 8 + i]; ss += kr * kr; }
                    ss += __shfl_xor(ss, 1); ss += __shfl_xor(ss, 2); ss += __shfl_xor(ss, 4);
                    if ((lane & 7) == 0) rnp[(size_t)row * 8 + (lane >> 3)] = 1.0f / sqrtf(ss + 1e-12f); } }
            if (lane < 48) { u32x4 o;
#pragma unroll
                for (int i = 0; i < 4; ++i) { float lo = bflo(lxc[i]), hi = bfhi(lxc[i]);
                    if (lane < 16) { const float el = __builtin_amdgcn_exp2f(-2.885390081777927f * lo), eh = __builtin_amdgcn_exp2f(-2.885390081777927f * hi);
                        lo = 2.0f * __builtin_amdgcn_rcpf(1.0f + el) - 1.0f; hi = 2.0f * __builtin_amdgcn_rcpf(1.0f + eh) - 1.0f; }
                    else if (lane >= 32) { lo = sigmoidf_(lo); hi = sigmoidf_(hi); }
                    o[i] = cvt_pk_bf16(lo, hi); }
                *(u32x4*)(ACT + (size_t)row * 384 + lane * 8) = o; }
            { float sa = bflo(qac.x) * bflo(qac.x) + bfhi(qac.x) * bfhi(qac.x) + bflo(qac.y) * bflo(qac.y) + bfhi(qac.y) * bfhi(qac.y);
              float sb = bflo(qcc.x) * bflo(qcc.x) + bfhi(qcc.x) * bfhi(qcc.x) + bflo(qcc.y) * bflo(qcc.y) + bfhi(qcc.y) * bfhi(qcc.y);
              sa = wave_sum(sa); sb = wave_sum(sb);
              if (lane == 0) { rq[row] = 1.0f / sqrtf(sa * (1.f / 256.f) + RMS_EPS); rkv[row] = 1.0f / sqrtf(sb * (1.f / 256.f) + RMS_EPS); } }
            if (lane < 32) { float o1, o2; const int g = (lane >> 4) & 1, jj = lane & 15; const float x1 = bf2f(k1c), x2 = bf2f(k2c);
                if (row < ML) { const float pos = (float)(g == 0 ? (t >> 6) : (t & 63)); float rev = pos * rope_invfreq(jj); rev = rev - floorf(rev);
                    const float sn = __builtin_amdgcn_sinf(rev), cs = __builtin_amdgcn_cosf(rev); o1 = x1 * cs - x2 * sn; o2 = x2 * cs + x1 * sn; }
                else { o1 = x1; o2 = x2; }
                const bf16_t w1 = (bf16_t)(cvt_pk_bf16(o1, 0.f) & 0xffffu), w2 = (bf16_t)(cvt_pk_bf16(o2, 0.f) & 0xffffu);
#pragma unroll
                for (int hh = 0; hh < 4; ++hh) { bf16_t* kp = Kb + ((size_t)(b * 4 + hh) * SKV + key) * 192 + 128 + g * 32 + jj; kp[0] = w1; kp[16] = w2; } }
#pragma unroll
            for (int q = 0; q < 3; ++q) { prv[q] = cur[q]; cur[q] = nxt[q]; nxt[q] = nn[q]; }
        }
#undef PREP_LOADROW
#undef PREP_LOADAUX
    }
}

constexpr int SC_CH = 32, SC_TOKF = 344;
__device__ __forceinline__ int scan_row_of(int b, int dir, int n) {
    if (n < CTX) { const int tc = dir ? (CTX - 1 - n) : n; return ML + b * CTX + tc; }
    const int tl = dir ? (T - 1 - (n - CTX)) : (n - CTX); return b * T + tl;
}
__device__ __forceinline__ void ph_scan(KP p, LAS unsigned char* lds) {
    const int tid = threadIdx.x, lane = tid & 63, wave = tid >> 6;
    unsigned char* ws = p.ws;
    const _Float16* RKV = (const _Float16*)(ws + WS_RKV); const _Float16* E16 = (const _Float16*)(ws + WS_E16); const _Float16* A16 = (const _Float16*)(ws + WS_A16);
    _Float16* YS = (_Float16*)((unsigned char*)p.out + DO_YS);
    const float* kkp = p.in[I_KK]; const float* kap = p.in[I_KA];
    LAS float* buf = (LAS float*)lds;
    constexpr int NCHUNK = SKV / SC_CH;
    for (int unit = blockIdx.x; unit < 256; unit += gridDim.x) {
        const int chain = unit >> 2, rb = (unit & 3) * 16;
        const int dir = chain & 1, hh = (chain >> 1) & 3  ;
        const int b = chain >> 4, head = (chain >> 1) & 7;
        (void)hh;
#define SC_PREP(ck) do { const int pt = tid - 256; const int tt = pt >> 3, part = pt & 7;                                                        \
        const int row = scan_row_of(b, dir, (ck) * SC_CH + tt); const int ch0 = head * 64 + part * 8;                                            \
        const h16x8 r8 = *(const h16x8*)(RKV + (size_t)row * 1536 + ch0), k8 = *(const h16x8*)(RKV + (size_t)row * 1536 + 512 + ch0);          \
        const h16x8 a8 = *(const h16x8*)(A16 + ((size_t)dir * MA + row) * 512 + ch0), e8 = *(const h16x8*)(E16 + ((size_t)dir * MA + row) * 512 + ch0); \
        float kf[8], kkr[8]; float ss = 0.f;                                                                                                     \
        _Pragma("unroll") for (int i = 0; i < 8; ++i) { kf[i] = (float)k8[i]; kkr[i] = kf[i] * kkp[ch0 + i]; ss += kkr[i] * kkr[i]; }           \
        ss += __shfl_xor(ss, 1); ss += __shfl_xor(ss, 2); ss += __shfl_xor(ss, 4);                                                               \
        const float rn = 1.0f / sqrtf(ss + 1e-12f);                                                                                              \
        LAS float* rec = buf + ((ck) & 1) * (SC_CH * SC_TOKF) + tt * SC_TOKF; float c1 = 0.f, c2 = 0.f;                                         \
        _Pragma("unroll") for (int i = 0; i < 8; ++i) { const float a = (float)a8[i], r = (float)r8[i]; const float kk = kkr[i] * rn;           \
            const float w = __builtin_amdgcn_exp2f(-1.4426950408889634f * (float)e8[i]); const float ka = kk * a;                                \
            const float kd = kf[i] * (1.0f + (a - 1.0f) * kap[ch0 + i]);                                                                         \
            rec[part * 8 + i] = kk; rec[64 + part * 8 + i] = w * r; rec[128 + part * 8 + i] = w; rec[192 + part * 8 + i] = kd; rec[256 + part * 8 + i] = ka; \
            c1 += ka * r; c2 += kd * r; }                                                                                                        \
        c1 += __shfl_xor(c1, 1); c1 += __shfl_xor(c1, 2); c1 += __shfl_xor(c1, 4); c2 += __shfl_xor(c2, 1); c2 += __shfl_xor(c2, 2); c2 += __shfl_xor(c2, 4); \
        if (part == 0) { rec[336] = c1; rec[337] = c2; }                                                                                         \
        if (part < 2) { const h16x8 v8 = *(const h16x8*)(RKV + (size_t)row * 1536 + 1024 + head * 64 + rb + part * 8);                           \
            _Pragma("unroll") for (int i = 0; i < 8; ++i) rec[320 + part * 8 + i] = (float)v8[i]; } } while (0)
        if (wave >= 4) SC_PREP(0);
        __syncthreads();
        f32x2 S01 = {0.f, 0.f}, S23 = {0.f, 0.f};
        const int ri = (wave & 3) * 4 + (lane >> 4), q = lane & 15;
        for (int ck = 0; ck < NCHUNK; ++ck) {
            if (wave >= 4) { if (ck + 1 < NCHUNK) SC_PREP(ck + 1); }
            else {
                const LAS float* cb = buf + (ck & 1) * (SC_CH * SC_TOKF);
                float yk0 = 0.f, yk1 = 0.f;
#pragma unroll 4
                for (int tt = 0; tt < SC_CH; ++tt) {
                    const LAS float* rec = cb + tt * SC_TOKF;
                    const f32x4 kk4 = *(const LAS f32x4*)(rec + q * 4), wr4 = *(const LAS f32x4*)(rec + 64 + q * 4), w4 = *(const LAS f32x4*)(rec + 128 + q * 4);
                    const f32x4 kd4 = *(const LAS f32x4*)(rec + 192 + q * 4), ka4 = *(const LAS f32x4*)(rec + 256 + q * 4);
                    const float v = rec[320 + ri]; const f32x2 cc = *(const LAS f32x2*)(rec + 336);
                    f32x2 d1 = S01 * (f32x2){kk4.x, kk4.y}; d1 = S23 * (f32x2){kk4.z, kk4.w} + d1;
                    f32x2 d2 = S01 * (f32x2){wr4.x, wr4.y}; d2 = S23 * (f32x2){wr4.z, wr4.w} + d2;
                    const float sk = allred16(d1.x + d1.y), qv = allred16(d2.x + d2.y);
                    const float y = qv - sk * cc.x + v * cc.y;
                    const f32x2 vv = {v, v}, ns = {-sk, -sk};
                    S01 = S01 * (f32x2){w4.x, w4.y}; S01 = vv * (f32x2){kd4.x, kd4.y} + S01; S01 = ns * (f32x2){ka4.x, ka4.y} + S01;
                    S23 = S23 * (f32x2){w4.z, w4.w}; S23 = vv * (f32x2){kd4.z, kd4.w} + S23; S23 = ns * (f32x2){ka4.z, ka4.w} + S23;
                    if ((tt & 15) == q) { if (tt < 16) yk0 = y; else yk1 = y; }
                }
                if (ck >= CTX / SC_CH) {
                    const int r0 = scan_row_of(b, dir, ck * SC_CH + q), r1 = scan_row_of(b, dir, ck * SC_CH + 16 + q);
                    YS[((size_t)dir * ML + r0) * 512 + head * 64 + rb + ri] = (_Float16)yk0;
                    YS[((size_t)dir * ML + r1) * 512 + head * 64 + rb + ri] = (_Float16)yk1;
                }
            }
            __syncthreads();
        }
#undef SC_PREP
    }
}


#ifndef SC2_DUP
#define SC2_DUP 0
#endif
namespace sc2 {
constexpr int PITCH = 128, SLOT = 64 * PITCH;
constexpr int CPS = 33, CH = 64;
enum { SL_S = 0, SL_MT = 1, SL_AH = 2, SL_BH = 3, SL_KH = 4, SL_RH = 5, SL_AHT = 6, SL_BBT = 7, SL_VT = 8, SL_KBT = 9, SL_AAB = 10, SL_AAKT = 11, SL_ARB = 12, SL_ARK = 13, SL_P2T = 14,
       SL_TT = 2, SL_ET = 3, SL_T = 4, SL_Q1 = 2, SL_Q2 = 3, SL_ML = 4, SL_ZX = 6, SL_P1T = 10, SL_TB = 15, SL_TTB = 16 };
constexpr int GC_OFF = 17 * SLOT;
__device__ __forceinline__ int swz(int row, int byte) { return row * PITCH + ((((byte >> 4) ^ (row >> 1)) & 7) << 4) + (byte & 15); }
struct Fr { bf16x8 k0, k1; };
__device__ __forceinline__ Fr ldf(const LAS char* M, int tile, int lane) { const int row = 16 * tile + (lane & 15), cq = lane >> 4, sw = (row >> 1) & 7; Fr f;
    f.k0 = *(const LAS bf16x8*)(M + row * PITCH + ((cq ^ sw) << 4)); f.k1 = *(const LAS bf16x8*)(M + row * PITCH + (((cq + 4) ^ sw) << 4)); return f; }
__device__ __forceinline__ f32x4 mm(const Fr& A, const Fr& B, f32x4 acc) {
    acc = __builtin_amdgcn_mfma_f32_16x16x32_bf16(A.k0, B.k0, acc, 0, 0, 0); acc = __builtin_amdgcn_mfma_f32_16x16x32_bf16(A.k1, B.k1, acc, 0, 0, 0); return acc; }
__device__ __forceinline__ void st4(LAS char* M, int row, int col, f32x4 v) { u32x2 w; w.x = cvt_pk_bf16_n(v[0], v[1]); w.y = cvt_pk_bf16_n(v[2], v[3]); *(LAS u32x2*)(M + swz(row, col * 2)) = w; }
__device__ __forceinline__ f32x4 ld4(const LAS char* M, int row, int col) { const u32x2 w = *(const LAS u32x2*)(M + swz(row, col * 2)); return (f32x4){bflo(w.x), bfhi(w.x), bflo(w.y), bfhi(w.y)}; }
__device__ __forceinline__ void st1(LAS char* M, int row, int col, float v) { *(LAS unsigned short*)(M + swz(row, col * 2)) = (unsigned short)(cvt_pk_bf16_n(v, 0.f) & 0xffffu); }
#define SC2_SLOT(i) ((LAS char*)lds + (i) * SLOT)
#define SC2_BAR() do { asm volatile("s_waitcnt lgkmcnt(0)" ::: "memory"); __syncthreads(); } while (0)
#define SC2_Z ((f32x4){0.f, 0.f, 0.f, 0.f})
#define SC2_SB() __builtin_amdgcn_sched_barrier(0)

__device__ __forceinline__ void pass_a(KP p, LAS unsigned char* lds) {
    int tid_o = threadIdx.x; asm volatile("" : "+v"(tid_o));
    const int tid = tid_o, lane = tid & 63, wave = __builtin_amdgcn_readfirstlane(tid >> 6), q4 = (lane >> 4) * 4, l15 = lane & 15;
    unsigned char* ws = p.ws;
    const _Float16* RKV = (const _Float16*)(ws + WS_RKV); const _Float16* E16 = (const _Float16*)(ws + WS_E16); const _Float16* A16 = (const _Float16*)(ws + WS_A16);
    _Float16* YS = (_Float16*)((unsigned char*)p.out + DO_YS);
    LAS float* gC = (LAS float*)((LAS char*)lds + GC_OFF); const float* RN = (const float*)(ws + WS_RN);
    const int tx = wave >> 1, ty0 = (wave & 1) * 2;
    const int x = 16 * tx + l15;
    for (int unit = blockIdx.x; unit < 256; unit += gridDim.x) {
        const int chain = unit >> 2, seg = unit & 3, dir = chain & 1, head = (chain >> 1) & 7, b = chain >> 4;
        bf16_t* QC = (bf16_t*)(ws + (dir ? WS_QC1 : WS_QC0)) + (size_t)(chain >> 1) * SKV * 64;
        float* SEG = (float*)(ws + WS_SEG) + (size_t)unit * 8192;
        h16x8 e8n, a8n, r8n, k8n, v8n; float rnn;
#define SC2_LOADRAW(ck_) do { const int row_ = scan_row_of(b, dir, (ck_) * CH + lane); const size_t eo_ = ((size_t)dir * MA + row_) * 512 + head * 64 + wave * 8; \
        e8n = *(const h16x8*)(E16 + eo_); a8n = *(const h16x8*)(A16 + eo_); const _Float16* rp_ = RKV + (size_t)row_ * 1536 + head * 64 + wave * 8; \
        r8n = *(const h16x8*)rp_; k8n = *(const h16x8*)(rp_ + 512); v8n = *(const h16x8*)(rp_ + 1024); rnn = RN[(size_t)row_ * 8 + head]; } while (0)
        unsigned zo_ = 0u; asm volatile("" : "+v"(zo_)); const u32x4 zz4 = {zo_, zo_, zo_, zo_};
        for (int i = tid; i < 2 * SLOT / 16; i += NTHREADS) *(LAS u32x4*)((LAS char*)lds + i * 16) = zz4;
        SC2_BAR();
        if (tid < 64) st1(SC2_SLOT(SL_MT), tid, tid, 1.0f);
        const int cb = wave & 3;
        f32x4 mst[4];
#pragma unroll
        for (int tk = 0; tk < 4; ++tk) { mst[tk] = SC2_Z;
            if (wave >= 4) {
#pragma unroll
                for (int e = 0; e < 4; ++e) mst[tk][e] = (16 * tk + q4 + e == 16 * cb + l15) ? 1.0f : 0.0f; } }
        SC2_BAR();
        SC2_LOADRAW(seg * CPS);
        for (int ck = seg * CPS; ck < (seg + 1) * CPS; ++ck) {
            {
                const h16x8 e8 = e8n, a8 = a8n, r8 = r8n, k8 = k8n, v8 = v8n; const float rn = rnn;
                u32x4 wah, wrh, wbh, wkh; unsigned pa = 0, pr = 0, pb = 0, pk = 0; float gcv = 0.f;
                const f32x4 kk0 = *(const f32x4*)(p.in[I_KK] + head * 64 + wave * 8), kk1 = *(const f32x4*)(p.in[I_KK] + head * 64 + wave * 8 + 4), ka0 = *(const f32x4*)(p.in[I_KA] + head * 64 + wave * 8), ka1 = *(const f32x4*)(p.in[I_KA] + head * 64 + wave * 8 + 4);
#pragma unroll
                for (int j = 0; j < 8; ++j) {
                    const float ev = (float)e8[j];
                    float L = ev; L += dppf<0x111>(L); L += dppf<0x112>(L); L += dppf<0x114>(L); L += dppf<0x118>(L);
                    L += dppm<0x142, 0xA>(L); L += dppm<0x143, 0xC>(L);
                    const float tot = __int_as_float(__builtin_amdgcn_readlane(__float_as_int(L), 63));
                    const float gam = __builtin_amdgcn_exp2f(-L), gprev = __builtin_amdgcn_exp2f(ev - L);
                    const float ginv = __builtin_amdgcn_exp2f(L), gbar = __builtin_amdgcn_exp2f(L - tot);
                    gcv = (lane == j) ? tot : gcv;
                    const float kf = (float)k8[j], af = (float)a8[j], kkn = kf * (j < 4 ? kk0[j & 3] : kk1[j & 3]) * rn;
                    const float ka = kkn * af, kd = kf * (1.0f + (af - 1.0f) * (j < 4 ? ka0[j & 3] : ka1[j & 3]));
                    const float Ah = -kkn * gprev, Rh = (float)r8[j] * gam, Bh = ka * ginv, Kh = kd * ginv, Bb = ka * gbar, Kb = kd * gbar;
                    const int c = wave * 8 + j;
                    st1(SC2_SLOT(SL_AHT), c, lane, Ah); st1(SC2_SLOT(SL_BBT), c, lane, Bb); st1(SC2_SLOT(SL_VT), c, lane, (float)v8[j]); st1(SC2_SLOT(SL_KBT), c, lane, Kb);
                    if (j & 1) { wah[j >> 1] = cvt_pk_bf16_n(__uint_as_float(pa), Ah); wrh[j >> 1] = cvt_pk_bf16_n(__uint_as_float(pr), Rh); wbh[j >> 1] = cvt_pk_bf16_n(__uint_as_float(pb), Bh); wkh[j >> 1] = cvt_pk_bf16_n(__uint_as_float(pk), Kh); SC2_SB(); }
                    else { pa = __float_as_uint(Ah); pr = __float_as_uint(Rh); pb = __float_as_uint(Bh); pk = __float_as_uint(Kh); } }
                if (lane < 8) gC[wave * 8 + lane] = __builtin_amdgcn_exp2f(-gcv);
                const int ro = swz(lane, wave * 16);
                *(LAS u32x4*)(SC2_SLOT(SL_AH) + ro) = wah; *(LAS u32x4*)(SC2_SLOT(SL_RH) + ro) = wrh; *(LAS u32x4*)(SC2_SLOT(SL_BH) + ro) = wbh; *(LAS u32x4*)(SC2_SLOT(SL_KH) + ro) = wkh;
            }
            SC2_BAR();
            { const Fr fAHx = ldf(SC2_SLOT(SL_AH), tx, lane), fKHx = ldf(SC2_SLOT(SL_KH), tx, lane), fRHx = ldf(SC2_SLOT(SL_RH), tx, lane);
#pragma unroll
              for (int j = 0; j < 2; ++j) { const int y0 = 16 * (ty0 + j) + q4;
                const Fr fBHy = ldf(SC2_SLOT(SL_BH), ty0 + j, lane), fAHy = ldf(SC2_SLOT(SL_AH), ty0 + j, lane), fKHy = ldf(SC2_SLOT(SL_KH), ty0 + j, lane);
                SC2_SB();
                f32x4 aab = mm(fBHy, fAHx, SC2_Z), aak = mm(fAHy, fKHx, SC2_Z), arb = mm(fBHy, fRHx, SC2_Z), ark = mm(fKHy, fRHx, SC2_Z);
                SC2_SB();
#pragma unroll
                for (int e = 0; e < 4; ++e) { const int y = y0 + e; if (!(y < x)) aab[e] = 0.f; if (!(x < y)) aak[e] = 0.f; if (!(y <= x)) { arb[e] = 0.f; ark[e] = 0.f; } }
                st4(SC2_SLOT(SL_AAB), x, y0, aab); st4(SC2_SLOT(SL_AAKT), x, y0, aak); st4(SC2_SLOT(SL_ARB), x, y0, arb); st4(SC2_SLOT(SL_ARK), x, y0, ark); } }
            SC2_BAR();
            if (wave == 0) {
                const int blk = lane >> 4; int c = lane & 15; asm volatile("" : "+v"(c));
                float X[16];
                const LAS char* am = SC2_SLOT(SL_AAB);
                { u32x4 ar0[9];
#pragma unroll
                  for (int r = 1; r < 9; ++r) ar0[r] = *(const LAS u32x4*)(am + swz(16 * blk + r, 32 * blk));
#pragma unroll
                  for (int r = 0; r < 9; ++r) { float xv = (r == c) ? 1.0f : 0.0f;
#pragma unroll
                      for (int s2 = 0; s2 < 8; ++s2) { if (s2 < r) { const unsigned wv = ar0[r][s2 >> 1]; xv += ((s2 & 1) ? bfhi(wv) : bflo(wv)) * X[s2]; } }
                      X[r] = xv; st1(SC2_SLOT(SL_T), 16 * blk + r, 16 * blk + c, xv); } }
                asm volatile("" ::: "memory");
                { u32x4 ar0[7], ar1[7];
#pragma unroll
                  for (int r = 9; r < 16; ++r) { ar0[r - 9] = *(const LAS u32x4*)(am + swz(16 * blk + r, 32 * blk)); ar1[r - 9] = *(const LAS u32x4*)(am + swz(16 * blk + r, 32 * blk + 16)); }
#pragma unroll
                  for (int r = 9; r < 16; ++r) { float xv = (r == c) ? 1.0f : 0.0f;
#pragma unroll
                      for (int s2 = 0; s2 < 16; ++s2) { if (s2 < r) { const unsigned wv = s2 < 8 ? ar0[r - 9][s2 >> 1] : ar1[r - 9][(s2 - 8) >> 1]; xv += ((s2 & 1) ? bfhi(wv) : bflo(wv)) * X[s2]; } }
                      X[r] = xv; st1(SC2_SLOT(SL_T), 16 * blk + r, 16 * blk + c, xv); } }
                u32x4 o0, o1;
#pragma unroll
                for (int i = 0; i < 4; ++i) { o0[i] = cvt_pk_bf16_n(X[2 * i], X[2 * i + 1]); o1[i] = cvt_pk_bf16_n(X[8 + 2 * i], X[9 + 2 * i]); }
                *(LAS u32x4*)(SC2_SLOT(SL_TT) + swz(16 * blk + c, 32 * blk)) = o0; *(LAS u32x4*)(SC2_SLOT(SL_TT) + swz(16 * blk + c, 32 * blk + 16)) = o1;
            } else {
                for (int i = tid - 64; i < 768; i += NTHREADS - 64) { const int m = i / 384, rem = i % 384, b12 = rem >> 5, rr = (rem & 31) >> 1, hf = rem & 1; const int bi = b12 / 3; int bj = b12 % 3; bj += (bj >= bi) ? 1 : 0;
                    *(LAS u32x4*)(SC2_SLOT(m ? SL_TT : SL_T) + swz(16 * bi + rr, 32 * bj + 16 * hf)) = zz4; }
            }
            SC2_BAR();
#pragma unroll
            for (int lv = 0; lv < 2; ++lv) { const int sh = 4 + lv;
                const LAS char* Ts = SC2_SLOT(lv ? SL_TB : SL_T); const LAS char* TTs = SC2_SLOT(lv ? SL_TTB : SL_TT); LAS char* Td = SC2_SLOT(lv ? SL_T : SL_TB); LAS char* TTd = SC2_SLOT(lv ? SL_TT : SL_TTB);
                { const Fr fTTx = ldf(TTs, tx, lane); Fr fABy[2];
#pragma unroll
                  for (int j = 0; j < 2; ++j) fABy[j] = ldf(SC2_SLOT(SL_AAB), ty0 + j, lane);
                  SC2_SB();
                  f32x4 ev[2];
#pragma unroll
                  for (int j = 0; j < 2; ++j) ev[j] = mm(fABy[j], fTTx, SC2_Z);
                  SC2_SB();
#pragma unroll
                  for (int j = 0; j < 2; ++j) { const int r0 = 16 * (ty0 + j) + q4;
#pragma unroll
                    for (int e = 0; e < 4; ++e) { const int r = r0 + e; const bool ok = ((r >> (sh + 1)) == (x >> (sh + 1))) && ((r >> sh) & 1) && !((x >> sh) & 1); if (!ok) ev[j][e] = 0.f; }
                    st4(SC2_SLOT(SL_ET), x, r0, ev[j]); } }
                SC2_BAR();
                { const Fr fTx = ldf(Ts, tx, lane), fETx = ldf(SC2_SLOT(SL_ET), tx, lane); Fr fETy[2], fTy[2]; f32x4 tn[2], ttn[2];
#pragma unroll
                  for (int j = 0; j < 2; ++j) { const int y0 = 16 * (ty0 + j) + q4; fETy[j] = ldf(SC2_SLOT(SL_ET), ty0 + j, lane); tn[j] = ld4(Ts, x, y0);
                      if (lv == 0) { fTy[j] = ldf(Ts, ty0 + j, lane); ttn[j] = ld4(TTs, x, y0); } }
                  SC2_SB();
#pragma unroll
                  for (int j = 0; j < 2; ++j) { tn[j] = mm(fETy[j], fTx, tn[j]);
                      if (lv == 0) ttn[j] = mm(fTy[j], fETx, ttn[j]); }
                  SC2_SB();
#pragma unroll
                  for (int j = 0; j < 2; ++j) { const int y0 = 16 * (ty0 + j) + q4; st4(Td, x, y0, tn[j]); if (lv == 0) st4(TTd, x, y0, ttn[j]); } }
                SC2_BAR();
            }
            { const Fr fAHTx = ldf(SC2_SLOT(SL_AHT), tx, lane), fAAKTx = ldf(SC2_SLOT(SL_AAKT), tx, lane); Fr fTy[2];
#pragma unroll
              for (int j = 0; j < 2; ++j) fTy[j] = ldf(SC2_SLOT(SL_T), ty0 + j, lane);
              SC2_SB();
              f32x4 p1[2], p2[2];
#pragma unroll
              for (int j = 0; j < 2; ++j) { p1[j] = mm(fTy[j], fAHTx, SC2_Z); p2[j] = mm(fTy[j], fAAKTx, SC2_Z); }
              SC2_SB();
#pragma unroll
              for (int j = 0; j < 2; ++j) { const int y0 = 16 * (ty0 + j) + q4; st4(SC2_SLOT(SL_P1T), x, y0, p1[j]); st4(SC2_SLOT(SL_P2T), x, y0, p2[j]); } }
            SC2_BAR();
            { const Fr fARBx = ldf(SC2_SLOT(SL_ARB), tx, lane), fBBTx = ldf(SC2_SLOT(SL_BBT), tx, lane); Fr fP1y[2], fP2y[2]; f32x4 q1[2], q2[2], ml[2], zx[2];
#pragma unroll
              for (int j = 0; j < 2; ++j) { const int y0 = 16 * (ty0 + j) + q4; fP1y[j] = ldf(SC2_SLOT(SL_P1T), ty0 + j, lane); fP2y[j] = ldf(SC2_SLOT(SL_P2T), ty0 + j, lane);
                  q1[j] = ld4(SC2_SLOT(SL_RH), x, y0); q2[j] = ld4(SC2_SLOT(SL_ARK), x, y0); zx[j] = ld4(SC2_SLOT(SL_KBT), x, y0); }
              SC2_SB();
#pragma unroll
              for (int j = 0; j < 2; ++j) { q1[j] = mm(fP1y[j], fARBx, q1[j]); q2[j] = mm(fP2y[j], fARBx, q2[j]); ml[j] = mm(fP1y[j], fBBTx, SC2_Z); zx[j] = mm(fP2y[j], fBBTx, zx[j]); }
              SC2_SB();
#pragma unroll
              for (int j = 0; j < 2; ++j) { const int y0 = 16 * (ty0 + j) + q4; st4(SC2_SLOT(SL_Q1), x, y0, q1[j]); st4(SC2_SLOT(SL_Q2), x, y0, q2[j]); st4(SC2_SLOT(SL_ML), x, y0, ml[j]); st4(SC2_SLOT(SL_ZX), x, y0, zx[j]); } }
            SC2_BAR();
            {
                if (ck + 1 < (seg + 1) * CPS) SC2_LOADRAW(ck + 1);
                const Fr fSt = ldf(SC2_SLOT(wave < 4 ? SL_S : SL_MT), cb, lane); Fr fVT = fSt; if (wave < 4) fVT = ldf(SC2_SLOT(SL_VT), cb, lane);
#pragma unroll
                for (int hf = 0; hf < 2; ++hf) { Fr fQ1[2], fQ2[2];
#pragma unroll
                  for (int t2 = 0; t2 < 2; ++t2) { const int tt = 2 * hf + t2; fQ1[t2] = ldf(SC2_SLOT(SL_Q1), tt, lane); fQ2[t2] = fQ1[t2]; if (wave < 4) fQ2[t2] = ldf(SC2_SLOT(SL_Q2), tt, lane); }
                  SC2_SB();
                  f32x4 yv[2];
#pragma unroll
                  for (int t2 = 0; t2 < 2; ++t2) { yv[t2] = mm(fSt, fQ1[t2], SC2_Z); if (wave < 4) yv[t2] = mm(fVT, fQ2[t2], yv[t2]); }
                  SC2_SB();
#pragma unroll
                  for (int t2 = 0; t2 < 2; ++t2) { const int tt = 2 * hf + t2; const int n = ck * CH + 16 * tt + l15;
                    if (wave < 4) {
                        if (ck >= CTX / CH) { const int row = scan_row_of(b, dir, n); h16x4 o; o[0] = (_Float16)yv[t2][0]; o[1] = (_Float16)yv[t2][1]; o[2] = (_Float16)yv[t2][2]; o[3] = (_Float16)yv[t2][3];
                            *(h16x4*)(YS + ((size_t)dir * ML + row) * 512 + head * 64 + 16 * cb + q4) = o; } }
                    else { u32x2 w; w.x = cvt_pk_bf16_n(yv[t2][0], yv[t2][1]); w.y = cvt_pk_bf16_n(yv[t2][2], yv[t2][3]); *(u32x2*)(QC + (size_t)n * 64 + 16 * cb + q4) = w; } } }
#pragma unroll
                for (int hf = 0; hf < 2; ++hf) { Fr fML[2], fZX[2]; f32x4 g[2];
#pragma unroll
                  for (int t2 = 0; t2 < 2; ++t2) { const int tk = 2 * hf + t2; fML[t2] = ldf(SC2_SLOT(SL_ML), tk, lane); fZX[t2] = fML[t2]; if (wave < 4) fZX[t2] = ldf(SC2_SLOT(SL_ZX), tk, lane); g[t2] = *(const LAS f32x4*)(gC + 16 * tk + q4); }
                  SC2_SB();
#pragma unroll
                  for (int t2 = 0; t2 < 2; ++t2) { const int tk = 2 * hf + t2; f32x4 xn = mm(fML[t2], fSt, mst[tk] * g[t2]); if (wave < 4) xn = mm(fZX[t2], fVT, xn); mst[tk] = xn; }
                  SC2_SB(); }
                SC2_BAR();
                LAS char* Sw = SC2_SLOT(wave < 4 ? SL_S : SL_MT);
#pragma unroll
                for (int tk = 0; tk < 4; ++tk) st4(Sw, 16 * cb + l15, 16 * tk + q4, mst[tk]);
            }
        }
        { float* dst = SEG + (wave < 4 ? 0 : 4096);
#pragma unroll
          for (int tk = 0; tk < 4; ++tk)
#pragma unroll
              for (int e = 0; e < 4; ++e) dst[(16 * tk + q4 + e) * 64 + 16 * cb + l15] = mst[tk][e]; }
        SC2_BAR();
    }
#undef SC2_LOADRAW
}

__device__ __forceinline__ void pass_b(KP p, LAS unsigned char* lds) {
    const int tid = threadIdx.x, lane = tid & 63, wave = __builtin_amdgcn_readfirstlane(tid >> 6), q4 = (lane >> 4) * 4, l15 = lane & 15;
    unsigned char* ws = p.ws;
    _Float16* YS = (_Float16*)((unsigned char*)p.out + DO_YS);
    LAS float* Xa = (LAS float*)lds; LAS float* Xb = Xa + 4096; LAS float* Mm = Xb + 4096;
    LAS char* Sst = (LAS char*)lds + 3 * 16384;
    for (int unit = blockIdx.x; unit < 256; unit += gridDim.x) {
        const int chain = unit >> 2, seg = unit & 3, dir = chain & 1, head = (chain >> 1) & 7, b = chain >> 4;
        if (seg == 0) continue;
        const bf16_t* QC = (const bf16_t*)(ws + (dir ? WS_QC1 : WS_QC0)) + (size_t)(chain >> 1) * SKV * 64;
        const float* SEG0 = (const float*)(ws + WS_SEG) + (size_t)(chain * 4) * 8192;
        for (int i = tid; i < 4096; i += NTHREADS) Xa[i] = SEG0[i];
        __syncthreads();
        LAS float* xc = Xa; LAS float* xn = Xb;
        for (int m = 1; m < seg; ++m) {
            const float* sg = SEG0 + (size_t)m * 8192;
            for (int i = tid; i < 4096; i += NTHREADS) Mm[i] = sg[4096 + i];
            __syncthreads();
            const int v = lane, k0 = wave * 8; float acc[8];
#pragma unroll
            for (int i = 0; i < 8; ++i) acc[i] = sg[(k0 + i) * 64 + v];
            for (int k2 = 0; k2 < 64; ++k2) { const float xv = xc[k2 * 64 + v];
#pragma unroll
                for (int i = 0; i < 8; ++i) acc[i] += Mm[(k0 + i) * 64 + k2] * xv; }
#pragma unroll
            for (int i = 0; i < 8; ++i) xn[(k0 + i) * 64 + v] = acc[i];
            __syncthreads();
            LAS float* tmp = xc; xc = xn; xn = tmp;
        }
        { const int v = lane, k0 = wave * 8; u32x4 o;
#pragma unroll
          for (int i = 0; i < 4; ++i) o[i] = cvt_pk_bf16_n(xc[(k0 + 2 * i) * 64 + v], xc[(k0 + 2 * i + 1) * 64 + v]);
          *(LAS u32x4*)(Sst + swz(v, k0 * 2)) = o; }
        SC2_BAR();
        const int cb = wave & 3, tt0 = (wave >> 2) * 2; const Fr fS = ldf(Sst, cb, lane);
        bf16x8 nb0[2], nb1[2]; h16x4 ny[2]; _Float16* nyp[2];
#define SC2_PBLOAD(ck_) do { _Pragma("unroll") for (int j = 0; j < 2; ++j) { const int n_ = (ck_) * CH + 16 * (tt0 + j) + l15; const bf16_t* qp_ = QC + (size_t)n_ * 64 + (lane >> 4) * 8; \
            nb0[j] = *(const bf16x8*)qp_; nb1[j] = *(const bf16x8*)(qp_ + 32); const int row_ = scan_row_of(b, dir, n_); \
            nyp[j] = YS + ((size_t)dir * ML + row_) * 512 + head * 64 + 16 * cb + q4; ny[j] = *(const h16x4*)nyp[j]; } } while (0)
        SC2_PBLOAD(seg * CPS);
        for (int ck = seg * CPS; ck < (seg + 1) * CPS; ++ck) {
            bf16x8 b0[2], b1[2]; h16x4 yv[2]; _Float16* yp[2];
#pragma unroll
            for (int j = 0; j < 2; ++j) { b0[j] = nb0[j]; b1[j] = nb1[j]; yv[j] = ny[j]; yp[j] = nyp[j]; }
            if (ck + 1 < (seg + 1) * CPS) SC2_PBLOAD(ck + 1);
#pragma unroll
            for (int j = 0; j < 2; ++j) {
                f32x4 acc = {0.f, 0.f, 0.f, 0.f};
                acc = __builtin_amdgcn_mfma_f32_16x16x32_bf16(fS.k0, b0[j], acc, 0, 0, 0);
                acc = __builtin_amdgcn_mfma_f32_16x16x32_bf16(fS.k1, b1[j], acc, 0, 0, 0);
                h16x4 o = yv[j]; o[0] = (_Float16)((float)o[0] + acc[0]); o[1] = (_Float16)((float)o[1] + acc[1]); o[2] = (_Float16)((float)o[2] + acc[2]); o[3] = (_Float16)((float)o[3] + acc[3]);
                *(h16x4*)yp[j] = o; }
        }
#undef SC2_PBLOAD
        __syncthreads();
    }
}
#undef SC2_SLOT
#undef SC2_BAR
}

__device__ __forceinline__ void ph_readout(KP p) {
    const int tid = threadIdx.x, lane = tid & 63, wave = tid >> 6;
    unsigned char* ws = p.ws;
    const _Float16* RKV = (const _Float16*)(ws + WS_RKV); const _Float16* A16 = (const _Float16*)(ws + WS_A16); const _Float16* G16 = (const _Float16*)(ws + WS_G16);
    const _Float16* YS = (const _Float16*)((const unsigned char*)p.out + DO_YS); bf16_t* MIX = (bf16_t*)((unsigned char*)p.out + DO_MIX);
    const int gw = blockIdx.x * NWAVES + wave, NGW = gridDim.x * NWAVES; const int c0 = lane * 8;
    float gng[8], gnb[8], ka_[8], rk_[8];
#pragma unroll
    for (int i = 0; i < 8; ++i) { gng[i] = p.in[I_GNG][c0 + i]; gnb[i] = p.in[I_GNB][c0 + i]; ka_[i] = p.in[I_KA][c0 + i]; rk_[i] = p.in[I_RK][c0 + i]; }
    ER(8) for (int row = gw; row < ML; row += NGW) {
        const h16x8 y0 = __builtin_nontemporal_load((const h16x8*)(YS + (size_t)row * 512 + c0)), y1 = __builtin_nontemporal_load((const h16x8*)(YS + ((size_t)ML + row) * 512 + c0));
        const h16x8 r8 = __builtin_nontemporal_load((const h16x8*)(RKV + (size_t)row * 1536 + c0)), k8 = __builtin_nontemporal_load((const h16x8*)(RKV + (size_t)row * 1536 + 512 + c0)), v8 = __builtin_nontemporal_load((const h16x8*)(RKV + (size_t)row * 1536 + 1024 + c0));
        const h16x8 a0 = __builtin_nontemporal_load((const h16x8*)(A16 + (size_t)row * 512 + c0)), a1 = __builtin_nontemporal_load((const h16x8*)(A16 + ((size_t)MA + row) * 512 + c0)), g8 = __builtin_nontemporal_load((const h16x8*)(G16 + (size_t)row * 512 + c0));
        float y[8]; float s = 0.f, bo = 0.f;
#pragma unroll
        for (int i = 0; i < 8; ++i) { y[i] = (float)y0[i] + (float)y1[i]; s += y[i];
            const float ksum = (float)k8[i] * (2.0f + ((float)a0[i] + (float)a1[i] - 2.0f) * ka_[i]); bo += (float)r8[i] * ksum * rk_[i]; }
        s += __shfl_xor(s, 1); s += __shfl_xor(s, 2); s += __shfl_xor(s, 4);
        bo += __shfl_xor(bo, 1); bo += __shfl_xor(bo, 2); bo += __shfl_xor(bo, 4);
        const float mu = s * (1.f / 64.f); float q = 0.f;
#pragma unroll
        for (int i = 0; i < 8; ++i) { y[i] -= mu; q += y[i] * y[i]; }
        q += __shfl_xor(q, 1); q += __shfl_xor(q, 2); q += __shfl_xor(q, 4);
        const float rstd = 1.0f / sqrtf(q * (1.f / 64.f) + GN_EPS);
        float o[8];
#pragma unroll
        for (int i = 0; i < 8; ++i) o[i] = (y[i] * rstd * gng[i] + gnb[i] + bo * (float)v8[i]) * (float)g8[i];
        u32x4 w; w.x = cvt_pk_bf16(o[0], o[1]); w.y = cvt_pk_bf16(o[2], o[3]); w.z = cvt_pk_bf16(o[4], o[5]); w.w = cvt_pk_bf16(o[6], o[7]);
        *(u32x4*)(MIX + (size_t)row * 1024 + c0) = w;
    }
}

__device__ __forceinline__ void ph_ln1_router(KP p, LAS unsigned char* lds) {
    const int tid = threadIdx.x, lane = tid & 63, wave = tid >> 6;
    unsigned char* ws = p.ws;
    _Float16* X1 = (_Float16*)(ws + WS_X1); bf16_t* XM2 = (bf16_t*)(ws + WS_XM2);
    float* AFF = (float*)(ws + WS_AFF); int* SLOT = (int*)(ws + WS_SLOT); const float* mod = (const float*)(ws + WS_MOD);
    LAS float* rt = (LAS float*)lds;
    LAS float* vec = (LAS float*)(lds + 65536);
    for (int i = tid; i < 1024 * 16; i += NTHREADS) rt[(i & 15) * 1024 + (i >> 4)] = p.in[I_ROUTER][i];
    for (int i = tid; i < 2048; i += NTHREADS) vec[3072 + i] = i < 1024 ? p.in[I_LN1G][i] : p.in[I_LN1B][i - 1024];
    const int G = gridDim.x, RPB = (((ML + G - 1) / G) + 15) & ~15;
    const int r0 = blockIdx.x * RPB, r1 = (r0 + RPB < ML) ? r0 + RPB : ML;
    const bf16_t* MO = (const bf16_t*)(ws + WS_Y1); const float* Xin = p.in[I_X];
    int curb = -1;
    f32x4 xa[4], xb[4]; u32x2 ma[4], mb[4];
#define LN1_LOAD(X, M, row_) do { const int rr_ = (row_) < r1 ? (row_) : (r1 - 8 + wave); const size_t o_ = (size_t)rr_ * D + lane * 4; \
    _Pragma("unroll") for (int q = 0; q < 4; ++q) { X[q] = __builtin_nontemporal_load((const f32x4*)(Xin + o_ + q * 256)); M[q] = __builtin_nontemporal_load((const u32x2*)(MO + o_ + q * 256)); } } while (0)
    if (r0 < ML) { LN1_LOAD(xa, ma, r0 + wave); LN1_LOAD(xb, mb, r0 + 8 + wave); }
#define LN1_HEAD(X, M, U, row_, nxt_) do { const int row = (row_); \
        f32x4 v[4]; float s = 0.f; \
        _Pragma("unroll") for (int q = 0; q < 4; ++q) { const f32x4 gv = *(const LAS f32x4*)(lds + lb1 + q * 1024), mv = {bflo(M[q].x), bfhi(M[q].x), bflo(M[q].y), bfhi(M[q].y)}; \
            v[q] = X[q] * ALPHA + gv * mv; s += (v[q].x + v[q].y) + (v[q].z + v[q].w); } \
        LN1_LOAD(X, M, nxt_); \
        float mean = wave_sum(s) * (1.f / D); float s2 = 0.f; \
        _Pragma("unroll") for (int q = 0; q < 4; ++q) { v[q] = v[q] - mean; s2 += (v[q].x * v[q].x + v[q].y * v[q].y) + (v[q].z * v[q].z + v[q].w * v[q].w); } \
        float rstd = __builtin_amdgcn_rsqf(wave_sum(s2) * (1.f / D) + LN_EPS); \
        s = 0.f; \
        _Pragma("unroll") for (int q = 0; q < 4; ++q) { const int c = q * 256 + lane * 4; const f32x4 g = *(const LAS f32x4*)(lds + lb1 + 12288 + q * 1024), bb = *(const LAS f32x4*)(lds + lb1 + 16384 + q * 1024); \
            v[q] = v[q] * rstd * g + bb; { h16x4 hv_ = {(_Float16)v[q].x, (_Float16)v[q].y, (_Float16)v[q].z, (_Float16)v[q].w}; *(h16x4*)(X1 + (size_t)row * D + c) = hv_; } s += (v[q].x + v[q].y) + (v[q].z + v[q].w); } \
        mean = wave_sum(s) * (1.f / D); s2 = 0.f; \
        _Pragma("unroll") for (int q = 0; q < 4; ++q) { v[q] = v[q] - mean; s2 += (v[q].x * v[q].x + v[q].y * v[q].y) + (v[q].z * v[q].z + v[q].w * v[q].w); } \
        rstd = __builtin_amdgcn_rsqf(wave_sum(s2) * (1.f / D) + LN_EPS); \
        _Pragma("unroll") for (int q = 0; q < 4; ++q) { const int c = q * 256 + lane * 4; const f32x4 a1 = *(const LAS f32x4*)(lds + lb1 + 8192 + q * 1024), bsh = *(const LAS f32x4*)(lds + lb1 + 4096 + q * 1024); \
            U[q] = v[q] * rstd * a1 + bsh; \
            u32x2 w; w.x = cvt_pk_bf16(U[q].x, U[q].y); w.y = cvt_pk_bf16(U[q].z, U[q].w); *(u32x2*)(XM2 + (size_t)row * D + c) = w; } } while (0)
#define LN1_TAIL(CMP, row_) do { const int row = (row_); const int b = row >> 13, t = row & (T - 1); \
        float lg[16]; \
        _Pragma("unroll") for (int e = 0; e < 16; ++e) lg[e] = acc[e].CMP; \
        float t8[8], t4[4]; \
        _Pragma("unroll") for (int e = 0; e < 8; ++e) { const auto r = __builtin_amdgcn_permlane32_swap(__float_as_uint(lg[e]), __float_as_uint(lg[e + 8]), false, false); t8[e] = __uint_as_float(r[0]) + __uint_as_float(r[1]); } \
        _Pragma("unroll") for (int e = 0; e < 4; ++e) { const auto r = __builtin_amdgcn_permlane16_swap(__float_as_uint(t8[e]), __float_as_uint(t8[e + 4]), false, false); t4[e] = __uint_as_float(r[0]) + __uint_as_float(r[1]); } \
        const bool o0 = lane & 1, o1 = lane & 2; \
        const float w0 = (o0 ? t4[1] : t4[0]) + dppf<0xB1>(o0 ? t4[0] : t4[1]), w1 = (o0 ? t4[3] : t4[2]) + dppf<0xB1>(o0 ? t4[2] : t4[3]); \
        float z = (o1 ? w1 : w0) + dppf<0x4E>(o1 ? w0 : w1); \
        z += dppf<0x124>(z); z += dppf<0x128>(z); \
        float mx = fmaxf(z, dppf<0xB1>(z)); mx = fmaxf(mx, dppf<0x4E>(mx)); mx = fmaxf(mx, dppf<0x141>(mx)); mx = fmaxf(mx, dppf<0x140>(mx)); \
        { const auto r = __builtin_amdgcn_permlane16_swap(__float_as_uint(mx), __float_as_uint(mx), false, false); mx = fmaxf(__uint_as_float(r[0]), __uint_as_float(r[1])); } \
        { const auto r = __builtin_amdgcn_permlane32_swap(__float_as_uint(mx), __float_as_uint(mx), false, false); mx = fmaxf(__uint_as_float(r[0]), __uint_as_float(r[1])); } \
        const float ez = __expf(z - mx); const float den = wave_sum(ez) * 0.25f;          \
        if (((lane >> 2) & 3) == 0) { const int e = (lane & 3) + 4 * (lane >> 4); AFF[((size_t)b * 16 + e) * T + t] = ez * __builtin_amdgcn_rcpf(den); SLOT[(size_t)row * 16 + e] = -1; } } while (0)
    for (int rb = r0; rb < r1; rb += 16) {
        const int b = rb >> 13;
        if (b != curb) { __syncthreads();
            for (int i = tid; i < 3072; i += NTHREADS) { const float x = mod[b * 6144 + 2048 + i]; vec[i] = (i >= 2048) ? x + 1.0f : x; }
            __syncthreads(); curb = b; }
        int lb0 = lane * 16, lb1 = 65536 + lane * 16; asm volatile("" : "+v"(lb0), "+v"(lb1));
        f32x4 ua[4], ub[4];
        LN1_HEAD(xa, ma, ua, rb + wave, rb + 16 + wave);
        __builtin_amdgcn_sched_barrier(0);
        LN1_HEAD(xb, mb, ub, rb + 8 + wave, rb + 24 + wave);
        __builtin_amdgcn_sched_barrier(0);
        f32x2 acc[16];
#pragma unroll
        for (int e = 0; e < 16; ++e) acc[e] = (f32x2){0.f, 0.f};
#pragma unroll
        for (int q = 0; q < 4; ++q) {
            const f32x2 u0 = {ua[q].x, ub[q].x}, u1 = {ua[q].y, ub[q].y}, u2 = {ua[q].z, ub[q].z}, u3 = {ua[q].w, ub[q].w};
#pragma unroll
            for (int eh = 0; eh < 16; eh += 8) { f32x4 r[8];
#pragma unroll
                for (int e = 0; e < 8; ++e) r[e] = *(const LAS f32x4*)(lds + lb0 + (eh + e) * 4096 + q * 1024);
#pragma unroll
                for (int e = 0; e < 8; ++e) { f32x2 t = acc[eh + e];
                    t = __builtin_elementwise_fma(u0, (f32x2){r[e].x, r[e].x}, t); t = __builtin_elementwise_fma(u1, (f32x2){r[e].y, r[e].y}, t);
                    t = __builtin_elementwise_fma(u2, (f32x2){r[e].z, r[e].z}, t); t = __builtin_elementwise_fma(u3, (f32x2){r[e].w, r[e].w}, t); acc[eh + e] = t; }
                __builtin_amdgcn_sched_barrier(0); } }
        LN1_TAIL(x, rb + wave);
        __builtin_amdgcn_sched_barrier(0);
        LN1_TAIL(y, rb + 8 + wave);
        __builtin_amdgcn_sched_barrier(0);
    }
#undef LN1_HEAD
#undef LN1_TAIL
#undef LN1_LOAD
#undef LN1_ROW
}

__device__ __forceinline__ void ph_expert_weights(KP p, LAS unsigned char* lds) {
    const int tid = threadIdx.x, lane = tid & 63, wave = tid >> 6;
    unsigned char* ws = p.ws;
    const int gw = blockIdx.x * NWAVES + wave, NGW = gridDim.x * NWAVES;
    {
        LAS float* scr = (LAS float*)(lds + wave * 8448);
        bf16_t* WGU = (bf16_t*)(ws + WS_WGU); bf16_t* WD = (bf16_t*)(ws + WS_WD);
        constexpr int PER = 16 * 32;
#ifndef TOPK_ITEMS
#define TOPK_ITEMS 9
#endif
        constexpr int NIT = 3 * 16 * PER; const int G = gridDim.x, bx = blockIdx.x;
        int ibase, icnt;
        if (G == 256 && (NIT - 64 * 8 * TOPK_ITEMS) % (192 * 8) == 0) { constexpr int CN = (NIT - 64 * 8 * TOPK_ITEMS) / (192 * 8);
            if (bx < 64) { icnt = TOPK_ITEMS; ibase = 192 * 8 * CN + bx * 8 * TOPK_ITEMS; } else { icnt = CN; ibase = (bx - 64) * 8 * CN; } }
        else { icnt = (NIT + NGW - 1) / NGW; ibase = bx * 8 * icnt; }
        ER(11) for (int ii = 0; ii < icnt; ++ii) { const int it = ibase + ii * 8 + wave; if (it >= NIT) break;
            const int which = it / (16 * PER), r = it % (16 * PER), e = r / PER, kb = (r % PER) / 32, nb = r % 32;
            if (which < 2) { const float* W = p.in[which == 0 ? I_EG : I_EU] + (size_t)e * 1024 * 1024; const int f0 = nb * 32;
                const int drow = 256 * (f0 >> 7) + (which == 1 ? 128 : 0) + (f0 & 127);
                transpose_item(W, 1024, kb * 64, f0, WGU + ((size_t)e * 2048 + drow) * 1024 + kb * 64, 1024, nullptr, scr, lane); }
            else { const float* W = p.in[I_ED] + (size_t)e * 1024 * 1024;
                transpose_item(W, 1024, kb * 64, nb * 32, WD + ((size_t)e * 1024 + nb * 32) * 1024 + kb * 64, 1024, nullptr, scr, lane); }
        }
    }
}

__device__ __forceinline__ void ph_topk(KP p, LAS unsigned char* lds) {
    const int tid = threadIdx.x, lane = tid & 63, wave = tid >> 6;
    unsigned char* ws = p.ws;
    const float* AFF = (const float*)(ws + WS_AFF); int* SLOT = (int*)(ws + WS_SLOT); int* IDX = (int*)(ws + WS_IDX); float* GATE = (float*)(ws + WS_GATE);
    LAS unsigned* hist = (LAS unsigned*)lds;
    LAS unsigned* sh = (LAS unsigned*)(lds + 1024);
    for (int prob = blockIdx.x; prob < 64; prob += gridDim.x) {
        const int b = prob >> 4, e = prob & 15;
        const float* av = AFF + (size_t)prob * T;
        unsigned key[16];
#pragma unroll
        for (int i = 0; i < 4; ++i) { const u32x4 x = __builtin_nontemporal_load((const u32x4*)(av + tid * 16 + i * 4)); key[4 * i] = x.x; key[4 * i + 1] = x.y; key[4 * i + 2] = x.z; key[4 * i + 3] = x.w; }
        unsigned prefix = 0, kth = CAP;
        for (int pass = 0; pass < 4; ++pass) {
            const int shift = 24 - 8 * pass; const unsigned himask = pass == 0 ? 0u : (0xffffffffu << (shift + 8));
            if (tid < 256) hist[tid] = 0u;
            __syncthreads();
#pragma unroll
            for (int i = 0; i < 16; ++i) if ((key[i] & himask) == prefix) atomicAdd((unsigned*)&hist[(key[i] >> shift) & 255u], 1u);
            __syncthreads();
            if (wave == 0) {
                const u32x4 h4 = *(const LAS u32x4*)(hist + lane * 4); const unsigned sl = h4.x + h4.y + h4.z + h4.w; unsigned suf = sl;
#pragma unroll
                for (int o = 1; o < 64; o <<= 1) { const unsigned tt = __shfl_down(suf, o); if (lane + o < 64) suf += tt; }
                const unsigned above = suf - sl;
                if (above < kth && kth <= suf) { unsigned cum = above; int d;
                    if (cum + h4.w >= kth) d = 3; else { cum += h4.w; if (cum + h4.z >= kth) d = 2; else { cum += h4.z; if (cum + h4.y >= kth) d = 1; else { cum += h4.y; d = 0; } } }
                    sh[0] = prefix | ((unsigned)(4 * lane + d) << shift); sh[1] = kth - cum; } }
            __syncthreads();
            prefix = sh[0]; kth = sh[1];
            __syncthreads();
        }
        unsigned ngt = 0, neq = 0;
#pragma unroll
        for (int i = 0; i < 16; ++i) { ngt += key[i] > prefix; neq += key[i] == prefix; }
        unsigned ig = ngt, iq = neq;
#pragma unroll
        for (int o = 1; o < 64; o <<= 1) { const unsigned a = __shfl_up(ig, o), c = __shfl_up(iq, o); if (lane >= o) { ig += a; iq += c; } }
        if (lane == 63) { sh[8 + wave] = ig; sh[16 + wave] = iq; }
        __syncthreads();
        unsigned og = 0, oq = 0;
        for (int w = 0; w < wave; ++w) { og += sh[8 + w]; oq += sh[16 + w]; }
        unsigned eg = og + ig - ngt, eq = oq + iq - neq;
        const int sbase = (e * 4 + b) * CAP;
#pragma unroll
        for (int i = 0; i < 16; ++i) {
            const int t = tid * 16 + i; bool take = false;
            if (key[i] > prefix) take = true; else if (key[i] == prefix) { take = eq < kth; }
            if (take) { const unsigned eqsel = eq < kth ? eq : kth; const int c = (int)(eg + eqsel);
                IDX[sbase + c] = t; GATE[sbase + c] = __uint_as_float(key[i]); SLOT[((size_t)b * T + t) * 16 + e] = c; }
            if (key[i] > prefix) ++eg; else if (key[i] == prefix) ++eq;
        }
        __syncthreads();
    }
}

__device__ __forceinline__ void ph_final(KP p) {
    const int tid = threadIdx.x, lane = tid & 63, wave = tid >> 6;
    unsigned char* ws = p.ws;
    const _Float16* X1 = (const _Float16*)(ws + WS_X1); const bf16_t* YE = (const bf16_t*)(ws + WS_YE); const int* SLOT = (const int*)(ws + WS_SLOT); const float* mod = (const float*)(ws + WS_MOD);
    const int gw = blockIdx.x * NWAVES + wave, NGW = gridDim.x * NWAVES;
    if (gw >= ML) return;
#define FIN_ROWC(r_) ((r_) < ML ? (r_) : gw)
#define FIN_SLOTS(r_) (lane < 16 ? SLOT[(size_t)FIN_ROWC(r_) * 16 + lane] : -1)
#define FIN_GATHER(W, NE, REST, sl_, r_) do { unsigned long long act_ = __ballot((sl_) >= 0); const int b_ = FIN_ROWC(r_) >> 13; NE = 0; \
        _Pragma("unroll") for (int i = 0; i < 4; ++i) { const bool on_ = act_ != 0; const int e_ = on_ ? __builtin_ctzll(act_) : 0; if (on_) { act_ &= act_ - 1; NE = i + 1; } \
            const int c_ = __shfl((sl_), e_); const bf16_t* yr_ = YE + ((size_t)(e_ * 4 + b_) * CAP + (c_ < 0 ? 0 : c_)) * 1024; \
            if (on_) { _Pragma("unroll") for (int q = 0; q < 4; ++q) W[i][q] = __builtin_nontemporal_load((const u32x2*)(yr_ + q * 256 + lane * 4)); } } \
        REST = act_; } while (0)
    int s1 = FIN_SLOTS(gw), s2 = FIN_SLOTS(gw + NGW);
    f32x4 nx[4]; u32x2 nw[4][4]; int nne; unsigned long long nrest;
#pragma unroll
    for (int q = 0; q < 4; ++q) { const h16x4 hv_ = __builtin_nontemporal_load((const h16x4*)(X1 + (size_t)gw * D + q * 256 + lane * 4)); nx[q] = (f32x4){(float)hv_[0], (float)hv_[1], (float)hv_[2], (float)hv_[3]}; }
    FIN_GATHER(nw, nne, nrest, s1, gw);
    ER(14) for (int row = gw; row < ML; row += NGW) {
        const int b = row >> 13;
        const int myslot = s1; const int ne = nne; unsigned long long rest = nrest;
        f32x4 v[4]; u32x2 w[4][4];
#pragma unroll
        for (int q = 0; q < 4; ++q) v[q] = nx[q];
#pragma unroll
        for (int i = 0; i < 4; ++i)
#pragma unroll
            for (int q = 0; q < 4; ++q) w[i][q] = nw[i][q];
        s1 = s2; s2 = FIN_SLOTS(row + 2 * NGW);
        { const int nr = FIN_ROWC(row + NGW);
#pragma unroll
          for (int q = 0; q < 4; ++q) { const h16x4 hv_ = __builtin_nontemporal_load((const h16x4*)(X1 + (size_t)nr * D + q * 256 + lane * 4)); nx[q] = (f32x4){(float)hv_[0], (float)hv_[1], (float)hv_[2], (float)hv_[3]}; }
          FIN_GATHER(nw, nne, nrest, s1, row + NGW); }
        f32x4 m[4];
#pragma unroll
        for (int q = 0; q < 4; ++q) m[q] = (f32x4){0.f, 0.f, 0.f, 0.f};
#pragma unroll
        for (int i = 0; i < 4; ++i) if (i < ne) {
#pragma unroll
            for (int q = 0; q < 4; ++q) { m[q].x += bflo(w[i][q].x); m[q].y += bfhi(w[i][q].x); m[q].z += bflo(w[i][q].y); m[q].w += bfhi(w[i][q].y); } }
        while (rest) {
            const int e = __builtin_ctzll(rest); rest &= rest - 1;
            const int c = __shfl(myslot, e); const bf16_t* yr = YE + ((size_t)(e * 4 + b) * CAP + (c < 0 ? 0 : c)) * 1024;
#pragma unroll
            for (int q = 0; q < 4; ++q) { const u32x2 ww = *(const u32x2*)(yr + q * 256 + lane * 4); m[q].x += bflo(ww.x); m[q].y += bfhi(ww.x); m[q].z += bflo(ww.y); m[q].w += bfhi(ww.y); } }
        float s = 0.f;
#pragma unroll
        for (int q = 0; q < 4; ++q) { const int c = q * 256 + lane * 4; const f32x4 g2 = *(const f32x4*)(mod + b * 6144 + 5120 + c);
            v[q] = v[q] * ALPHA + g2 * m[q]; s += (v[q].x + v[q].y) + (v[q].z + v[q].w); }
        const float mean = wave_sum(s) * (1.f / D); float s2v = 0.f;
#pragma unroll
        for (int q = 0; q < 4; ++q) { v[q] = v[q] - mean; s2v += (v[q].x * v[q].x + v[q].y * v[q].y) + (v[q].z * v[q].z + v[q].w * v[q].w); }
        const float rstd = __builtin_amdgcn_rsqf(wave_sum(s2v) * (1.f / D) + LN_EPS);
#pragma unroll
        for (int q = 0; q < 4; ++q) { const int c = q * 256 + lane * 4; const f32x4 g = *(const f32x4*)(p.in[I_LN2G] + c), bb = *(const f32x4*)(p.in[I_LN2B] + c);
            __builtin_nontemporal_store(v[q] * rstd * g + bb, (f32x4*)(p.out + (size_t)row * D + c)); }
    }
#undef FIN_ROWC
#undef FIN_SLOTS
#undef FIN_GATHER
}

__global__ void __launch_bounds__(NTHREADS, 2) mega(Params p_unused) {
    const Params __attribute__((address_space(4)))* pq = (const Params __attribute__((address_space(4)))*)__builtin_amdgcn_kernarg_segment_ptr();
    KP p = *pq;
    extern __shared__ __attribute__((aligned(16))) unsigned char lds_raw[];
    LAS unsigned char* lds = (LAS unsigned char*)lds_raw;
    cg::grid_group grid = cg::this_grid();
    unsigned char* ws = p.ws;
    const int lo = p.ph_lo, hi = p.ph_hi;
    const int G = gridDim.x, bx = blockIdx.x;
    volatile LAS unsigned* xst = (volatile LAS unsigned*)(lds + LDS_BYTES - 64);
    if (threadIdx.x < 4) xst[threadIdx.x] = 0u;
    __syncthreads();
    const XcdBarrier xbar = xcd_barrier_post((unsigned*)(ws + WS_CTL), xst);
    if (lo < 0) grid.sync();
#ifndef PHMASK
#define PHMASK 0x7fff
#endif
#define IN(k) ((((PHMASK) >> (k)) & 1) && lo <= (k) && (k) < hi)
#define SEAM(k) do { if (IN(k) && IN((k) + 1)) xcd_barrier(xbar); } while (0)
#ifndef DUPMASK
#define DUPMASK 0
#endif
#ifndef GDUP
#define GDUP 0
#endif
#define GD(k) ((((GDUP) >> (k)) & 1) + 1)
#define REPL(k) for (int repl_ = 0; repl_ <= (((DUPMASK) >> (k)) & 1); ++repl_, __syncthreads())
#define REP(k) for (int rep_ = 0; rep_ <= (((DUPMASK) >> (k)) & 1); ++rep_, ((((DUPMASK) >> (k)) & 1) && rep_ == 1 ? grid.sync() : (void)0))
    if (IN(0)) REP(0) { ph_mod_and_weights(p, lds); } SEAM(0);
    if (IN(1)) REP(1) { ph_modulate1(p); } SEAM(1);
    if (IN(2)) REP(2) {
        pg8::Gemm g{(const bf16_t*)(ws + WS_XM), (const bf16_t*)(ws + WS_WIN), 1024, 1024}; pg8::DenseOrder S; S.init(MA, NHP, G, bx, GD(2));
        EpiH E{(bf16_t*)(ws + WS_H)}; pg8::gemm_phase(lds, g, S, E); } SEAM(2);
    if (IN(3)) REP(3) { ph_prepare(p); } SEAM(3);
    if (IN(4)) REP(4) {
        { pg8::Gemm g{(const bf16_t*)(ws + WS_H) + 1920, (const bf16_t*)(ws + WS_WUQ), 256, NHP}; pg8::DenseOrder S; S.init(ML, 768, G, bx, GD(4));
          EpiQ E{(bf16_t*)(ws + WS_Q), (const float*)(ws + WS_RSTDQ)}; pg8::gemm_phase(lds, g, S, E); }
        { pg8::Gemm g{(const bf16_t*)(ws + WS_H) + 2176, (const bf16_t*)(ws + WS_WUKV), 256, NHP}; pg8::DenseOrder S; S.init(MA, 1024, G, bx, GD(4));
          EpiKV E{(bf16_t*)(ws + WS_K), (bf16_t*)(ws + WS_V), (const float*)(ws + WS_RSTDKV)}; pg8::gemm_phase(lds, g, S, E); } } SEAM(4);
    if (IN(5)) REP(5) {
        pg8::Gemm g{(const bf16_t*)(ws + WS_ACT), (const bf16_t*)(ws + WS_WLORA), 128, 384}; pg8::LoraOrder S; S.init(MA, 2560, G, bx, GD(5));
        EpiLora E{(_Float16*)(ws + WS_E16), (_Float16*)(ws + WS_A16), (_Float16*)(ws + WS_G16), p.in[I_W0], p.in[I_A0]}; pg8::gemm_phase(lds, g, S, E); } SEAM(5);
#define PADA 0
    asm volatile(".rept %0\n s_nop 0\n .endr" :: "n"(PADA));
    if (IN(6)) REP(6) {
        const int vcu = (G % 8 == 0) ? (bx % 8) * (G / 8) + bx / 8 : bx;
#ifndef MIXGRP
#define MIXGRP 2
#endif
        const int grp = (MIXGRP == 1) ? 0 : ((G % 8 == 0) ? (bx / 8) % MIXGRP : bx % MIXGRP);
        const int scan_slot = (MIXGRP == 1) ? 2 : (MIXGRP == 2 ? (grp == 0 ? 2 : 0) : 2 - grp);
        int au = vcu; const int natt = vcu < 512 ? (512 - vcu + G - 1) / G : 0; const int sslot = scan_slot < natt ? scan_slot : natt;
        for (int slot = 0; slot <= natt; ++slot) {
            if (slot == sslot) { sc2::pass_a(p, lds); __syncthreads(); }
            else { const int unit = au; au += G; const int bh = unit >> 5, qb = unit & 31; const int b = bh >> 2, hh = bh & 3;
                att2::attn_unit((const bf16_t*)(ws + WS_Q) + ((size_t)bh * T + qb * 256) * 192, (const bf16_t*)(ws + WS_K) + (size_t)bh * SKV * 192, (const bf16_t*)(ws + WS_V) + (size_t)bh * SKV * 128,
                               (bf16_t*)((unsigned char*)p.out + DO_MIX) + ((size_t)b * T + qb * 256) * 1024 + 512 + hh * 128, lds);
                __syncthreads(); }
        }
        } SEAM(6);
#define PADB 7
    asm volatile(".rept %0\n s_nop 0\n .endr" :: "n"(PADB));
    if (IN(7)) REP(7) { sc2::pass_b(p, lds); } SEAM(7);
    if (IN(8)) REP(8) { ph_readout(p); } SEAM(8);
    if (IN(9)) REP(9) {
        pg8::Gemm g{(const bf16_t*)((unsigned char*)p.out + DO_MIX), (const bf16_t*)(ws + WS_WOUT), 1024, 1024}; pg8::DenseOrder S; S.init(ML, 1024, G, bx, GD(9));
        EpiMix E{(bf16_t*)(ws + WS_Y1)}; pg8::gemm_phase(lds, g, S, E); } SEAM(9);
    if (IN(10)) REP(10) { ph_ln1_router(p, lds); } SEAM(10);
    if (IN(11)) REP(11) { ph_topk(p, lds); __syncthreads(); ph_expert_weights(p, lds); } SEAM(11);
    if (IN(12)) REP(12) {
        pg8::Gemm g{(const bf16_t*)(ws + WS_XM2), (const bf16_t*)(ws + WS_WGU), 1024, 1024}; GuOrder S{G, bx, (const int*)(ws + WS_IDX), GD(12)};
        EpiHid E{(bf16_t*)(ws + WS_HID)}; pg8::gemm_phase(lds, g, S, E); } SEAM(12);
    if (IN(13)) REP(13) {
        pg8::Gemm g{(const bf16_t*)(ws + WS_HID), (const bf16_t*)(ws + WS_WD), 1024, 1024}; DnOrder S{G, bx, GD(13)};
        EpiYe E{(bf16_t*)(ws + WS_YE), (const float*)(ws + WS_GATE)}; pg8::gemm_phase(lds, g, S, E); } SEAM(13);
    if (IN(14)) REP(14) { ph_final(p); }
#undef IN
#undef SEAM
}

extern "C" void kernel_launch(void* const* d_in, const int* in_sizes, int n_in, void* d_out, int out_size, void* d_ws, size_t ws_size, hipStream_t stream) {
    static int grid_blocks = 0;
    if (grid_blocks == 0) {
        if (n_in != 32 || out_size != ML * D || ws_size < WS_END) { fprintf(stderr, "kernel_launch: unexpected shapes: n_in %d out %d ws %zu (need %zu)\n", n_in, out_size, ws_size, (size_t)WS_END); grid_blocks = -1; return; }
        int dev = 0, cus = 0, per_cu = 0;
        (void)hipGetDevice(&dev);
        (void)hipDeviceGetAttribute(&cus, hipDeviceAttributeMultiprocessorCount, dev);
        (void)hipFuncSetAttribute((const void*)mega, hipFuncAttributeMaxDynamicSharedMemorySize, LDS_BYTES);
        (void)hipOccupancyMaxActiveBlocksPerMultiprocessor(&per_cu, (const void*)mega, NTHREADS, LDS_BYTES);
        if (per_cu < 1) { fprintf(stderr, "kernel_launch: occupancy query says %d blocks per CU\n", per_cu); grid_blocks = -1; return; }
        grid_blocks = cus;
    }
    if (grid_blocks < 0) return;
    if (hipMemsetAsync((char*)d_ws + WS_CTL, 0, CTL_BYTES, stream) != hipSuccess) { fprintf(stderr, "kernel_launch: memset failed\n"); return; }
    Params p{};
    for (int i = 0; i < 32; ++i) p.in[i] = (const float*)d_in[i];
    p.out = (float*)d_out; p.ws = (unsigned char*)d_ws; p.ph_lo = 0; p.ph_hi = NPHASE;
    void* args[] = {&p};
    hipError_t e = hipLaunchCooperativeKernel((const void*)mega, dim3(grid_blocks), dim3(NTHREADS), args, LDS_BYTES, stream);
    if (e != hipSuccess) fprintf(stderr, "kernel_launch: cooperative launch failed: %s (grid %d)\n", hipGetErrorString(e), grid_blocks);
}
```
